# Optimizing an MI355X kernel written in HIP

```python
import math
import jax
import jax.numpy as jnp
from jax import lax
import numpy as np

D_MODEL = 1024
BATCH = 16
SEQ = 2048
DEPTH = 2

GRID_W = 64
CTX_LEN = 256
EPS = 1e-6
N_MIXERS = 4
D_MIX = D_MODEL
W_GRP = D_MIX // N_MIXERS
CHUNK = 128

SSD_HEAD_DIM = 64
SSD_HEADS = W_GRP // SSD_HEAD_DIM
SSD_STATE = 64
SSD_CONV = 3
SSD_XBC = W_GRP + 2 * SSD_STATE
SSD_COLS = W_GRP + SSD_XBC + 2 * SSD_HEADS

HY_ORDER = 2
HY_EMB = 33
HY_BANDS = (HY_EMB - 1) // 2
HY_FILT = 64
HY_CONV = 3
HY_DECAY_SHORT = 0.3
HY_DECAY_LONG = 1.5
HY_DECAY_TARGET = 1e-2
HY_COLS = (HY_ORDER + 1) * W_GRP

RET_HEADS = 4
RET_HEAD_DIM = W_GRP // RET_HEADS
ROPE_BASE = 10000.0
RET_COLS = 4 * W_GRP

S5_CH = 16
S5_GROUPS = W_GRP // S5_CH
S5_STATE = 64
S5_DT_MIN = 1e-3
S5_DT_MAX = 1e-1
S5_COLS = W_GRP

OFF_HY = SSD_COLS
OFF_RET = OFF_HY + HY_COLS
OFF_S5 = OFF_RET + RET_COLS
D_IN = OFF_S5 + S5_COLS

D_FF = -(-8 * D_MODEL // (3 * 256)) * 256

kernel_name = 'hybrid_ssd_hyena_retention_s5_dit'


def rms_norm(x, g):
    xf = x.astype(jnp.float32)
    y = xf * lax.rsqrt(jnp.mean(xf * xf, axis=-1, keepdims=True) + EPS)
    return (y * g.astype(jnp.float32)).astype(x.dtype)


def modulate(x, shift, scale):
    return x * (1.0 + scale) + shift


def dwconv(x, w, b):
    k = w.shape[0]
    y = lax.conv_general_dilated(x, w[:, None, :].astype(x.dtype), window_strides=(1,),
                                 padding=((k // 2, k // 2),),
                                 dimension_numbers=('NWC', 'WIO', 'NWC'),
                                 feature_group_count=x.shape[-1])
    return y + b


def chunked_scan(q, k, v, log_a, h0):
    f32 = jnp.float32
    bsz, L, H, N = q.shape
    P = v.shape[-1]
    nc = L // CHUNK
    qc = q.astype(f32).reshape(bsz, nc, CHUNK, H, N)
    kc = k.astype(f32).reshape(bsz, nc, CHUNK, H, N)
    vc = v.astype(f32).reshape(bsz, nc, CHUNK, H, P)
    acs = jnp.cumsum(log_a.astype(f32).reshape(bsz, nc, CHUNK, H), axis=2)
    acs_h = jnp.swapaxes(acs, 2, 3)
    seg = acs_h[..., :, None] - acs_h[..., None, :]
    lower = jnp.tril(jnp.ones((CHUNK, CHUNK), dtype=bool))
    decay = jnp.exp(jnp.where(lower, seg, -jnp.inf))
    scores = jnp.einsum('bcihn,bcjhn->bchij', qc, kc) * decay
    y = jnp.einsum('bchij,bcjhp->bcihp', scores, vc)
    to_end = jnp.exp(acs[:, :, -1:, :] - acs)
    states = jnp.einsum('bcjhn,bcjh,bcjhp->bchnp', kc, to_end, vc)
    chunk_decay = jnp.exp(acs[:, :, -1, :])

    def step(h, inp):
        s, d = inp
        return h * d[:, :, None, None] + s, h

    h_last, h_in = lax.scan(step, h0.astype(f32),
                            (jnp.moveaxis(states, 1, 0), jnp.moveaxis(chunk_decay, 1, 0)))
    h_in = jnp.moveaxis(h_in, 0, 1)
    y = y + jnp.einsum('bcihn,bchnp->bcihp', qc * jnp.exp(acs)[..., None], h_in)
    return y.reshape(bsz, L, H, P).astype(v.dtype), h_last


def two_stream_scan(q_c, k_c, v_c, la_c, q_l, k_l, v_l, la_l, reverse):
    if reverse:
        q_c, k_c, v_c, la_c = (jnp.flip(q_c, 1), jnp.flip(k_c, 1), jnp.flip(v_c, 1), jnp.flip(la_c, 1))
        q_l, k_l, v_l, la_l = (jnp.flip(q_l, 1), jnp.flip(k_l, 1), jnp.flip(v_l, 1), jnp.flip(la_l, 1))
    bsz, _, H, N = q_c.shape
    h0 = jnp.zeros((bsz, H, N, v_c.shape[-1]), jnp.float32)
    y_c, h_c = chunked_scan(q_c, k_c, v_c, la_c, h0)
    y_l, _ = chunked_scan(q_l, k_l, v_l, la_l, h_c)
    if reverse:
        y_c, y_l = jnp.flip(y_c, 1), jnp.flip(y_l, 1)
    return y_c, y_l


def ssd_prep(u, conv_w, conv_b, dt_bias):
    bsz, L, _ = u.shape
    z = u[..., :W_GRP]
    xbc = jax.nn.silu(dwconv(u[..., W_GRP:W_GRP + SSD_XBC], conv_w, conv_b))
    xs = xbc[..., :W_GRP].reshape(bsz, L, SSD_HEADS, SSD_HEAD_DIM)
    bm = xbc[..., W_GRP:W_GRP + SSD_STATE]
    cm = xbc[..., W_GRP + SSD_STATE:]
    dt = jax.nn.softplus(u[..., W_GRP + SSD_XBC:].reshape(bsz, L, 2, SSD_HEADS) + dt_bias)
    return z, xs, bm, cm, dt


def ssd_direction_args(xs, bm, cm, dt_dir, a_dir):
    bsz, L = bm.shape[:2]
    q = jnp.broadcast_to(cm[:, :, None, :], (bsz, L, SSD_HEADS, SSD_STATE))
    k = bm[:, :, None, :] * dt_dir[..., None]
    return q, k, xs, dt_dir.astype(jnp.float32) * a_dir


def ssd_mixer(u_c, u_l, conv_w, conv_b, a_log, dt_bias, d_skip, norm_g):
    z_c, xs_c, b_c, c_c, dt_c = ssd_prep(u_c, conv_w, conv_b, dt_bias)
    z_l, xs_l, b_l, c_l, dt_l = ssd_prep(u_l, conv_w, conv_b, dt_bias)
    a = -jnp.exp(a_log.astype(jnp.float32))
    y_c = xs_c * d_skip[:, None]
    y_l = xs_l * d_skip[:, None]
    for r in range(2):
        yc, yl = two_stream_scan(*ssd_direction_args(xs_c, b_c, c_c, dt_c[:, :, r], a[r]),
                                 *ssd_direction_args(xs_l, b_l, c_l, dt_l[:, :, r], a[r]),
                                 reverse=(r == 1))
        y_c = y_c + yc
        y_l = y_l + yl
    out_c = rms_norm(y_c.reshape(z_c.shape) * jax.nn.silu(z_c), norm_g)
    out_l = rms_norm(y_l.reshape(z_l.shape) * jax.nn.silu(z_l), norm_g)
    return out_c, out_l


def hyena_filter(L, w1, b1, freq, w2, b2, w3):
    f32 = jnp.float32
    t = jnp.linspace(0.0, 1.0, L, dtype=f32)[:, None]
    w = 2.0 * math.pi * jnp.arange(L, dtype=f32)[:, None] / L
    bands = jnp.linspace(1e-4, HY_BANDS - 1, HY_BANDS, dtype=f32)[None, :]
    feats = jnp.concatenate([t, jnp.cos(bands * w), -jnp.sin(bands * w)], axis=-1)
    h = jnp.sin(freq * (feats @ w1 + b1))
    h = jnp.sin(freq * (h @ w2 + b2))
    h = (h @ w3).astype(f32)
    max_decay = math.log(HY_DECAY_TARGET) / HY_DECAY_SHORT
    min_decay = math.log(HY_DECAY_TARGET) / HY_DECAY_LONG
    deltas = jnp.abs(jnp.linspace(min_decay, max_decay, h.shape[-1], dtype=f32))
    h = h * jnp.exp(-t * deltas)
    return h.reshape(L, 2, HY_ORDER, W_GRP)


def two_sided_filter(h_f, h_b):
    L, C = h_f.shape
    k = jnp.concatenate([h_f, jnp.zeros((1, C), h_f.dtype), jnp.flip(h_b[1:], axis=0)], axis=0)
    return k / (jnp.sum(jnp.abs(k), axis=0, keepdims=True) + EPS)


def fft_conv(u, filt):
    L = u.shape[1]
    U = jnp.fft.rfft(u.astype(jnp.float32), n=2 * L, axis=1)
    F = jnp.fft.rfft(filt.astype(jnp.float32), axis=0)
    return jnp.fft.irfft(U * F, n=2 * L, axis=1)[:, :L].astype(u.dtype)


def hyena_stream(u, conv_w, conv_b, w1, b1, freq, w2, b2, w3, bias):
    L = u.shape[1]
    u = dwconv(u, conv_w, conv_b)
    x1, x2, z = jnp.split(u, 3, axis=-1)
    filt = hyena_filter(L, w1, b1, freq, w2, b2, w3)
    for o, gate in enumerate((x1, x2)):
        f2 = two_sided_filter(filt[:, 0, o], filt[:, 1, o])
        z = gate * (fft_conv(z, f2) + z * bias[o])
    return z


def rope_half(t, pos):
    f = t.shape[-1] // 2
    inv = ROPE_BASE ** (-jnp.arange(f, dtype=jnp.float32) / f)
    ang = pos.astype(jnp.float32)[:, None] * inv
    cos = jnp.cos(ang)[:, None, :]
    sin = jnp.sin(ang)[:, None, :]
    t1, t2 = t[..., :f], t[..., f:]
    return jnp.concatenate([t1 * cos - t2 * sin, t1 * sin + t2 * cos], axis=-1).astype(t.dtype)


def axial_rope(t, row_id, col_id):
    h = t.shape[-1] // 2
    return jnp.concatenate([rope_half(t[..., :h], row_id), rope_half(t[..., h:], col_id)], axis=-1)


def retention_out(y, g):
    yf = y.astype(jnp.float32)
    mu = jnp.mean(yf, axis=-1, keepdims=True)
    var = jnp.mean(jnp.square(yf - mu), axis=-1, keepdims=True)
    yn = ((yf - mu) * lax.rsqrt(var + EPS)).astype(g.dtype)
    return (jax.nn.silu(g) * yn).reshape(g.shape[0], g.shape[1], W_GRP)


def retention_mixer(u_c, u_l, decay_param, row_id, col_id):
    bc, lc = u_c.shape[:2]
    bl, ll = u_l.shape[:2]
    qc, kc, vc, gc = [t.reshape(bc, lc, RET_HEADS, RET_HEAD_DIM) for t in jnp.split(u_c, 4, axis=-1)]
    ql, kl, vl, gl = [t.reshape(bl, ll, RET_HEADS, RET_HEAD_DIM) for t in jnp.split(u_l, 4, axis=-1)]
    ql = axial_rope(ql, row_id, col_id)
    kl = axial_rope(kl, row_id, col_id)
    scale = RET_HEAD_DIM ** -0.5
    log_gamma = -jnp.exp(decay_param.astype(jnp.float32))
    y_c = jnp.zeros(vc.shape, jnp.float32)
    y_l = jnp.zeros(vl.shape, jnp.float32)
    for r in range(2):
        la_c = jnp.broadcast_to(log_gamma[r], (bc, lc, RET_HEADS))
        la_l = jnp.broadcast_to(log_gamma[r], (bl, ll, RET_HEADS))
        yc, yl = two_stream_scan(qc, kc * scale, vc, la_c, ql, kl * scale, vl, la_l, reverse=(r == 1))
        y_c = y_c + yc
        y_l = y_l + yl
    return retention_out(y_c, gc), retention_out(y_l, gl)


def s5_discretize(a_re, a_im, log_dt):
    f32 = jnp.float32
    dt = jnp.exp(log_dt.astype(f32))[:, None]
    a_re = a_re.astype(f32)
    a_im = a_im.astype(f32)
    mag = jnp.exp(a_re * dt)
    ab_re = mag * jnp.cos(a_im * dt)
    ab_im = mag * jnp.sin(a_im * dt)
    den = a_re * a_re + a_im * a_im
    z_re = ((ab_re - 1.0) * a_re + ab_im * a_im) / den
    z_im = (ab_im * a_re - (ab_re - 1.0) * a_im) / den
    return ab_re, ab_im, z_re, z_im


def s5_combine(e1, e2):
    a1r, a1i, b1r, b1i = e1
    a2r, a2i, b2r, b2i = e2
    return (a2r * a1r - a2i * a1i, a2r * a1i + a2i * a1r,
            a2r * b1r - a2i * b1i + b2r, a2r * b1i + a2i * b1r + b2i)


def s5_scan(ab_re, ab_im, bu_re, bu_im, h0_re, h0_im):
    b_re = bu_re.at[:, 0].add(ab_re * h0_re - ab_im * h0_im)
    b_im = bu_im.at[:, 0].add(ab_re * h0_im + ab_im * h0_re)
    a_re = jnp.broadcast_to(ab_re, b_re.shape)
    a_im = jnp.broadcast_to(ab_im, b_im.shape)
    _, _, h_re, h_im = lax.associative_scan(s5_combine, (a_re, a_im, b_re, b_im), axis=1)
    return h_re, h_im


def s5_direction(u, h0_re, h0_im, ab_re, ab_im, bb_re, bb_im, c_re, c_im, reverse):
    if reverse:
        u = jnp.flip(u, 1)
    bu_re = jnp.einsum('gpc,blgc->blgp', bb_re, u)
    bu_im = jnp.einsum('gpc,blgc->blgp', bb_im, u)
    h_re, h_im = s5_scan(ab_re, ab_im, bu_re, bu_im, h0_re, h0_im)
    y = (jnp.einsum('gcp,blgp->blgc', c_re.astype(jnp.float32), h_re)
         - jnp.einsum('gcp,blgp->blgc', c_im.astype(jnp.float32), h_im))
    if reverse:
        y = jnp.flip(y, 1)
    return y, h_re[:, -1], h_im[:, -1]


def s5_glu(y, w, b, dtype):
    y = jax.nn.gelu(y.reshape(y.shape[0], y.shape[1], W_GRP)).astype(dtype)
    return y * jax.nn.sigmoid(y @ w + b)


def s5_mixer(u_c, u_l, a_re, a_im, log_dt, b_re, b_im, c_re, c_im, d_skip, glu_w, glu_b):
    f32 = jnp.float32
    uc = u_c.astype(f32).reshape(u_c.shape[0], u_c.shape[1], S5_GROUPS, S5_CH)
    ul = u_l.astype(f32).reshape(u_l.shape[0], u_l.shape[1], S5_GROUPS, S5_CH)
    dg = d_skip.astype(f32).reshape(S5_GROUPS, S5_CH)
    y_c = uc * dg
    y_l = ul * dg
    b_re = b_re.astype(f32)
    b_im = b_im.astype(f32)
    zero = jnp.zeros((u_c.shape[0], S5_GROUPS, S5_STATE), f32)
    for r in range(2):
        ab_re, ab_im, z_re, z_im = s5_discretize(a_re[r], a_im[r], log_dt[r])
        bb_re = z_re[..., None] * b_re - z_im[..., None] * b_im
        bb_im = z_re[..., None] * b_im + z_im[..., None] * b_re
        yc, hc_re, hc_im = s5_direction(uc, zero, zero, ab_re, ab_im, bb_re, bb_im,
                                        c_re[r], c_im[r], r == 1)
        yl, _, _ = s5_direction(ul, hc_re, hc_im, ab_re, ab_im, bb_re, bb_im,
                                c_re[r], c_im[r], r == 1)
        y_c = y_c + yc
        y_l = y_l + yl
    return s5_glu(y_c, glu_w, glu_b, u_c.dtype), s5_glu(y_l, glu_w, glu_b, u_l.dtype)


def swiglu(x, w_up, w_down):
    g, u = jnp.split(x @ w_up, 2, axis=-1)
    return (jax.nn.silu(g) * u) @ w_down


def split_cols(u):
    return jnp.split(u, [OFF_HY, OFF_RET, OFF_S5], axis=-1)


def setup_inputs(seed: int = 0) -> dict:
    key = jax.random.key(seed)
    ks = iter(jax.random.split(key, 64))
    f32 = jnp.float32
    L = DEPTH

    def nrm(shape, scale):
        return scale * jax.random.normal(next(ks), shape, f32)

    def unif(shape, lo, hi):
        return jax.random.uniform(next(ks), shape, f32, lo, hi)

    x = nrm((BATCH, SEQ, D_MODEL), 1.0)
    c = nrm((BATCH, D_MODEL), 1.0)
    ctx = nrm((BATCH, CTX_LEN, D_MODEL), 1.0)
    c_ctx = nrm((D_MODEL,), 1.0)
    mod_w = nrm((L, D_MODEL, 6 * D_MODEL), 0.5 * D_MODEL ** -0.5)
    mod_b = nrm((L, 6 * D_MODEL), 0.02)
    norm1_g = 1.0 + nrm((L, D_MODEL), 0.02)
    norm2_g = 1.0 + nrm((L, D_MODEL), 0.02)
    w_in = nrm((L, D_MODEL, D_IN), D_MODEL ** -0.5)
    w_out = nrm((L, D_MIX, D_MODEL), D_MIX ** -0.5)
    ssd_conv_w = nrm((L, SSD_CONV, SSD_XBC), SSD_CONV ** -0.5)
    ssd_conv_b = nrm((L, SSD_XBC), 0.02)
    ssd_a_log = jnp.log(unif((L, 2, SSD_HEADS), 1.0, 16.0))
    dt0 = jnp.exp(unif((L, 2, SSD_HEADS), math.log(1e-3), math.log(1e-1)))
    ssd_dt_bias = dt0 + jnp.log(-jnp.expm1(-dt0))
    ssd_d = 1.0 + nrm((L, SSD_HEADS), 0.02)
    ssd_norm_g = 1.0 + nrm((L, W_GRP), 0.02)
    hy_conv_w = nrm((L, HY_CONV, HY_COLS), HY_CONV ** -0.5)
    hy_conv_b = nrm((L, HY_COLS), 0.02)
    hy_w1 = nrm((L, HY_EMB, HY_FILT), HY_EMB ** -0.5)
    hy_b1 = nrm((L, HY_FILT), 0.02)
    hy_freq = 1.0 + nrm((L, HY_FILT), 0.02)
    hy_w2 = nrm((L, HY_FILT, HY_FILT), HY_FILT ** -0.5)
    hy_b2 = nrm((L, HY_FILT), 0.02)
    hy_w3 = nrm((L, HY_FILT, 2 * HY_ORDER * W_GRP), HY_FILT ** -0.5)
    hy_bias = nrm((L, HY_ORDER, W_GRP), 1.0)
    gam = 1.0 - 2.0 ** (-5.0 - jnp.arange(RET_HEADS, dtype=f32))
    ret_decay = jnp.log(-jnp.log(gam)) + nrm((L, 2, RET_HEADS), 0.01)
    n_idx = jnp.arange(S5_STATE, dtype=f32)
    s5_a_re = -0.5 + nrm((L, 2, S5_GROUPS, S5_STATE), 0.01)
    s5_a_im = math.pi * n_idx + nrm((L, 2, S5_GROUPS, S5_STATE), 0.01)
    s5_log_dt = unif((L, 2, S5_GROUPS), math.log(S5_DT_MIN), math.log(S5_DT_MAX))
    s5_b_re = nrm((L, S5_GROUPS, S5_STATE, S5_CH), (2 * S5_CH) ** -0.5)
    s5_b_im = nrm((L, S5_GROUPS, S5_STATE, S5_CH), (2 * S5_CH) ** -0.5)
    s5_c_re = nrm((L, 2, S5_GROUPS, S5_CH, S5_STATE), (2 * S5_STATE) ** -0.5)
    s5_c_im = nrm((L, 2, S5_GROUPS, S5_CH, S5_STATE), (2 * S5_STATE) ** -0.5)
    s5_d = nrm((L, W_GRP), 1.0)
    s5_glu_w = nrm((L, W_GRP, W_GRP), W_GRP ** -0.5)
    s5_glu_b = nrm((L, W_GRP), 0.02)
    ffn_w_up = nrm((L, D_MODEL, 2 * D_FF), D_MODEL ** -0.5)
    ffn_w_down = nrm((L, D_FF, D_MODEL), D_FF ** -0.5)
    final_norm_g = 1.0 + nrm((D_MODEL,), 0.02)
    return {'x': x, 'c': c, 'ctx': ctx, 'c_ctx': c_ctx, 'mod_w': mod_w, 'mod_b': mod_b,
            'norm1_g': norm1_g, 'norm2_g': norm2_g, 'w_in': w_in, 'w_out': w_out,
            'ssd_conv_w': ssd_conv_w, 'ssd_conv_b': ssd_conv_b, 'ssd_a_log': ssd_a_log,
            'ssd_dt_bias': ssd_dt_bias, 'ssd_d': ssd_d, 'ssd_norm_g': ssd_norm_g,
            'hy_conv_w': hy_conv_w, 'hy_conv_b': hy_conv_b, 'hy_w1': hy_w1, 'hy_b1': hy_b1,
            'hy_freq': hy_freq, 'hy_w2': hy_w2, 'hy_b2': hy_b2, 'hy_w3': hy_w3, 'hy_bias': hy_bias,
            'ret_decay': ret_decay, 's5_a_re': s5_a_re, 's5_a_im': s5_a_im, 's5_log_dt': s5_log_dt,
            's5_b_re': s5_b_re, 's5_b_im': s5_b_im, 's5_c_re': s5_c_re, 's5_c_im': s5_c_im,
            's5_d': s5_d, 's5_glu_w': s5_glu_w, 's5_glu_b': s5_glu_b,
            'ffn_w_up': ffn_w_up, 'ffn_w_down': ffn_w_down, 'final_norm_g': final_norm_g}


def reference(x, c, ctx, c_ctx, mod_w, mod_b, norm1_g, norm2_g, w_in, w_out,
              ssd_conv_w, ssd_conv_b, ssd_a_log, ssd_dt_bias, ssd_d, ssd_norm_g,
              hy_conv_w, hy_conv_b, hy_w1, hy_b1, hy_freq, hy_w2, hy_b2, hy_w3, hy_bias,
              ret_decay, s5_a_re, s5_a_im, s5_log_dt, s5_b_re, s5_b_im, s5_c_re, s5_c_im,
              s5_d, s5_glu_w, s5_glu_b, ffn_w_up, ffn_w_down, final_norm_g):
    n_lat = x.shape[1]
    rows = n_lat // GRID_W
    row_id = jnp.repeat(jnp.arange(rows), GRID_W)
    col_id = jnp.tile(jnp.arange(GRID_W), rows)
    silu_c = jax.nn.silu(c)
    silu_cc = jax.nn.silu(c_ctx)
    h_l, h_c = x, ctx
    for i in range(DEPTH):
        last = i == DEPTH - 1
        m_l = jnp.split((silu_c @ mod_w[i] + mod_b[i])[:, None, :], 6, axis=-1)
        m_c = jnp.split((silu_cc @ mod_w[i] + mod_b[i])[None, None, :], 6, axis=-1)
        ul = split_cols(modulate(rms_norm(h_l, norm1_g[i]), m_l[0], m_l[1]) @ w_in[i])
        uc = split_cols(modulate(rms_norm(h_c, norm1_g[i]), m_c[0], m_c[1]) @ w_in[i])
        ssd_c, ssd_l = ssd_mixer(uc[0], ul[0], ssd_conv_w[i], ssd_conv_b[i], ssd_a_log[i],
                                 ssd_dt_bias[i], ssd_d[i], ssd_norm_g[i])
        hy_args = (hy_conv_w[i], hy_conv_b[i], hy_w1[i], hy_b1[i], hy_freq[i],
                   hy_w2[i], hy_b2[i], hy_w3[i], hy_bias[i])
        hy_l = hyena_stream(ul[1], *hy_args)
        ret_c, ret_l = retention_mixer(uc[2], ul[2], ret_decay[i], row_id, col_id)
        s5c, s5l = s5_mixer(uc[3], ul[3], s5_a_re[i], s5_a_im[i], s5_log_dt[i], s5_b_re[i],
                            s5_b_im[i], s5_c_re[i], s5_c_im[i], s5_d[i], s5_glu_w[i], s5_glu_b[i])
        y_l = jnp.concatenate([ssd_l, hy_l, ret_l, s5l], axis=-1) @ w_out[i]
        h_l = h_l + m_l[2] * y_l
        h_l = h_l + m_l[5] * swiglu(modulate(rms_norm(h_l, norm2_g[i]), m_l[3], m_l[4]),
                                    ffn_w_up[i], ffn_w_down[i])
        if not last:
            hy_c = hyena_stream(uc[1], *hy_args)
            y_c = jnp.concatenate([ssd_c, hy_c, ret_c, s5c], axis=-1) @ w_out[i]
            h_c = h_c + m_c[2] * y_c
            h_c = h_c + m_c[5] * swiglu(modulate(rms_norm(h_c, norm2_g[i]), m_c[3], m_c[4]),
                                        ffn_w_up[i], ffn_w_down[i])
    return rms_norm(h_l, final_norm_g)
```

```cpp
#include <hip/hip_runtime.h>
#include <hip/hip_cooperative_groups.h>
#include <cstdio>
#include <cstdint>
namespace cg = cooperative_groups;

#ifndef ONE_LAUNCH
#define ONE_LAUNCH 1
#endif

#define LAS __attribute__((address_space(3)))
typedef unsigned short bf16_t;
typedef short bf16x8 __attribute__((ext_vector_type(8)));
typedef float f32x4 __attribute__((ext_vector_type(4)));
typedef float f32x2 __attribute__((ext_vector_type(2)));
typedef unsigned u32x4 __attribute__((ext_vector_type(4)));
typedef unsigned u32x2 __attribute__((ext_vector_type(2)));

constexpr int DM = 1024, NB = 16, SEQ = 2048, CTX = 256;
constexpr int MLAT = NB * SEQ, MCTX = NB * CTX, MTOT = MLAT + MCTX;
constexpr int D_IN = 2696, NIN = 2816, DFF = 2816, UW = 1928;
constexpr int UC_Z = 0, UC_X = 256, UC_B = 512, UC_C = 576, UC_DT = 640, UC_Q = 648, UC_K = 904, UC_V = 1160, UC_G = 1416, UC_S5 = 1672;

constexpr size_t AL(size_t x) { return (x + 255) & ~(size_t)255; }
constexpr size_t WS_SUM = 0;
constexpr size_t WS_MOD = 8192;
constexpr size_t WS_S5AB = AL(WS_MOD + (size_t)2 * 17 * 6144 * 4);
constexpr size_t WS_S5BB = AL(WS_S5AB + (size_t)2 * 2 * 16 * 64 * 8);
constexpr size_t WS_S5CM = AL(WS_S5BB + (size_t)2 * 2 * 16 * 128 * 16 * 2);
constexpr size_t WS_GLAT = AL(WS_S5CM + (size_t)2 * 2 * 16 * 16 * 128 * 2);
constexpr size_t WS_GCTX = AL(WS_GLAT + (size_t)2 * 2 * 256 * 4096 * 4);
constexpr size_t WS_WIN = AL(WS_GCTX + (size_t)2 * 256 * 512 * 4);
constexpr size_t WS_WOUT = AL(WS_WIN + (size_t)2 * NIN * DM * 2);
constexpr size_t WS_WUP = AL(WS_WOUT + (size_t)2 * DM * DM * 2);
constexpr size_t WS_WDN = AL(WS_WUP + (size_t)2 * 2 * DFF * DM * 2);
constexpr size_t WS_WGLU = AL(WS_WDN + (size_t)2 * DM * DFF * 2);
constexpr size_t WS_HC = AL(WS_WGLU + (size_t)2 * 256 * 256 * 2);
constexpr size_t WS_XN = AL(WS_HC + (size_t)MCTX * DM * 4);
constexpr size_t WS_U = AL(WS_XN + (size_t)MTOT * DM * 2);
constexpr size_t WS_UH = WS_U + (size_t)MTOT * UW * 2;
constexpr size_t WS_Y = AL(WS_U + (size_t)MTOT * DFF * 2);
constexpr size_t WS_ZH = AL(WS_Y + (size_t)6 * MTOT * 256 * 2);
constexpr size_t WS_XBC = AL(WS_ZH + (size_t)256 * MTOT * 2);
constexpr size_t WS_SSQ = AL(WS_XBC + (size_t)MTOT * 384 * 2);
constexpr size_t WS_SWUP = AL(WS_SSQ + (size_t)MTOT * 4);
constexpr size_t WS_SSQ2 = AL(WS_SWUP + (size_t)2 * 17 * 2 * DFF * 4);
constexpr size_t WS_SWIN = AL(WS_SSQ2 + (size_t)MTOT * 4);
constexpr size_t WS_XBAR = AL(WS_SWIN + (size_t)17 * NIN * 4);
constexpr size_t WS_END = AL(WS_XBAR + 16384);
static_assert(WS_UH + (size_t)768 * MTOT * 2 <= WS_Y, "U/UH overlay");

constexpr int LDS_BYTES = 144 * 1024;

struct Params { const float* in[39]; float* out; unsigned char* ws; };
struct PV { const Params& K; int z; int tid;
    __device__ __forceinline__ const float* in_(int i) const { return K.in[i + z]; }
    __device__ __forceinline__ float* out_() const { return K.out + z; }
    __device__ __forceinline__ unsigned char* ws_() const { return K.ws + z; } };
enum { I_X = 0, I_C, I_CTX, I_CCTX, I_MODW, I_MODB, I_N1G, I_N2G, I_WIN, I_WOUT, I_SCW, I_SCB, I_SALOG, I_SDTB, I_SD, I_SNG,
       I_HCW, I_HCB, I_HW1, I_HB1, I_HFREQ, I_HW2, I_HB2, I_HW3, I_HBIAS, I_RDEC, I_5ARE, I_5AIM, I_5LDT, I_5BRE, I_5BIM,
       I_5CRE, I_5CIM, I_5D, I_5GW, I_5GB, I_FUP, I_FDN, I_FNG };

typedef __bf16 bf16x2_t __attribute__((ext_vector_type(2)));
__device__ __forceinline__ unsigned pk2(float lo, float hi) { const f32x2 v = {lo, hi}; const bf16x2_t b = __builtin_convertvector(v, bf16x2_t); return __builtin_bit_cast(unsigned, b); }
__device__ __forceinline__ bf16_t f2bf(float f) { return (bf16_t)(pk2(f, 0.f) & 0xffffu); }
__device__ __forceinline__ float bf2f(bf16_t b) { return __uint_as_float(((unsigned)b) << 16); }
__device__ __forceinline__ float bflo(unsigned w) { return __uint_as_float(w << 16); }
__device__ __forceinline__ float bfhi(unsigned w) { return __uint_as_float(w & 0xffff0000u); }
__device__ __forceinline__ void unpack8(u32x4 w, float* v) {
    v[0] = bflo(w.x); v[1] = bfhi(w.x); v[2] = bflo(w.y); v[3] = bfhi(w.y); v[4] = bflo(w.z); v[5] = bfhi(w.z); v[6] = bflo(w.w); v[7] = bfhi(w.w);
}
__device__ __forceinline__ u32x4 pack8(const float* v) { u32x4 w; w.x = pk2(v[0], v[1]); w.y = pk2(v[2], v[3]); w.z = pk2(v[4], v[5]); w.w = pk2(v[6], v[7]); return w; }
__device__ __forceinline__ float sigmoidf_(float x) { return __builtin_amdgcn_rcpf(1.f + __expf(-x)); }
__device__ __forceinline__ float siluf_(float x) { return x * __builtin_amdgcn_rcpf(1.f + __expf(-x)); }
__device__ __forceinline__ float softplusf_(float x) { return x > 20.f ? x : log1pf(__expf(x)); }
__device__ __forceinline__ float gelu_tanh(float x) { const float u = 0.7978845608f * (x + 0.044715f * x * x * x); return x * __builtin_amdgcn_rcpf(1.f + __expf(-2.f * u)); }
__device__ __forceinline__ float wave_sum(float v) {
#pragma unroll
    for (int o = 1; o < 64; o <<= 1) v += __shfl_xor(v, o);
    return v;
}
#define WAVE_SYNC() do { asm volatile("s_waitcnt lgkmcnt(0)" ::: "memory"); __builtin_amdgcn_wave_barrier(); } while (0)

namespace pg8 {
constexpr int BM = 256, BK = 64, HALF = 128, HTB = HALF * BK * 2, STAGE_BYTES = 8 * HTB, NXCD = 8, WGM = 8;
__host__ __device__ __forceinline__ int lds_byte(int r, int c) { const int st = (r >> 4) * 2 + (c >> 5), rr = r & 15, cc = c & 31, ob = rr * 64 + cc * 2; return st * 1024 + (ob ^ (((ob >> 9) & 1) << 5)); }
__host__ __device__ __forceinline__ void stage_rc(int b, int& R, int& C) { const int st = b / 1024, sb = b % 1024, swz = sb ^ (((sb >> 9) & 1) << 5); R = (st >> 1) * 16 + swz / 64; C = (st & 1) * 32 + (swz % 64) / 2; }
struct Unit { int pm, pn; };
struct Gemm { const bf16_t* A; const bf16_t* Bt; int M, N, K; };
struct StaticOrder {
    int nM, nN, nwg, G, c;
    __host__ __device__ void init(int M, int N, int G_, int c_) { nM = M / BM; nN = N / BM; nwg = nM * nN; G = G_; c = c_; }
    __host__ __device__ bool next(int i, Unit& u) const {
        const long L = (long)i * G + c; if (L >= nwg) return false;
        int wgid = (int)L; { const int q = nwg / NXCD, r = nwg % NXCD, xcd = wgid % NXCD, off = wgid / NXCD; wgid = (xcd < r ? xcd * (q + 1) : r * (q + 1) + (xcd - r) * q) + off; }
        const int nig = WGM * nN, gid = wgid / nig, fm = gid * WGM, gsz = (nM - fm) < WGM ? (nM - fm) : WGM;
        u.pm = fm + ((wgid % nig) % gsz); u.pn = (wgid % nig) / gsz; return true;
    }
};
struct LastWinOrder {
    StaticOrder lat; int G, c;
    __host__ __device__ void init(int G_, int c_) { lat.init(MLAT, NIN, G_, c_); G = G_; c = c_; }
    __host__ __device__ bool next(int i, Unit& u) const {
        const int L = i * G + c;
        if (L < lat.nwg) return lat.next(i, u);
        const int idx = L - lat.nwg; if (idx >= 16 * 8) return false;
        const int k = idx & 7; u.pm = MLAT / 256 + (idx >> 3); u.pn = k == 0 ? 1 : (k == 1 ? 2 : k + 3);
        return true;
    }
};
template <class Epi, class Sched>
__device__ __forceinline__ void gemm_phase(LAS unsigned char* lds, const Gemm g, const Sched& S, const Epi& E, const int tid) {
    const int wid = __builtin_amdgcn_readfirstlane(tid >> 6), lane = tid & 63, wr = wid >> 2, wc = wid & 3, fr = lane & 15, fq = lane >> 4;
    const int K = g.K, nt = K / BK;
    unsigned voffA[2];
#pragma unroll
    for (int i = 0; i < 2; ++i) { int R, C; stage_rc(tid * 16 + i * 8192, R, C); voffA[i] = (unsigned)(R * K + C) * 2u; }
    const size_t kstep = (size_t)(BK * 2);
    const size_t hstep = (size_t)HALF * K * 2;
    const size_t tstep = 2 * hstep;
    const unsigned ldsw = (unsigned)wid * 1024u;
    const int aoff = lds_byte(wr * 64 + fr, fq * 8), boff = lds_byte(wc * 32 + fr, fq * 8);
#define PG8_SA(b, h) (((b) * 2 + (h)) * HTB)
#define PG8_SB(b, h) ((4 + (b) * 2 + (h)) * HTB)
#define PG8_STAGE(bufoff, gbase, voff) do { _Pragma("unroll") for (int _i = 0; _i < 2; ++_i) \
        __builtin_amdgcn_global_load_lds((const unsigned*)((const char*)(gbase) + (voff)[_i]), (LAS unsigned*)(lds + (bufoff) + ldsw + _i * 8192), 16, 0, 0); } while (0)
#define PG8_LDA(dst, b, h) do { _Pragma("unroll") for (int m = 0; m < 4; ++m) _Pragma("unroll") for (int k = 0; k < 2; ++k) dst[m][k] = *(const LAS bf16x8*)(lds + PG8_SA(b, h) + aoff + m * 2048 + k * 1024); } while (0)
#define PG8_LDB(dst, b, h) do { _Pragma("unroll") for (int n = 0; n < 2; ++n) _Pragma("unroll") for (int k = 0; k < 2; ++k) dst[n][k] = *(const LAS bf16x8*)(lds + PG8_SB(b, h) + boff + n * 2048 + k * 1024); } while (0)
#define PG8_MMA(ai, bj, At, Bt) do { __builtin_amdgcn_s_setprio(1); _Pragma("unroll") for (int m = 0; m < 4; ++m) _Pragma("unroll") for (int n = 0; n < 2; ++n) _Pragma("unroll") for (int k = 0; k < 2; ++k) \
        acc[ai][bj][m][n] = __builtin_amdgcn_mfma_f32_16x16x32_bf16(Bt[n][k], At[m][k], acc[ai][bj][m][n], 0, 0, 0); __builtin_amdgcn_s_setprio(0); } while (0)
#define PG8_WAIT_V(n) asm volatile("s_waitcnt vmcnt(" #n ")" ::: "memory")
#define PG8_WAIT_L(n) asm volatile("s_waitcnt lgkmcnt(" #n ")" ::: "memory")
#define PG8_BAR __builtin_amdgcn_s_barrier()
#define PG8_SCHED __builtin_amdgcn_sched_barrier(0)
    Unit cur, nxt; int ui = 0;
    if (!S.next(0, cur)) return;
    f32x4 acc[2][2][4][2];
#pragma unroll
    for (int a = 0; a < 2; ++a)
#pragma unroll
        for (int b = 0; b < 2; ++b)
#pragma unroll
            for (int m = 0; m < 4; ++m)
#pragma unroll
                for (int n = 0; n < 2; ++n) acc[a][b][m][n] = (f32x4){0.f, 0.f, 0.f, 0.f};
    bf16x8 At[4][2], B0[2][2], B1[2][2];
    const char* cA = (const char*)g.A + (size_t)cur.pm * tstep; const char* cB = (const char*)g.Bt + (size_t)cur.pn * tstep;
    PG8_STAGE(PG8_SB(0, 0), cB, voffA); PG8_STAGE(PG8_SA(0, 0), cA, voffA); PG8_STAGE(PG8_SB(0, 1), cB + hstep, voffA); PG8_STAGE(PG8_SA(0, 1), cA + hstep, voffA);
    if (wr == 1) PG8_BAR;
    PG8_WAIT_V(4); PG8_BAR;
    PG8_STAGE(PG8_SB(1, 0), cB + kstep, voffA); PG8_STAGE(PG8_SA(1, 0), cA + kstep, voffA); PG8_STAGE(PG8_SB(1, 1), cB + hstep + kstep, voffA);
    PG8_WAIT_V(6); PG8_BAR;
    for (;;) {
        const bool has_next = S.next(ui + 1, nxt);
        const char* nA = has_next ? (const char*)g.A + (size_t)nxt.pm * tstep : cA; const char* nB = has_next ? (const char*)g.Bt + (size_t)nxt.pn * tstep : cB;
        for (int t = 0; t < nt; t += 2) {
            const bool last = (t == nt - 2);
            const char* a1 = cA + (size_t)(t + 1) * kstep;
            const char* a2 = last ? nA : cA + (size_t)(t + 2) * kstep; const char* b2 = last ? nB : cB + (size_t)(t + 2) * kstep;
            const char* a3 = a2 + kstep; const char* b3 = b2 + kstep;
            PG8_LDB(B0, 0, 0); PG8_SCHED; PG8_LDA(At, 0, 0); PG8_STAGE(PG8_SA(1, 1), a1 + hstep, voffA);
            PG8_WAIT_L(8); PG8_BAR; PG8_WAIT_L(0); PG8_MMA(0, 0, At, B0); PG8_BAR; PG8_SCHED;
            PG8_LDB(B1, 0, 1); PG8_STAGE(PG8_SB(0, 0), b2, voffA);
            PG8_BAR; PG8_WAIT_L(0); PG8_MMA(0, 1, At, B1); PG8_BAR;
            PG8_LDA(At, 0, 1); PG8_STAGE(PG8_SA(0, 0), a2, voffA);
            PG8_BAR; PG8_WAIT_L(0); PG8_MMA(1, 0, At, B0); PG8_BAR; PG8_SCHED;
            PG8_STAGE(PG8_SB(0, 1), b2 + hstep, voffA);
            PG8_WAIT_V(6); PG8_BAR; PG8_MMA(1, 1, At, B1); PG8_BAR;
            PG8_LDB(B0, 1, 0); PG8_SCHED; PG8_LDA(At, 1, 0); PG8_STAGE(PG8_SA(0, 1), a2 + hstep, voffA);
            PG8_WAIT_L(8); PG8_BAR; PG8_WAIT_L(0); PG8_MMA(0, 0, At, B0); PG8_BAR; PG8_SCHED;
            PG8_LDB(B1, 1, 1); PG8_STAGE(PG8_SB(1, 0), b3, voffA);
            PG8_BAR; PG8_WAIT_L(0); PG8_MMA(0, 1, At, B1); PG8_BAR;
            PG8_LDA(At, 1, 1); PG8_STAGE(PG8_SA(1, 0), a3, voffA);
            PG8_BAR; PG8_WAIT_L(0); PG8_MMA(1, 0, At, B0); PG8_BAR; PG8_SCHED;
            PG8_STAGE(PG8_SB(1, 1), b3 + hstep, voffA);
            PG8_WAIT_V(6); PG8_BAR; PG8_MMA(1, 1, At, B1); PG8_BAR;
        }
        E(acc, cur, wr, wc, fr, fq);
        if (!has_next) break;
#pragma unroll
        for (int a = 0; a < 2; ++a)
#pragma unroll
            for (int b = 0; b < 2; ++b)
#pragma unroll
                for (int m = 0; m < 4; ++m)
#pragma unroll
                    for (int n = 0; n < 2; ++n) acc[a][b][m][n] = (f32x4){0.f, 0.f, 0.f, 0.f};
        cur = nxt; cA = nA; cB = nB; ++ui;
    }
    PG8_WAIT_V(0);
    if (wr == 0) PG8_BAR;
    PG8_BAR;
#undef PG8_SA
#undef PG8_SB
#undef PG8_STAGE
#undef PG8_LDA
#undef PG8_LDB
#undef PG8_MMA
#undef PG8_WAIT_V
#undef PG8_WAIT_L
#undef PG8_BAR
#undef PG8_SCHED
}
}
using pg8::Unit;

struct EpiU {
    bf16_t* U; bf16_t* UH;
    __device__ __forceinline__ void operator()(const f32x4 (&acc)[2][2][4][2], const Unit& u, int wr, int wc, int fr, int fq) const {
#pragma unroll
        for (int ai = 0; ai < 2; ++ai)
#pragma unroll
            for (int m = 0; m < 4; ++m) {
                const int row = u.pm * 256 + ai * 128 + wr * 64 + m * 16 + fr;
#pragma unroll
                for (int bj = 0; bj < 2; ++bj)
#pragma unroll
                    for (int n = 0; n < 2; ++n) {
                        const int c = u.pn * 256 + bj * 128 + wc * 32 + n * 16 + 4 * fq;
                        const f32x4 v = acc[ai][bj][m][n];
                        if (c >= D_IN) continue;
                        if (c < 648 || c >= 1416) {
                            const int uc = c < 648 ? c : c - 768;
                            u32x2 w; w.x = pk2(v[0], v[1]); w.y = pk2(v[2], v[3]);
                            *(u32x2*)(U + (size_t)row * UW + uc) = w;
                        } else {
                            const int hc = c - 648;
#pragma unroll
                            for (int j = 0; j < 4; ++j) UH[(size_t)(hc + j) * MTOT + row] = f2bf(v[j]);
                        }
                    }
            }
    }
};
struct EpiRes {
    const float* oldL; const float* oldC; float* newL; float* newC; const float* gate;
    __device__ __forceinline__ void operator()(const f32x4 (&acc)[2][2][4][2], const Unit& u, int wr, int wc, int fr, int fq) const {
        const bool lat = u.pm < MLAT / 256;
        const float* gp = gate + (size_t)(lat ? (u.pm >> 3) : 16) * 6144;
#pragma unroll
        for (int bj = 0; bj < 2; ++bj) {
            f32x4 gt[2];
#pragma unroll
            for (int n = 0; n < 2; ++n) gt[n] = *(const f32x4*)(gp + u.pn * 256 + bj * 128 + wc * 32 + n * 16 + 4 * fq);
#pragma unroll
            for (int ai = 0; ai < 2; ++ai) {
                f32x4 o[4][2];
#pragma unroll
                for (int m = 0; m < 4; ++m) {
                    const int row = u.pm * 256 + ai * 128 + wr * 64 + m * 16 + fr;
                    const float* op = lat ? oldL + (size_t)row * DM : oldC + (size_t)(row - MLAT) * DM;
#pragma unroll
                    for (int n = 0; n < 2; ++n) o[m][n] = *(const f32x4*)(op + u.pn * 256 + bj * 128 + wc * 32 + n * 16 + 4 * fq);
                }
#pragma unroll
                for (int m = 0; m < 4; ++m) {
                    const int row = u.pm * 256 + ai * 128 + wr * 64 + m * 16 + fr;
                    float* np = lat ? newL + (size_t)row * DM : newC + (size_t)(row - MLAT) * DM;
#pragma unroll
                    for (int n = 0; n < 2; ++n) *(f32x4*)(np + u.pn * 256 + bj * 128 + wc * 32 + n * 16 + 4 * fq) = o[m][n] + gt[n] * acc[ai][bj][m][n];
                }
            }
        }
    }
};
struct EpiSwiglu {
    bf16_t* Act;
    __device__ __forceinline__ void operator()(const f32x4 (&acc)[2][2][4][2], const Unit& u, int wr, int wc, int fr, int fq) const {
#pragma unroll
        for (int ai = 0; ai < 2; ++ai)
#pragma unroll
            for (int m = 0; m < 4; ++m) {
                const int row = u.pm * 256 + ai * 128 + wr * 64 + m * 16 + fr;
#pragma unroll
                for (int bj = 0; bj < 2; ++bj) {
                    const int G = u.pn * 128 + bj * 64 + wc * 16 + 4 * fq;
                    const f32x4 g = acc[ai][bj][m][0], up = acc[ai][bj][m][1];
                    u32x2 w; w.x = pk2(siluf_(g[0]) * up[0], siluf_(g[1]) * up[1]); w.y = pk2(siluf_(g[2]) * up[2], siluf_(g[3]) * up[3]);
                    *(u32x2*)(Act + (size_t)row * DFF + G) = w;
                }
            }
    }
};


struct EpiResN {
    const float* oldL; const float* oldC; float* newL; float* newC; const float* gate; const float* g2; const float* scale2; bf16_t* A2; float* ssq;
    __device__ __forceinline__ void operator()(const f32x4 (&acc)[2][2][4][2], const Unit& u, int wr, int wc, int fr, int fq) const {
        const bool lat = u.pm < MLAT / 256;
        const int r = lat ? (u.pm >> 3) : 16;
        const float* gp = gate + (size_t)r * 6144; const float* sp = scale2 + (size_t)r * 6144;
#pragma unroll
        for (int bj = 0; bj < 2; ++bj) {
            f32x4 gt[2], gs[2];
#pragma unroll
            for (int n = 0; n < 2; ++n) { const int c = u.pn * 256 + bj * 128 + wc * 32 + n * 16 + 4 * fq;
                gt[n] = *(const f32x4*)(gp + c); gs[n] = *(const f32x4*)(g2 + c) * (*(const f32x4*)(sp + c) + 1.f); }
#pragma unroll
            for (int ai = 0; ai < 2; ++ai) {
                f32x4 o[4][2];
#pragma unroll
                for (int m = 0; m < 4; ++m) {
                    const int row = u.pm * 256 + ai * 128 + wr * 64 + m * 16 + fr;
                    const float* op = lat ? oldL + (size_t)row * DM : oldC + (size_t)(row - MLAT) * DM;
#pragma unroll
                    for (int n = 0; n < 2; ++n) o[m][n] = *(const f32x4*)(op + u.pn * 256 + bj * 128 + wc * 32 + n * 16 + 4 * fq);
                }
#pragma unroll
                for (int m = 0; m < 4; ++m) {
                    const int row = u.pm * 256 + ai * 128 + wr * 64 + m * 16 + fr;
                    float* np = lat ? newL + (size_t)row * DM : newC + (size_t)(row - MLAT) * DM;
                    float ss = 0.f;
#pragma unroll
                    for (int n = 0; n < 2; ++n) {
                        const int c = u.pn * 256 + bj * 128 + wc * 32 + n * 16 + 4 * fq;
                        const f32x4 hn = o[m][n] + gt[n] * acc[ai][bj][m][n];
                        *(f32x4*)(np + c) = hn;
                        ss += hn.x * hn.x + hn.y * hn.y + hn.z * hn.z + hn.w * hn.w;
                        const f32x4 a2 = hn * gs[n];
                        u32x2 w; w.x = pk2(a2.x, a2.y); w.y = pk2(a2.z, a2.w);
                        *(u32x2*)(A2 + (size_t)row * DM + c) = w;
                    }
                    ss += __shfl_xor(ss, 16); ss += __shfl_xor(ss, 32);
                    if (fq == 0) atomicAdd(ssq + row, ss);
                }
            }
        }
    }
};
struct EpiSwigluN {
    bf16_t* Act; const float* ssq; const float* sw;
    __device__ __forceinline__ void operator()(const f32x4 (&acc)[2][2][4][2], const Unit& u, int wr, int wc, int fr, int fq) const {
        const int r = u.pm < MLAT / 256 ? (u.pm >> 3) : 16;
        f32x4 swg[2], swu[2];
#pragma unroll
        for (int bj = 0; bj < 2; ++bj) { const int G = u.pn * 128 + bj * 64 + wc * 16 + 4 * fq; swg[bj] = *(const f32x4*)(sw + (size_t)r * 2 * DFF + G); swu[bj] = *(const f32x4*)(sw + (size_t)r * 2 * DFF + DFF + G); }
        float rs[2][4];
#pragma unroll
        for (int ai = 0; ai < 2; ++ai)
#pragma unroll
            for (int m = 0; m < 4; ++m) rs[ai][m] = ssq[u.pm * 256 + ai * 128 + wr * 64 + m * 16 + fr];
#pragma unroll
        for (int ai = 0; ai < 2; ++ai)
#pragma unroll
            for (int m = 0; m < 4; ++m) {
                const int row = u.pm * 256 + ai * 128 + wr * 64 + m * 16 + fr;
                const float rstd = rsqrtf(rs[ai][m] * (1.f / DM) + 1e-6f);
#pragma unroll
                for (int bj = 0; bj < 2; ++bj) {
                    const int G = u.pn * 128 + bj * 64 + wc * 16 + 4 * fq;
                    const f32x4 g = acc[ai][bj][m][0] * rstd + swg[bj], up = acc[ai][bj][m][1] * rstd + swu[bj];
                    u32x2 w; w.x = pk2(siluf_(g[0]) * up[0], siluf_(g[1]) * up[1]); w.y = pk2(siluf_(g[2]) * up[2], siluf_(g[3]) * up[3]);
                    *(u32x2*)(Act + (size_t)row * DFF + G) = w;
                }
            }
    }
};

struct EpiUN {
    bf16_t* U; bf16_t* UH; const float* ssq; const float* sw;
    __device__ __forceinline__ void operator()(const f32x4 (&acc)[2][2][4][2], const Unit& u, int wr, int wc, int fr, int fq) const {
        const int r = u.pm < MLAT / 256 ? (u.pm >> 3) : 16;
        f32x4 swv[2][2]; float rs[2][4];
#pragma unroll
        for (int bj = 0; bj < 2; ++bj)
#pragma unroll
            for (int n = 0; n < 2; ++n) swv[bj][n] = *(const f32x4*)(sw + (size_t)r * NIN + u.pn * 256 + bj * 128 + wc * 32 + n * 16 + 4 * fq);
#pragma unroll
        for (int ai = 0; ai < 2; ++ai)
#pragma unroll
            for (int m = 0; m < 4; ++m) rs[ai][m] = ssq[u.pm * 256 + ai * 128 + wr * 64 + m * 16 + fr];
#pragma unroll
        for (int ai = 0; ai < 2; ++ai)
#pragma unroll
            for (int m = 0; m < 4; ++m) {
                const int row = u.pm * 256 + ai * 128 + wr * 64 + m * 16 + fr;
                const float rstd = rsqrtf(rs[ai][m] * (1.f / DM) + 1e-6f);
#pragma unroll
                for (int bj = 0; bj < 2; ++bj)
#pragma unroll
                    for (int n = 0; n < 2; ++n) {
                        const int c = u.pn * 256 + bj * 128 + wc * 32 + n * 16 + 4 * fq;
                        const f32x4 v = acc[ai][bj][m][n] * rstd + swv[bj][n];
                        if (c >= D_IN) continue;
                        if (c < 648 || c >= 1416) {
                            const int uc = c < 648 ? c : c - 768;
                            u32x2 w; w.x = pk2(v[0], v[1]); w.y = pk2(v[2], v[3]);
                            *(u32x2*)(U + (size_t)row * UW + uc) = w;
                        } else {
                            const int hc = c - 648;
#pragma unroll
                            for (int j = 0; j < 4; ++j) UH[(size_t)(hc + j) * MTOT + row] = f2bf(v[j]);
                        }
                    }
            }
    }
};
template <class F>
__device__ __forceinline__ void transpose_item(const float* W, int K, int N, bf16_t* WT, LAS float* scr, int item, int nblk, int lane, F srccol) {
    const int kb = item / nblk, nb = item % nblk, k0 = 64 * kb, n0 = 32 * nb;
    const int sc = srccol(n0 + (lane & 31));
    float tv[32];
#pragma unroll
    for (int i = 0; i < 32; ++i) { const int kk = 2 * i + (lane >> 5); tv[i] = W[(size_t)(k0 + kk) * N + (sc >= 0 ? sc : 0)]; }
#pragma unroll
    for (int i = 0; i < 32; ++i) { const int kk = 2 * i + (lane >> 5); scr[kk * 33 + (lane & 31)] = sc >= 0 ? tv[i] : 0.f; }
    WAVE_SYNC();
    const int c = lane & 7;
#pragma unroll
    for (int j = 0; j < 4; ++j) { const int n = (lane >> 3) + 8 * j; const LAS float* s = scr + (8 * c) * 33 + n;
        u32x4 o; o.x = pk2(s[0 * 33], s[1 * 33]); o.y = pk2(s[2 * 33], s[3 * 33]); o.z = pk2(s[4 * 33], s[5 * 33]); o.w = pk2(s[6 * 33], s[7 * 33]);
        *(u32x4*)(WT + (size_t)(n0 + n) * K + k0 + 8 * c) = o; }
    WAVE_SYNC();
}

__device__ __forceinline__ void p0_weights(const PV& P, LAS unsigned char* lds, int gw, int ngw, int wave, int lane, int it_lo, int it_hi) {
    LAS float* scr = (LAS float*)(lds + wave * 8704);
    constexpr int I_IN = 16 * 88, I_OUT = 16 * 32, I_UP = 16 * 176, I_DN = 44 * 32, I_GLU = 4 * 8, I_LAYER = I_IN + I_OUT + I_UP + I_DN + I_GLU;
    for (int it = it_lo + gw; it < it_hi; it += ngw) {
        const int l = it / I_LAYER; int r = it % I_LAYER;
        if (r < I_IN) { transpose_item(P.in_(I_WIN) + (size_t)l * DM * D_IN, DM, D_IN, (bf16_t*)(P.ws_() + WS_WIN) + (size_t)l * NIN * DM, scr, r, 88, lane, [](int n) { return n < D_IN ? n : -1; }); continue; } r -= I_IN;
        if (r < I_OUT) { transpose_item(P.in_(I_WOUT) + (size_t)l * DM * DM, DM, DM, (bf16_t*)(P.ws_() + WS_WOUT) + (size_t)l * DM * DM, scr, r, 32, lane, [](int n) { return n; }); continue; } r -= I_OUT;
        if (r < I_UP) { transpose_item(P.in_(I_FUP) + (size_t)l * DM * 2 * DFF, DM, 2 * DFF, (bf16_t*)(P.ws_() + WS_WUP) + (size_t)l * 2 * DFF * DM, scr, r, 176, lane,
                                       [](int n) { const int q = n >> 5, rem = n & 31, G = q * 16 + (rem & 15); return rem < 16 ? G : DFF + G; }); continue; } r -= I_UP;
        if (r < I_DN) { transpose_item(P.in_(I_FDN) + (size_t)l * DFF * DM, DFF, DM, (bf16_t*)(P.ws_() + WS_WDN) + (size_t)l * DM * DFF, scr, r, 32, lane, [](int n) { return n; }); continue; } r -= I_DN;
        transpose_item(P.in_(I_5GW) + (size_t)l * 256 * 256, 256, 256, (bf16_t*)(P.ws_() + WS_WGLU) + (size_t)l * 256 * 256, scr, r, 8, lane, [](int n) { return n; });
    }
}

__device__ __forceinline__ void p0_mod(const PV& P, LAS unsigned char* lds, int blk, int nblk) {
    LAS float* sc = (LAS float*)lds;
    LAS float* red = (LAS float*)(lds + 17 * 1024 * 4);
    const int tid = P.tid;
    bool loaded = false;
    for (int it = blk; it < 192; it += nblk) {
        if (!loaded) {
            for (int i = tid; i < 17 * 1024; i += 512) { const float v = i < 16 * 1024 ? P.in_(I_C)[i] : P.in_(I_CCTX)[i - 16 * 1024]; sc[i] = siluf_(v); }
            loaded = true;
        }
        __syncthreads();
        const int l = it / 96, j0 = (it % 96) * 64, col = tid & 63, ks = tid >> 6;
        const float* w = P.in_(I_MODW) + (size_t)l * DM * 6144 + j0 + col;
        float a[17];
#pragma unroll
        for (int r = 0; r < 17; ++r) a[r] = 0.f;
#pragma unroll 1
        for (int k0 = ks * 128; k0 < ks * 128 + 128; k0 += 16) {
            float wv[16];
#pragma unroll
            for (int u = 0; u < 16; ++u) wv[u] = w[(size_t)(k0 + u) * 6144];
#pragma unroll
            for (int u = 0; u < 16; ++u)
#pragma unroll
                for (int r = 0; r < 17; ++r) a[r] += sc[r * 1024 + k0 + u] * wv[u];
        }
#pragma unroll
        for (int r = 0; r < 17; ++r) red[(ks * 17 + r) * 64 + col] = a[r];
        __syncthreads();
        for (int i = tid; i < 17 * 64; i += 512) {
            const int r = i >> 6, c = i & 63; float s = 0.f;
#pragma unroll
            for (int k = 0; k < 8; ++k) s += red[(k * 17 + r) * 64 + c];
            ((float*)(P.ws_() + WS_MOD))[((size_t)l * 17 + r) * 6144 + j0 + c] = s + P.in_(I_MODB)[(size_t)l * 6144 + j0 + c];
        }
    }
    __syncthreads();
}

__device__ __forceinline__ void p0_filter(const PV& P, LAS unsigned char* lds, int blk, int nblk, int it_lo, int it_hi) {
    LAS float* feats = (LAS float*)lds;
    LAS float* h1 = feats + 32 * 33;
    LAS float* h2 = h1 + 32 * 65;
    const int tid = P.tid, pl = tid & 31, part = tid >> 5;
    for (int it2 = 2 * it_lo + blk; it2 < 2 * it_hi; it2 += nblk) {
        const int it = it2 >> 1, half = it2 & 1;
        int l, kind, pb;
        if (it < 64) { l = 0; kind = 0; pb = it; } else if (it < 72) { l = 0; kind = 1; pb = it - 64; } else { l = 1; kind = 0; pb = it - 72; }
        const int L = kind ? CTX : SEQ, pos = pb * 32 + pl;
        const float tt = (float)pos / (float)(L - 1);
        const float w = (6.283185307179586f * (float)pos) / (float)L;
        __syncthreads();
        {
            const float band = 1e-4f + (float)part * ((15.0f - 1e-4f) / 15.0f);
            float sn, cs; sincosf(band * w, &sn, &cs);
            feats[pl * 33 + 1 + part] = cs; feats[pl * 33 + 17 + part] = -sn;
            if (part == 0) feats[pl * 33] = tt;
        }
        __syncthreads();
        const float* w1 = P.in_(I_HW1) + (size_t)l * 33 * 64; const float* b1 = P.in_(I_HB1) + l * 64; const float* fq = P.in_(I_HFREQ) + l * 64;
        const float* w2 = P.in_(I_HW2) + (size_t)l * 64 * 64; const float* b2 = P.in_(I_HB2) + l * 64; const float* w3 = P.in_(I_HW3) + (size_t)l * 64 * 1024;
        {
            float a[4];
#pragma unroll
            for (int o = 0; o < 4; ++o) a[o] = b1[part * 4 + o];
#pragma unroll 1
            for (int f0 = 0; f0 < 33; f0 += 11) {
                f32x4 wv[11];
#pragma unroll
                for (int u = 0; u < 11; ++u) wv[u] = *(const f32x4*)(w1 + (f0 + u) * 64 + part * 4);
#pragma unroll
                for (int u = 0; u < 11; ++u) { const float fv = feats[pl * 33 + f0 + u]; a[0] += fv * wv[u].x; a[1] += fv * wv[u].y; a[2] += fv * wv[u].z; a[3] += fv * wv[u].w; }
            }
#pragma unroll
            for (int o = 0; o < 4; ++o) h1[pl * 65 + part * 4 + o] = sinf(fq[part * 4 + o] * a[o]);
        }
        __syncthreads();
        {
            float a[4];
#pragma unroll
            for (int o = 0; o < 4; ++o) a[o] = b2[part * 4 + o];
#pragma unroll 1
            for (int k0 = 0; k0 < 64; k0 += 16) {
                f32x4 wv[16];
#pragma unroll
                for (int u = 0; u < 16; ++u) wv[u] = *(const f32x4*)(w2 + (k0 + u) * 64 + part * 4);
#pragma unroll
                for (int u = 0; u < 16; ++u) { const float hv = h1[pl * 65 + k0 + u]; a[0] += hv * wv[u].x; a[1] += hv * wv[u].y; a[2] += hv * wv[u].z; a[3] += hv * wv[u].w; }
            }
#pragma unroll
            for (int o = 0; o < 4; ++o) h2[pl * 65 + part * 4 + o] = sinf(fq[part * 4 + o] * a[o]);
        }
        __syncthreads();
        const int dir = part >> 3, order = (part >> 2) & 1;
        float* G = kind ? (float*)(P.ws_() + WS_GCTX) : (float*)(P.ws_() + WS_GLAT) + (size_t)l * 2 * 256 * 4096;
        const int GL = 2 * L;
        const float min_decay = -3.0701134573253945f, max_decay = -15.350567286626972f;
#pragma unroll 1
        for (int ps = 2 * half; ps < 2 * half + 2; ++ps) {
            float a[16];
#pragma unroll
            for (int o = 0; o < 16; ++o) a[o] = 0.f;
            const int c0 = part * 64 + ps * 16;
#pragma unroll 1
            for (int k0 = 0; k0 < 64; k0 += 4) {
                f32x4 wv[4][4];
#pragma unroll
                for (int u = 0; u < 4; ++u)
#pragma unroll
                    for (int q = 0; q < 4; ++q) wv[u][q] = ((const f32x4*)(w3 + (size_t)(k0 + u) * 1024 + c0))[q];
#pragma unroll
                for (int u = 0; u < 4; ++u) { const float hv = h2[pl * 65 + k0 + u];
#pragma unroll
                    for (int q = 0; q < 4; ++q) { a[4 * q] += hv * wv[u][q].x; a[4 * q + 1] += hv * wv[u][q].y; a[4 * q + 2] += hv * wv[u][q].z; a[4 * q + 3] += hv * wv[u][q].w; } }
            }
#pragma unroll
            for (int o = 0; o < 16; ++o) {
                const int col = c0 + o, ch = col & 255;
                const float delta = fabsf(min_decay + (float)col * ((max_decay - min_decay) / 1023.0f));
                float val = a[o] * expf(-tt * delta);
                int x = dir == 0 ? L - pos : L + pos;
                if (dir == 1 && pos == 0) { x = 0; val = 0.f; }
                G[(size_t)(order * 256 + ch) * GL + x] = val;
            }
        }
    }
    __syncthreads();
}

__device__ __forceinline__ void p0_s5(const PV& P, int gw, int ngw, int lane, int it_lo, int it_hi) {
    for (int it = it_lo + gw; it < it_hi; it += ngw) {
        const int l = it >> 5, dir = (it >> 4) & 1, g = it & 15, p = lane;
        const int idx = ((l * 2 + dir) * 16 + g);
        const float dt = expf(P.in_(I_5LDT)[idx]);
        const float are = P.in_(I_5ARE)[idx * 64 + p], aim = P.in_(I_5AIM)[idx * 64 + p];
        const float mag = expf(are * dt); float sn, cs; sincosf(aim * dt, &sn, &cs);
        const float abr = mag * cs, abi = mag * sn, den = are * are + aim * aim;
        const float zr = ((abr - 1.f) * are + abi * aim) / den, zi = (abi * are - (abr - 1.f) * aim) / den;
        ((f32x2*)(P.ws_() + WS_S5AB))[idx * 64 + p] = (f32x2){abr, abi};
        bf16_t* bb = (bf16_t*)(P.ws_() + WS_S5BB) + (size_t)idx * 128 * 16;
        const float* bre = P.in_(I_5BRE) + ((size_t)(l * 16 + g) * 64 + p) * 16; const float* bim = P.in_(I_5BIM) + ((size_t)(l * 16 + g) * 64 + p) * 16;
        for (int c = 0; c < 16; ++c) {
            const float br = bre[c], bi = bim[c];
            bb[p * 16 + c] = f2bf(zr * br - zi * bi);
            bb[(64 + p) * 16 + c] = f2bf(zr * bi + zi * br);
        }
        bf16_t* cm = (bf16_t*)(P.ws_() + WS_S5CM) + (size_t)idx * 16 * 128;
        for (int c = 0; c < 16; ++c) {
            cm[c * 128 + p] = f2bf(P.in_(I_5CRE)[((size_t)idx * 16 + c) * 64 + p]);
            cm[c * 128 + 64 + p] = f2bf(-P.in_(I_5CIM)[((size_t)idx * 16 + c) * 64 + p]);
        }
    }
}

__device__ __forceinline__ void norm_phase(const PV& P, int l, int which, int M, int gw, int ngw, int lane) {
    const float* gam = P.in_(which == 1 ? I_N1G : I_N2G) + l * DM;
    const float* mod = (const float*)(P.ws_() + WS_MOD) + (size_t)l * 17 * 6144;
    const int so = which == 1 ? 0 : 3 * DM, co = which == 1 ? DM : 4 * DM;
    const bool from_in = (l == 0 && which == 1);
    bf16_t* Xn = (bf16_t*)(P.ws_() + WS_XN);
    constexpr int NR = 3;
    auto row_src = [&](int row) __attribute__((always_inline)) {
        const bool lat = row < MLAT;
        return lat ? (from_in ? P.in_(I_X) : P.out_()) + (size_t)row * DM : (from_in ? P.in_(I_CTX) : (const float*)(P.ws_() + WS_HC)) + (size_t)(row - MLAT) * DM;
    };
    f32x4 nx[NR][4];
#pragma unroll
    for (int q = 0; q < NR; ++q) { const int rr = gw + q * ngw; const float* src = row_src(rr < M ? rr : gw);
#pragma unroll
        for (int j = 0; j < 4; ++j) nx[q][j] = *(const f32x4*)(src + 4 * lane + 256 * j); }
    for (int row0 = gw; row0 < M; row0 += NR * ngw) {
        f32x4 v[NR][4]; float ss[NR];
#pragma unroll
        for (int q = 0; q < NR; ++q)
#pragma unroll
            for (int j = 0; j < 4; ++j) v[q][j] = nx[q][j];
        const int nrow0 = row0 + NR * ngw;
        if (nrow0 < M) {
#pragma unroll
            for (int q = 0; q < NR; ++q) { const int rr = nrow0 + q * ngw; const float* src = row_src(rr < M ? rr : nrow0);
#pragma unroll
                for (int j = 0; j < 4; ++j) nx[q][j] = *(const f32x4*)(src + 4 * lane + 256 * j); }
        }
#pragma unroll
        for (int q = 0; q < NR; ++q) { float s_ = 0.f;
#pragma unroll
            for (int j = 0; j < 4; ++j) s_ += v[q][j].x * v[q][j].x + v[q][j].y * v[q][j].y + v[q][j].z * v[q][j].z + v[q][j].w * v[q][j].w;
            ss[q] = s_; }
#pragma unroll
        for (int q = 0; q < NR; ++q) {
            const int row = row0 + q * ngw;
            if (row < M) {
                const bool lat = row < MLAT;
                const float* mr = mod + (size_t)(lat ? (row >> 11) : 16) * 6144;
                const float rstd = rsqrtf(wave_sum(ss[q]) * (1.f / DM) + 1e-6f);
#pragma unroll
                for (int j = 0; j < 4; ++j) {
                    const int c = 4 * lane + 256 * j;
                    const f32x4 g = *(const f32x4*)(gam + c), sh = *(const f32x4*)(mr + so + c), sc = *(const f32x4*)(mr + co + c);
                    const f32x4 y = (v[q][j] * rstd * g) * (sc + 1.f) + sh;
                    u32x2 w; w.x = pk2(y.x, y.y); w.y = pk2(y.z, y.w);
                    *(u32x2*)(Xn + (size_t)row * DM + c) = w;
                }
            }
        }
    }
}

__device__ __forceinline__ void conv8(const bf16_t* Urow, bool hasPrev, bool hasNext, const float* w, int ws, const float* b, float* out) {
    float c0[8], cm[8], cp[8];
    unpack8(*(const u32x4*)Urow, c0);
    if (hasPrev) unpack8(*(const u32x4*)(Urow - UW), cm); else {
#pragma unroll
        for (int e = 0; e < 8; ++e) cm[e] = 0.f; }
    if (hasNext) unpack8(*(const u32x4*)(Urow + UW), cp); else {
#pragma unroll
        for (int e = 0; e < 8; ++e) cp[e] = 0.f; }
#pragma unroll
    for (int e = 0; e < 8; ++e) out[e] = b[e] + w[e] * cm[e] + w[ws + e] * c0[e] + w[2 * ws + e] * cp[e];
}


__device__ __forceinline__ void xbc_prepass(const PV& P, int l, int blk, int nblk) {
    const bf16_t* U = (const bf16_t*)(P.ws_() + WS_U); bf16_t* X = (bf16_t*)(P.ws_() + WS_XBC);
    const float* cw = P.in_(I_SCW) + (size_t)l * 3 * 384; const float* cb = P.in_(I_SCB) + (size_t)l * 384;
    const int c = (P.tid % 48) * 8, rsub = P.tid / 48;
    if (rsub >= 10) return;
    float w0[8], w1[8], w2[8], b8[8];
#pragma unroll
    for (int e = 0; e < 8; ++e) { w0[e] = cw[c + e]; w1[e] = cw[384 + c + e]; w2[e] = cw[768 + c + e]; b8[e] = cb[c + e]; }
    const int step = 2 * nblk * 10;
    auto row_of = [&](int rr, int fallback) __attribute__((always_inline)) { return rr < MTOT ? rr : fallback; };
    u32x4 nx[2][3];
    {
#pragma unroll
        for (int q = 0; q < 2; ++q) {
            const int row = row_of(blk * 10 + rsub + q * nblk * 10, blk * 10 + rsub);
            const bool lat = row < MLAT; const int t = lat ? (row & 2047) : ((row - MLAT) & 255); const bool hp = t > 0, hn = t < (lat ? SEQ : CTX) - 1;
            const bf16_t* Ur = U + (size_t)row * UW + UC_X + c;
            nx[q][1] = *(const u32x4*)Ur; nx[q][0] = *(const u32x4*)(Ur - (hp ? UW : 0)); nx[q][2] = *(const u32x4*)(Ur + (hn ? UW : 0));
        }
    }
    for (int row0 = blk * 10 + rsub; row0 < MTOT; row0 += step) {
        u32x4 r[2][3];
#pragma unroll
        for (int q = 0; q < 2; ++q)
#pragma unroll
            for (int k = 0; k < 3; ++k) r[q][k] = nx[q][k];
        if (row0 + step < MTOT) {
#pragma unroll
            for (int q = 0; q < 2; ++q) {
                const int row = row_of(row0 + step + q * nblk * 10, row0 + step);
                const bool lat = row < MLAT; const int t = lat ? (row & 2047) : ((row - MLAT) & 255); const bool hp = t > 0, hn = t < (lat ? SEQ : CTX) - 1;
                const bf16_t* Ur = U + (size_t)row * UW + UC_X + c;
                nx[q][1] = *(const u32x4*)Ur; nx[q][0] = *(const u32x4*)(Ur - (hp ? UW : 0)); nx[q][2] = *(const u32x4*)(Ur + (hn ? UW : 0));
            }
        }
#pragma unroll
        for (int q = 0; q < 2; ++q) {
            const int rr = row0 + q * nblk * 10; const bool ok = rr < MTOT; const int row = ok ? rr : row0;
            const bool lat = row < MLAT; const int t = lat ? (row & 2047) : ((row - MLAT) & 255); const bool hp = t > 0, hn = t < (lat ? SEQ : CTX) - 1;
            float xm[8], x0[8], xp[8], o[8];
            unpack8(r[q][0], xm); unpack8(r[q][1], x0); unpack8(r[q][2], xp);
#pragma unroll
            for (int e = 0; e < 8; ++e) o[e] = siluf_(b8[e] + w0[e] * (hp ? xm[e] : 0.f) + w1[e] * x0[e] + w2[e] * (hn ? xp[e] : 0.f));
            if (ok) *(u32x4*)(X + (size_t)row * 384 + c) = pack8(o);
        }
    }
}

constexpr int SC_QS = 0, SC_KS = 18432, SC_KT = 36864, SC_VT = 54272, SC_PM = 71680, SC_HT = 106496, SC_CS = 115712, SC_LA = 119808, SC_ROPE = 120320;
__device__ __forceinline__ void scan_item(const PV& P, LAS unsigned char* lds, int l, int kind, int b, int h, int dir) {
    const int tid = P.tid, lane = tid & 63, w = __builtin_amdgcn_readfirstlane(tid >> 6), fr = lane & 15, fq = lane >> 4;
    LAS bf16_t* Qs = (LAS bf16_t*)(lds + SC_QS); LAS bf16_t* Ks = (LAS bf16_t*)(lds + SC_KS); LAS bf16_t* Kt = (LAS bf16_t*)(lds + SC_KT);
    LAS bf16_t* Vt = (LAS bf16_t*)(lds + SC_VT); LAS bf16_t* Pm = (LAS bf16_t*)(lds + SC_PM); LAS bf16_t* Ht = (LAS bf16_t*)(lds + SC_HT);
    LAS float* cs_all = (LAS float*)(lds + SC_CS); LAS float* la = (LAS float*)(lds + SC_LA); LAS float* rope = (LAS float*)(lds + SC_ROPE);
    const bf16_t* U = (const bf16_t*)(P.ws_() + WS_U); const bf16_t* XBC = (const bf16_t*)(P.ws_() + WS_XBC);
    bf16_t* Y = (bf16_t*)(P.ws_() + WS_Y) + (size_t)((kind ? 2 : 0) + dir) * MTOT * 256;
    __syncthreads();
    for (int i = tid; i < 64 * 36; i += 512) ((LAS unsigned*)Ht)[i] = 0u;
    float a_dir = 0.f, dtb = 0.f;
    if (kind == 0) { a_dir = -expf(P.in_(I_SALOG)[(l * 2 + dir) * 4 + h]); dtb = P.in_(I_SDTB)[(l * 2 + dir) * 4 + h]; }
    else {
        a_dir = -expf(P.in_(I_RDEC)[(l * 2 + dir) * 4 + h]);
        for (int i = tid; i < 64 * 16; i += 512) { const int pos = i >> 4, fi = i & 15; const float inv = powf(10000.0f, -(float)fi / 16.0f); float sn, c; sincosf((float)pos * inv, &sn, &c); rope[i] = c; rope[1024 + i] = sn; }
    }
    const float* cw = P.in_(I_SCW) + (size_t)l * 3 * 384; const float* cb = P.in_(I_SCB) + (size_t)l * 384;
    f32x4 hacc[2] = {(f32x4){0.f, 0.f, 0.f, 0.f}, (f32x4){0.f, 0.f, 0.f, 0.f}};
    __syncthreads();
#define SC_DECL(IT) u32x4 rw##IT##a = {0u, 0u, 0u, 0u}, rw##IT##b = {0u, 0u, 0u, 0u}, rw##IT##c = {0u, 0u, 0u, 0u};
    SC_DECL(0) SC_DECL(1) SC_DECL(2) SC_DECL(3) SC_DECL(4) SC_DECL(5)
    bf16_t dtr0 = 0, dtr1 = 0;
#define SC_ISSUE(IT) { \
        const int k2 = (IT) & 1, mat = (IT) >> 1; \
        const int vi = tid + 512 * k2, i = vi >> 3, c8 = (vi & 7) * 8; \
        const int t = dir == 0 ? g_c0 + i : g_c0 + 127 - i; \
        const bf16_t* Ur = U + (size_t)(g_tokbase + t) * UW; \
        if (kind == 0) { \
            const int xcol = (mat == 0 ? h * 64 : (mat == 1 ? 256 : 320)) + c8; \
            rw##IT##a = *(const u32x4*)(XBC + (size_t)(g_tokbase + t) * 384 + xcol); \
            if (mat == 1) { if (k2 == 0) dtr0 = Ur[UC_DT + dir * 4 + h]; else dtr1 = Ur[UC_DT + dir * 4 + h]; } \
        } else { \
            const int ucol = (mat == 0 ? UC_V : (mat == 1 ? UC_K : UC_Q)) + h * 64; \
            rw##IT##a = *(const u32x4*)(Ur + ucol + c8); \
            if (mat != 0) rw##IT##b = *(const u32x4*)(Ur + ucol + (((c8 & 31) < 16) ? c8 + 16 : c8 - 16)); \
        } }
#define SC_ISSUE_ALL(CK) { \
        const int ck_ = (CK); const bool g_isctx = ck_ < 2; \
        const int g_Ls = g_isctx ? CTX : SEQ, g_nck = g_isctx ? 2 : 16, g_cidx = g_isctx ? ck_ : ck_ - 2; \
        const int g_c0 = (dir == 0 ? g_cidx : g_nck - 1 - g_cidx) * 128, g_tokbase = g_isctx ? MLAT + b * CTX : b * SEQ; \
        SC_ISSUE(0) SC_ISSUE(1) SC_ISSUE(2) SC_ISSUE(3) SC_ISSUE(4) SC_ISSUE(5) }
#define SC_PROC(IT) { \
        const int k2 = (IT) & 1, mat = (IT) >> 1; \
        const int vi = tid + 512 * k2, i = vi >> 3, c8 = (vi & 7) * 8; \
        const int t = dir == 0 ? c0 + i : c0 + 127 - i; \
        float x[8]; \
        if (kind == 0) { \
            unpack8(rw##IT##a, x); \
            if (mat == 1) { \
                const float dt = softplusf_(bf2f(k2 == 0 ? dtr0 : dtr1) + dtb); \
                _Pragma("unroll") for (int e = 0; e < 8; ++e) x[e] *= dt; \
                if (c8 == 0) la[i] = dt * a_dir; \
            } \
        } else { \
            unpack8(rw##IT##a, x); \
            if (mat != 0 && !isctx) { \
                const int half = c8 >> 5, e32 = c8 & 31; const bool first = e32 < 16; const int fi0 = e32 & 15; \
                float xp[8]; \
                unpack8(rw##IT##b, xp); \
                const int pos = half == 0 ? (t >> 6) : (t & 63); \
                _Pragma("unroll") for (int e = 0; e < 8; ++e) { \
                    const float c = rope[pos * 16 + fi0 + e], sn = rope[1024 + pos * 16 + fi0 + e]; \
                    x[e] = first ? x[e] * c - xp[e] * sn : xp[e] * sn + x[e] * c; } \
            } \
            if (mat == 1) { \
                _Pragma("unroll") for (int e = 0; e < 8; ++e) x[e] *= 0.125f; \
                if (c8 == 0) la[i] = a_dir; \
            } \
        } \
        if (mat == 0) { _Pragma("unroll") for (int e = 0; e < 8; ++e) Vt[(c8 + e) * 136 + (i ^ (c8 & 56))] = f2bf(x[e]); } \
        else if (mat == 1) *(LAS u32x4*)(Ks + i * 72 + c8) = pack8(x); \
        else *(LAS u32x4*)(Qs + i * 72 + c8) = pack8(x); }
    SC_ISSUE_ALL(0)
    for (int ck = 0; ck < 18; ++ck) {
        const bool isctx = ck < 2;
        const int Ls = isctx ? CTX : SEQ, nck = isctx ? 2 : 16, cidx = isctx ? ck : ck - 2;
        const int c0 = (dir == 0 ? cidx : nck - 1 - cidx) * 128;
        const int tokbase = isctx ? MLAT + b * CTX : b * SEQ;
        SC_PROC(0) SC_PROC(1) SC_PROC(2) SC_PROC(3) SC_PROC(4) SC_PROC(5)
#ifdef XP1
        asm volatile("" ::: "memory"); SC_PROC(0) SC_PROC(1) SC_PROC(2) SC_PROC(3) SC_PROC(4) SC_PROC(5)
#endif
        if (ck + 1 < 18) SC_ISSUE_ALL(ck + 1)
        __syncthreads();
        LAS float* cs = cs_all + w * 128;
        {
            const float a0 = la[2 * lane], a1 = la[2 * lane + 1];
            float s = a0 + a1;
#pragma unroll
            for (int o = 1; o < 64; o <<= 1) { const float tv = __shfl_up(s, o); if (lane >= o) s += tv; }
            cs[2 * lane] = s - a1; cs[2 * lane + 1] = s;
        }
        WAVE_SYNC();
        const float cs_end = cs[127];
#pragma unroll 1
        for (int k2 = 0; k2 < 2; ++k2) {
            const int vi = tid + 512 * k2, i = vi >> 3, c8 = (vi & 7) * 8;
            const float te = __expf(cs_end - cs[i]);
            float kv[8]; { const LAS unsigned* kp = (const LAS unsigned*)(Ks + i * 72 + c8); u32x4 kw; kw.x = kp[0]; kw.y = kp[1]; kw.z = kp[2]; kw.w = kp[3]; unpack8(kw, kv); }
#pragma unroll
            for (int e = 0; e < 8; ++e) Kt[(c8 + e) * 136 + (i ^ (c8 & 56))] = f2bf(kv[e] * te);
        }
#pragma unroll 1
        for (int k5 = 0; k5 < 5; ++k5) {
            const int id = w + 8 * k5;
            const int it = (id >= 2) + (id >= 4) + (id >= 8) + (id >= 12) + (id >= 18) + (id >= 24) + (id >= 32);
            const int cb0 = 2 * (id >= 2) + 2 * (id >= 4) + 4 * (id >= 8) + 4 * (id >= 12) + 6 * (id >= 18) + 6 * (id >= 24) + 8 * (id >= 32);
            const int jt = id - cb0, i0t = 16 * it;
            u32x2 pw;
            if (jt <= it) {
                const float csi = cs[i0t + fr];
                f32x4 acc = {0.f, 0.f, 0.f, 0.f};
#pragma unroll
                for (int kk = 0; kk < 2; ++kk) { const bf16x8 kf = *(const LAS bf16x8*)(Ks + (jt * 16 + fr) * 72 + kk * 32 + fq * 8); const bf16x8 qf = *(const LAS bf16x8*)(Qs + (i0t + fr) * 72 + kk * 32 + fq * 8);
                    acc = __builtin_amdgcn_mfma_f32_16x16x32_bf16(kf, qf, acc, 0, 0, 0); }
                const int j = jt * 16 + 4 * fq, i = i0t + fr;
                float pv[4];
#pragma unroll
                for (int r = 0; r < 4; ++r) pv[r] = (j + r <= i) ? acc[r] * __expf(csi - cs[j + r]) : 0.f;
                pw.x = pk2(pv[0], pv[1]); pw.y = pk2(pv[2], pv[3]);
            } else { pw.x = 0u; pw.y = 0u; }
            *(LAS u32x2*)(Pm + (i0t + fr) * 136 + jt * 16 + 4 * fq) = pw;
        }
        __syncthreads();
#pragma unroll
        for (int hh = 0; hh < 2; ++hh) {
            const int it = hh == 0 ? w : 7 - w, i0t = 16 * it;
            const int nk = (it >> 1) + 1;
            const float ecs = __expf(cs[i0t + fr]);
            const int i = i0t + fr, t = dir == 0 ? c0 + i : c0 + 127 - i;
            bf16_t* yrow = Y + (size_t)(tokbase + t) * 256 + h * 64;
            bf16x8 qf[2];
#pragma unroll
            for (int kk = 0; kk < 2; ++kk) qf[kk] = *(const LAS bf16x8*)(Qs + (i0t + fr) * 72 + kk * 32 + fq * 8);
#pragma unroll
            for (int pp = 0; pp < 2; ++pp) {
                const int pt = 2 * hh + pp;
                f32x4 a1 = {0.f, 0.f, 0.f, 0.f}, a2 = {0.f, 0.f, 0.f, 0.f};
                for (int kk = 0; kk < nk; ++kk) {
                    const bf16x8 vf = *(const LAS bf16x8*)(Vt + (pt * 16 + fr) * 136 + ((kk * 32 + fq * 8) ^ ((pt * 16 + fr) & 56)));
                    const bf16x8 pf = *(const LAS bf16x8*)(Pm + (i0t + fr) * 136 + kk * 32 + fq * 8);
                    a1 = __builtin_amdgcn_mfma_f32_16x16x32_bf16(vf, pf, a1, 0, 0, 0);
                }
#pragma unroll
                for (int kk = 0; kk < 2; ++kk) { const bf16x8 hf = *(const LAS bf16x8*)(Ht + (pt * 16 + fr) * 72 + kk * 32 + fq * 8); a2 = __builtin_amdgcn_mfma_f32_16x16x32_bf16(hf, qf[kk], a2, 0, 0, 0); }
                u32x2 yw; yw.x = pk2(a1[0] + ecs * a2[0], a1[1] + ecs * a2[1]); yw.y = pk2(a1[2] + ecs * a2[2], a1[3] + ecs * a2[3]);
                *(u32x2*)(yrow + pt * 16 + 4 * fq) = yw;
            }
        }
        {
            const float dec = __expf(cs_end);
#pragma unroll
            for (int q2 = 0; q2 < 2; ++q2) {
                const int id = 2 * w + q2, nt = id >> 2, pt = id & 3;
                hacc[q2] = hacc[q2] * dec;
#pragma unroll
                for (int kk = 0; kk < 4; ++kk) {
                    const bf16x8 kf = *(const LAS bf16x8*)(Kt + (nt * 16 + fr) * 136 + ((kk * 32 + fq * 8) ^ ((nt * 16 + fr) & 56)));
                    const bf16x8 vf = *(const LAS bf16x8*)(Vt + (pt * 16 + fr) * 136 + ((kk * 32 + fq * 8) ^ ((pt * 16 + fr) & 56)));
                    hacc[q2] = __builtin_amdgcn_mfma_f32_16x16x32_bf16(kf, vf, hacc[q2], 0, 0, 0);
                }
            }
        }
        __syncthreads();
#pragma unroll
        for (int q2 = 0; q2 < 2; ++q2) {
            const int id = 2 * w + q2, nt = id >> 2, pt = id & 3;
            u32x2 hw; hw.x = pk2(hacc[q2][0], hacc[q2][1]); hw.y = pk2(hacc[q2][2], hacc[q2][3]);
            *(LAS u32x2*)(Ht + (pt * 16 + fr) * 72 + nt * 16 + 4 * fq) = hw;
        }
    }
    __syncthreads();
}

template <bool WITH_Y>
__device__ __forceinline__ void s5_pass(const bf16_t* U, bf16_t* Y, LAS float* buL, LAS bf16_t* hL, const bf16x8 (&bbf)[8], const bf16x8 (&cmf)[4],
                                        const f32x2 ab, float& hre, float& him, int b, int dir, int g, int j0, int lane) {
    const int fr = lane & 15, fq = lane >> 4;
    auto tok_row = [&](int j) { const bool c = j < 16; const int Ls = c ? CTX : SEQ, jb = c ? j : j - 16; const int ti = jb * 16 + fr; return (c ? MLAT + b * CTX : b * SEQ) + (dir == 0 ? ti : Ls - 1 - ti); };
    const bf16_t* ucol = U + UC_S5 + g * 16 + (fq & 1) * 8;
    const unsigned umask = fq < 2 ? 0xffffffffu : 0u;
    u32x4 unext = *(const u32x4*)(ucol + (size_t)tok_row(j0) * UW);
    for (int j = j0; j < j0 + 36; ++j) {
        const int row = tok_row(j);
        u32x4 ucur = unext; ucur.x &= umask; ucur.y &= umask; ucur.z &= umask; ucur.w &= umask;
        unext = *(const u32x4*)(ucol + (size_t)tok_row(j < j0 + 35 ? j + 1 : j) * UW);
        const bf16x8 uf = __builtin_bit_cast(bf16x8, ucur);
#pragma unroll
        for (int T = 0; T < 8; ++T) {
            f32x4 d = {0.f, 0.f, 0.f, 0.f};
            d = __builtin_amdgcn_mfma_f32_16x16x32_bf16(bbf[T], uf, d, 0, 0, 0);
            *(LAS f32x4*)(buL + fr * 132 + 16 * T + 4 * fq) = d;
        }
        WAVE_SYNC();
        float br[16], bi[16];
#pragma unroll
        for (int i = 0; i < 16; ++i) { br[i] = buL[i * 132 + lane]; bi[i] = buL[i * 132 + 64 + lane]; }
#pragma unroll
        for (int i = 0; i < 16; ++i) {
            const float nr = ab.x * hre - ab.y * him + br[i], ni = ab.x * him + ab.y * hre + bi[i];
            hre = nr; him = ni;
            if (WITH_Y) { hL[i * 136 + lane] = f2bf(hre); hL[i * 136 + 64 + lane] = f2bf(him); }
        }
        WAVE_SYNC();
        if (WITH_Y) {
            f32x4 acc = {0.f, 0.f, 0.f, 0.f};
#pragma unroll
            for (int kk = 0; kk < 4; ++kk) { const bf16x8 hf = *(const LAS bf16x8*)(hL + fr * 136 + kk * 32 + fq * 8); acc = __builtin_amdgcn_mfma_f32_16x16x32_bf16(cmf[kk], hf, acc, 0, 0, 0); }
            u32x2 yw; yw.x = pk2(acc[0], acc[1]); yw.y = pk2(acc[2], acc[3]);
            *(u32x2*)(Y + (size_t)row * 256 + g * 16 + 4 * fq) = yw;
            WAVE_SYNC();
        }
    }
}
__device__ __forceinline__ void s5_block(const PV& P, LAS unsigned char* lds, int l, int item) {
    const int tid = P.tid, lane = tid & 63, wave = tid >> 6, fr = lane & 15, fq = lane >> 4;
    const int wi = item * 2 + (wave >> 2), ch = wave & 3, b = wi >> 5, dir = (wi >> 4) & 1, g = wi & 15;
    LAS unsigned char* wl = lds + wave * 12800;
    LAS float* buL = (LAS float*)wl;
    LAS bf16_t* hL = (LAS bf16_t*)(wl + 16 * 132 * 4);
    LAS float* ex = (LAS float*)(lds + 8 * 12800) + (wave >> 2) * 512;
    const int idx = (l * 2 + dir) * 16 + g;
    const f32x2 ab = ((const f32x2*)(P.ws_() + WS_S5AB))[idx * 64 + lane];
    const bf16_t* bb = (const bf16_t*)(P.ws_() + WS_S5BB) + (size_t)idx * 128 * 16;
    const bf16_t* cm = (const bf16_t*)(P.ws_() + WS_S5CM) + (size_t)idx * 16 * 128;
    const bf16x8 zero8 = {0, 0, 0, 0, 0, 0, 0, 0};
    bf16x8 bbf[8], cmf[4];
#pragma unroll
    for (int T = 0; T < 8; ++T) bbf[T] = fq < 2 ? *(const bf16x8*)(bb + (16 * T + fr) * 16 + fq * 8) : zero8;
#pragma unroll
    for (int kk = 0; kk < 4; ++kk) cmf[kk] = *(const bf16x8*)(cm + fr * 128 + kk * 32 + fq * 8);
    const bf16_t* U = (const bf16_t*)(P.ws_() + WS_U);
    bf16_t* Y = (bf16_t*)(P.ws_() + WS_Y) + (size_t)(4 + dir) * MTOT * 256;
    __syncthreads();
    float hre = 0.f, him = 0.f;
    s5_pass<false>(U, Y, buL, hL, bbf, cmf, ab, hre, him, b, dir, g, 36 * ch, lane);
    ex[ch * 128 + lane] = hre; ex[ch * 128 + 64 + lane] = him;
    __syncthreads();
    float ar = ab.x, ai = ab.y, a64r = 0.f, a64i = 0.f;
#pragma unroll
    for (int q = 0; q < 9; ++q) { const float nr = ar * ar - ai * ai, ni = 2.f * ar * ai; ar = nr; ai = ni; if (q == 5) { a64r = ar; a64i = ai; } }
    const float Ar = ar * a64r - ai * a64i, Ai = ar * a64i + ai * a64r;
    float sr = 0.f, si = 0.f;
    for (int j = 0; j < ch; ++j) { const float er = ex[j * 128 + lane], ei = ex[j * 128 + 64 + lane]; const float nr = Ar * sr - Ai * si + er, ni = Ar * si + Ai * sr + ei; sr = nr; si = ni; }
    hre = sr; him = si;
    s5_pass<true>(U, Y, buL, hL, bbf, cmf, ab, hre, him, b, dir, g, 36 * ch, lane);
    __syncthreads();
}

template <int L>
__device__ __forceinline__ void hyena_seg(const PV& P, LAS unsigned char* lds, int l, int ch, int tokbase0, int tokstride) {
    constexpr int TPW = L / 128, NS = L / 32, CPB = (2 * L + 8) * 2, ZROW = (L + 8) * 2, ZOFF = 8 * CPB;
    static_assert(ZOFF + 16 * ZROW <= LDS_BYTES, "hyena LDS");
    const int tid = P.tid, lane = tid & 63, w = __builtin_amdgcn_readfirstlane(tid >> 6), fr = lane & 15, fq = lane >> 4;
    const bf16_t* UH = (const bf16_t*)(P.ws_() + WS_UH);
    bf16_t* ZH = (bf16_t*)(P.ws_() + WS_ZH);
    const float* hcw = P.in_(I_HCW) + (size_t)l * 3 * 768; const float* hcb = P.in_(I_HCB) + (size_t)l * 768;
    LAS bf16_t* cop = (LAS bf16_t*)lds; LAS unsigned char* zs = lds + ZOFF;
    __syncthreads();
    {
        const bf16_t* src = UH + (size_t)(512 + ch) * MTOT;
        const float w0 = hcw[512 + ch], w1 = hcw[768 + 512 + ch], w2 = hcw[2 * 768 + 512 + ch], bz = hcb[512 + ch];
#pragma unroll
        for (int i = tid; i < 16 * L / 8; i += 512) {
            const int b = i / (L / 8), t0 = (i % (L / 8)) * 8; const bf16_t* sp = src + tokbase0 + (size_t)b * tokstride + t0;
            float v[10]; unpack8(*(const u32x4*)sp, v + 1);
            v[0] = t0 > 0 ? bf2f(sp[-1]) : 0.f; v[9] = t0 + 8 < L ? bf2f(sp[8]) : 0.f;
            float o[8];
#pragma unroll
            for (int e = 0; e < 8; ++e) o[e] = bz + w0 * v[e] + w1 * v[e + 1] + w2 * v[e + 2];
            *(LAS u32x4*)(zs + b * ZROW + t0 * 2) = pack8(o);
        }
    }
    for (int order = 0; order < 2; ++order) {
        const float* G = (L == SEQ) ? (const float*)(P.ws_() + WS_GLAT) + ((size_t)(l * 2 + order) * 256 + ch) * 4096 : (const float*)(P.ws_() + WS_GCTX) + ((size_t)order * 256 + ch) * 512;
        LAS float* red = (LAS float*)(lds + LDS_BYTES - 64);
        float sum = 0.f;
        for (int m = tid; m < 2 * L / 8 + 1; m += 512) {
            float gv[16];
#pragma unroll
            for (int q = 0; q < 4; ++q) { const int x0 = 8 * m - 8 + 4 * q; const bool ok = x0 >= 0 && x0 < 2 * L; const f32x4 t4 = ok ? *(const f32x4*)(G + x0) : (f32x4){0.f, 0.f, 0.f, 0.f};
                gv[4 * q] = t4.x; gv[4 * q + 1] = t4.y; gv[4 * q + 2] = t4.z; gv[4 * q + 3] = t4.w; }
#pragma unroll
            for (int e = 8; e < 16; ++e) sum += fabsf(gv[e]);
#pragma unroll
            for (int c = 0; c < 8; ++c) { const int pc = (8 - c) & 7;
                *(LAS u32x4*)((LAS unsigned char*)cop + c * CPB + 16 * m) = pack8(gv + 8 - pc); }
        }
        sum = wave_sum(sum);
        if (lane == 0) red[w] = sum;
        __syncthreads();
        sum = ((red[0] + red[1]) + (red[2] + red[3])) + ((red[4] + red[5]) + (red[6] + red[7]));
        const float inv = 1.f / (sum + 1e-6f);
        f32x4 acc[TPW];
#pragma unroll
        for (int m = 0; m < TPW; ++m) acc[m] = (f32x4){0.f, 0.f, 0.f, 0.f};
        const int cidx = (8 - (fr & 7)) & 7;
        const LAS unsigned char* fbase = lds + cidx * CPB + 2 * (L - (fr & 8) + 8 * fq);
        const LAS unsigned char* zbase = zs + fr * ZROW + fq * 16;
        if constexpr (TPW == 16) {
            bf16x8 fg[16];
#pragma unroll
            for (int m = 2; m < 16; ++m) fg[m] = *(const LAS bf16x8*)(fbase - 32 * (16 * w + m));
            for (int sb = 0; sb < NS / 8; ++sb) {
#pragma unroll
                for (int u = 0; u < 8; ++u) {
                    const int si = sb * 8 + u;
                    fg[(0 - 2 * u) & 15] = *(const LAS bf16x8*)(fbase - 32 * (16 * w - 2 * si));
                    fg[(1 - 2 * u) & 15] = *(const LAS bf16x8*)(fbase - 32 * (16 * w + 1 - 2 * si));
                    const bf16x8 zf = *(const LAS bf16x8*)(zbase + 64 * si);
#pragma unroll
                    for (int m = 0; m < 16; ++m) acc[m] = __builtin_amdgcn_mfma_f32_16x16x32_bf16(fg[(m - 2 * u) & 15], zf, acc[m], 0, 0, 0);
                }
            }
        } else {
            for (int si = 0; si < NS; ++si) {
                const bf16x8 zf = *(const LAS bf16x8*)(zbase + 64 * si);
#pragma unroll
                for (int m = 0; m < TPW; ++m) { const bf16x8 ff = *(const LAS bf16x8*)(fbase - 32 * (TPW * w + m - 2 * si)); acc[m] = __builtin_amdgcn_mfma_f32_16x16x32_bf16(ff, zf, acc[m], 0, 0, 0); }
            }
        }
        __syncthreads();
        {
            const int xc = order * 256 + ch;
            const float w0 = hcw[xc], w1 = hcw[768 + xc], w2 = hcw[2 * 768 + xc], bx = hcb[xc];
            const float bias = P.in_(I_HBIAS)[(size_t)(l * 2 + order) * 256 + ch];
            const bf16_t* xs = UH + (size_t)xc * MTOT + tokbase0 + (size_t)fr * tokstride;
#pragma unroll
            for (int m = 0; m < TPW; ++m) {
                const int t0 = 16 * (TPW * w + m) + 4 * fq;
                float xv[6];
                { const u32x2 xw = *(const u32x2*)(xs + t0); xv[1] = bflo(xw.x); xv[2] = bfhi(xw.x); xv[3] = bflo(xw.y); xv[4] = bfhi(xw.y);
                  xv[0] = t0 > 0 ? bf2f(xs[t0 - 1]) : 0.f; xv[5] = t0 + 4 < L ? bf2f(xs[t0 + 4]) : 0.f; }
                LAS u32x2* zp = (LAS u32x2*)(zs + fr * ZROW + t0 * 2);
                const u32x2 zo = *zp;
                const float zv[4] = {bflo(zo.x), bfhi(zo.x), bflo(zo.y), bfhi(zo.y)};
                float o[4];
#pragma unroll
                for (int r = 0; r < 4; ++r) { const float xg = bx + w0 * xv[r] + w1 * xv[r + 1] + w2 * xv[r + 2]; o[r] = xg * (acc[m][r] * inv + zv[r] * bias); }
                u32x2 ow; ow.x = pk2(o[0], o[1]); ow.y = pk2(o[2], o[3]);
                if (order == 0) *zp = ow;
                else *(u32x2*)(ZH + (size_t)ch * MTOT + tokbase0 + (size_t)fr * tokstride + t0) = ow;
            }
        }
        __syncthreads();
    }
}

constexpr int FZ_T = 0, FZ_V = 256 * 66 * 2;
template <int NROWS>
__device__ __forceinline__ void finalize_item(const PV& P, LAS unsigned char* lds, int l, int row0) {
    constexpr int NPASS = NROWS / 16, NC8 = NROWS / 8;
    const int tid = P.tid, lane = tid & 63, w = __builtin_amdgcn_readfirstlane(tid >> 6), fr = lane & 15, fq = lane >> 4;
    LAS bf16_t* T = (LAS bf16_t*)(lds + FZ_T); LAS bf16_t* Vs = (LAS bf16_t*)(lds + FZ_V);
    const bf16_t* U = (const bf16_t*)(P.ws_() + WS_U);
    const bf16_t* Yb = (const bf16_t*)(P.ws_() + WS_Y); const size_t YS = (size_t)MTOT * 256;
    __syncthreads();
    {
        const bf16_t* ZH = (const bf16_t*)(P.ws_() + WS_ZH);
#pragma unroll
        for (int i = tid; i < 256 * NC8; i += 512) { const int ch = i / NC8, c8 = (i % NC8) * 8; const u32x4 v = *(const u32x4*)(ZH + (size_t)ch * MTOT + row0 + c8);
            LAS unsigned* d = (LAS unsigned*)(T + ch * 66 + c8); d[0] = v.x; d[1] = v.y; d[2] = v.z; d[3] = v.w; }
    }
    __syncthreads();
    const int sub = tid & 31, c = sub * 8;
    const float* cw = P.in_(I_SCW) + (size_t)l * 3 * 384; const float* cb = P.in_(I_SCB) + (size_t)l * 384;
    const float dsk = P.in_(I_SD)[l * 4 + (sub >> 3)];
    const float* ng = P.in_(I_SNG) + l * 256;
    const float* d5 = P.in_(I_5D) + l * 256;
    bf16x8 wf[8][2];
    {
        const bf16_t* Wg0 = (const bf16_t*)(P.ws_() + WS_WGLU) + (size_t)l * 256 * 256;
#pragma unroll
        for (int kk = 0; kk < 8; ++kk)
#pragma unroll
            for (int a = 0; a < 2; ++a) wf[kk][a] = *(const bf16x8*)(Wg0 + (size_t)((2 * w + a) * 16 + fr) * 256 + kk * 32 + fq * 8);
    }
    struct FRaw { u32x4 rx0, rz, rg, ru5, y0, y1, y2, y3, y4, y5; };
    auto load_raw = [&](int pass) __attribute__((always_inline)) {
        const int row = row0 + pass * 16 + (tid >> 5);
        const bf16_t* Ur = U + (size_t)row * UW; const bf16_t* yp = Yb + (size_t)row * 256 + c;
        FRaw f;
        f.rx0 = *(const u32x4*)((const bf16_t*)(P.ws_() + WS_XBC) + (size_t)row * 384 + c);
        f.rz = *(const u32x4*)(Ur + UC_Z + c); f.rg = *(const u32x4*)(Ur + UC_G + c); f.ru5 = *(const u32x4*)(Ur + UC_S5 + c);
        f.y0 = *(const u32x4*)(yp); f.y1 = *(const u32x4*)(yp + YS); f.y2 = *(const u32x4*)(yp + 2 * YS); f.y3 = *(const u32x4*)(yp + 3 * YS); f.y4 = *(const u32x4*)(yp + 4 * YS); f.y5 = *(const u32x4*)(yp + 5 * YS);
        return f;
    };
    float ng8[8], d58[8];
#pragma unroll
    for (int e = 0; e < 8; ++e) { ng8[e] = ng[c + e]; d58[e] = d5[c + e]; }
    FRaw nx = load_raw(0);
#pragma unroll 1
    for (int pass = 0; pass < NPASS; ++pass) {
        const int tk = pass * 16 + (tid >> 5), row = row0 + tk;
        bf16_t* Yc = (bf16_t*)(P.ws_() + WS_XN) + (size_t)row * DM;
        const FRaw cur = nx;
        if (pass + 1 < NPASS) nx = load_raw(pass + 1);
        const u32x4 rx0 = cur.rx0, rz = cur.rz, rg = cur.rg, ru5 = cur.ru5, y0 = cur.y0, y1 = cur.y1, y2 = cur.y2, y3 = cur.y3, y4 = cur.y4, y5 = cur.y5;
        {
            float v[8], x0[8], z[8], yf[8], yb[8]; float ss = 0.f;
            unpack8(rx0, x0); unpack8(rz, z); unpack8(y0, yf); unpack8(y1, yb);
#pragma unroll
            for (int e = 0; e < 8; ++e) { const float y = yf[e] + yb[e] + x0[e] * dsk; const float o = y * siluf_(z[e]); v[e] = o; ss += o * o; }
#pragma unroll
            for (int sh = 1; sh < 32; sh <<= 1) ss += __shfl_xor(ss, sh);
            const float rstd = rsqrtf(ss * (1.f / 256.f) + 1e-6f);
#pragma unroll
            for (int e = 0; e < 8; ++e) v[e] = v[e] * rstd * ng8[e];
            *(u32x4*)(Yc + c) = pack8(v);
        }
        {
            u32x4 o; unsigned short e8[8];
#pragma unroll
            for (int e = 0; e < 8; ++e) e8[e] = T[(c + e) * 66 + tk];
            o.x = e8[0] | ((unsigned)e8[1] << 16); o.y = e8[2] | ((unsigned)e8[3] << 16); o.z = e8[4] | ((unsigned)e8[5] << 16); o.w = e8[6] | ((unsigned)e8[7] << 16);
            *(u32x4*)(Yc + 256 + c) = o;
        }
        {
            float v[8], yf[8], yb[8], g[8]; float sm = 0.f;
            unpack8(y2, yf); unpack8(y3, yb); unpack8(rg, g);
#pragma unroll
            for (int e = 0; e < 8; ++e) { v[e] = yf[e] + yb[e]; sm += v[e]; }
            sm += __shfl_xor(sm, 1); sm += __shfl_xor(sm, 2); sm += __shfl_xor(sm, 4);
            const float mu = sm * (1.f / 64.f); float vs = 0.f;
#pragma unroll
            for (int e = 0; e < 8; ++e) { const float d = v[e] - mu; vs += d * d; }
            vs += __shfl_xor(vs, 1); vs += __shfl_xor(vs, 2); vs += __shfl_xor(vs, 4);
            const float rstd = rsqrtf(vs * (1.f / 64.f) + 1e-6f);
#pragma unroll
            for (int e = 0; e < 8; ++e) v[e] = siluf_(g[e]) * (v[e] - mu) * rstd;
            *(u32x4*)(Yc + 512 + c) = pack8(v);
        }
        {
            float u[8], yf[8], yb[8], o[8];
            unpack8(ru5, u); unpack8(y4, yf); unpack8(y5, yb);
#pragma unroll
            for (int e = 0; e < 8; ++e) o[e] = gelu_tanh(u[e] * d58[e] + yf[e] + yb[e]);
            *(LAS u32x4*)(Vs + tk * 264 + c) = pack8(o);
        }
    }
    __syncthreads();
    {
        const bf16_t* Wg = (const bf16_t*)(P.ws_() + WS_WGLU) + (size_t)l * 256 * 256;
        const float* gb = P.in_(I_5GB) + l * 256;
        f32x4 acc[2][NPASS];
#pragma unroll
        for (int a = 0; a < 2; ++a)
#pragma unroll
            for (int m = 0; m < NPASS; ++m) acc[a][m] = (f32x4){0.f, 0.f, 0.f, 0.f};
#pragma unroll
        for (int kk = 0; kk < 8; ++kk) {
            bf16x8 vf[NPASS];
#pragma unroll
            for (int m = 0; m < NPASS; ++m) vf[m] = *(const LAS bf16x8*)(Vs + (m * 16 + fr) * 264 + kk * 32 + fq * 8);
#pragma unroll
            for (int a = 0; a < 2; ++a)
#pragma unroll
                for (int m = 0; m < NPASS; ++m) acc[a][m] = __builtin_amdgcn_mfma_f32_16x16x32_bf16(wf[kk][a], vf[m], acc[a][m], 0, 0, 0);
        }
#pragma unroll
        for (int a = 0; a < 2; ++a)
#pragma unroll
            for (int m = 0; m < NPASS; ++m) {
                const int n = (2 * w + a) * 16 + 4 * fq, tkk = m * 16 + fr;
                const u32x2 vv = *(const LAS u32x2*)(Vs + tkk * 264 + n);
                const float v4[4] = {bflo(vv.x), bfhi(vv.x), bflo(vv.y), bfhi(vv.y)};
                float o[4];
#pragma unroll
                for (int r = 0; r < 4; ++r) o[r] = v4[r] * sigmoidf_(acc[a][m][r] + gb[n + r]);
                u32x2 ow; ow.x = pk2(o[0], o[1]); ow.y = pk2(o[2], o[3]);
                *(u32x2*)((bf16_t*)(P.ws_() + WS_XN) + (size_t)(row0 + tkk) * DM + 768 + n) = ow;
            }
    }
    __syncthreads();
}

__device__ __forceinline__ void final_norm(const PV& P, int gw, int ngw, int lane) {
    const float* g = P.in_(I_FNG);
    constexpr int NR = 4;
    f32x4 nx[NR][4];
#pragma unroll
    for (int q = 0; q < NR; ++q)
#pragma unroll
        for (int j = 0; j < 4; ++j) nx[q][j] = *(const f32x4*)(P.out_() + (size_t)(gw + q * ngw) * DM + 4 * lane + 256 * j);
    for (int row0 = gw; row0 < MLAT; row0 += NR * ngw) {
        f32x4 v[NR][4]; float ss[NR];
#pragma unroll
        for (int q = 0; q < NR; ++q)
#pragma unroll
            for (int j = 0; j < 4; ++j) v[q][j] = nx[q][j];
        if (row0 + NR * ngw < MLAT) {
#pragma unroll
            for (int q = 0; q < NR; ++q)
#pragma unroll
                for (int j = 0; j < 4; ++j) nx[q][j] = *(const f32x4*)(P.out_() + (size_t)(row0 + NR * ngw + q * ngw) * DM + 4 * lane + 256 * j);
        }
#pragma unroll
        for (int q = 0; q < NR; ++q) { float s_ = 0.f;
#pragma unroll
            for (int j = 0; j < 4; ++j) s_ += v[q][j].x * v[q][j].x + v[q][j].y * v[q][j].y + v[q][j].z * v[q][j].z + v[q][j].w * v[q][j].w;
            ss[q] = s_; }
#pragma unroll
        for (int q = 0; q < NR; ++q) {
            const float rstd = rsqrtf(wave_sum(ss[q]) * (1.f / DM) + 1e-6f);
#pragma unroll
            for (int j = 0; j < 4; ++j) { const f32x4 gg = *(const f32x4*)(g + 4 * lane + 256 * j); *(f32x4*)(P.out_() + (size_t)(row0 + q * ngw) * DM + 4 * lane + 256 * j) = v[q][j] * rstd * gg; }
        }
    }
}

__device__ __forceinline__ void sw_items(const PV& P, LAS unsigned char* lds, int lb, int nlb, int it_lo, int it_hi) {
    LAS float* sc = (LAS float*)lds;
    LAS float* red = (LAS float*)(lds + 17 * 1024 * 4);
    const int tid = P.tid;
    for (int it = it_lo + lb; it < it_hi; it += nlb) {
        const bool win = it >= 176;
        const int l = win ? 1 : it / 88, j0 = (win ? it - 176 : it % 88) * 64, col = tid & 63, ks = tid >> 6;
        const int WN = win ? D_IN : 2 * DFF, soff = win ? 0 : 3 * DM;
        const bool cvalid = j0 + col < WN;
        __syncthreads();
        for (int i = tid; i < 17 * 1024; i += 512) sc[i] = ((const float*)(P.ws_() + WS_MOD))[((size_t)l * 17 + (i >> 10)) * 6144 + soff + (i & 1023)];
        __syncthreads();
        const float* w = (win ? P.in_(I_WIN) + (size_t)DM * D_IN : P.in_(I_FUP) + (size_t)l * DM * 2 * DFF) + (cvalid ? j0 + col : 0);
        float a[17];
#pragma unroll
        for (int r = 0; r < 17; ++r) a[r] = 0.f;
#pragma unroll 1
        for (int k0 = ks * 128; k0 < ks * 128 + 128; k0 += 16) {
            float wv[16];
#pragma unroll
            for (int u = 0; u < 16; ++u) wv[u] = w[(size_t)(k0 + u) * WN];
#pragma unroll
            for (int u = 0; u < 16; ++u)
#pragma unroll
                for (int r = 0; r < 17; ++r) a[r] += sc[r * 1024 + k0 + u] * wv[u];
        }
#pragma unroll
        for (int r = 0; r < 17; ++r) red[(ks * 17 + r) * 64 + col] = a[r];
        __syncthreads();
        for (int i = tid; i < 17 * 64; i += 512) {
            const int r = i >> 6, c = i & 63; float sm = 0.f;
#pragma unroll
            for (int k = 0; k < 8; ++k) sm += red[(k * 17 + r) * 64 + c];
            if (win) ((float*)(P.ws_() + WS_SWIN))[(size_t)r * NIN + j0 + c] = (j0 + c < D_IN) ? sm : 0.f;
            else ((float*)(P.ws_() + WS_SWUP))[((size_t)l * 17 + r) * 2 * DFF + j0 + c] = sm;
        }
    }
    __syncthreads();
}
__device__ __forceinline__ void deferred_work(const PV& P, LAS unsigned char* lds, int which, int first_idle) {
    const int tid = P.tid, lane = tid & 63, wave = tid >> 6, blk = blockIdx.x, nblk = gridDim.x;
    if (blk < first_idle) return;
    const int lb = blk - first_idle, nlb = nblk - first_idle, lgw = lb * 8 + wave, nlgw = nlb * 8;
    constexpr int I_LAYER = 16 * 88 + 16 * 32 + 16 * 176 + 44 * 32 + 4 * 8;
    __syncthreads();
    if (which == 0) {
        p0_filter(P, lds, lb, nlb, 0, 72);
        __syncthreads();
        if (lb >= 72) sw_items(P, lds, lb - 72, nlb - 72, 0, 88);
        p0_s5(P, lgw, nlgw, lane, 0, 32);
        p0_weights(P, lds, lgw, nlgw, wave, lane, 1408, 1920);
        p0_weights(P, lds, lgw, nlgw, wave, lane, I_LAYER - 32, I_LAYER);
    } else if (which == 1) {
        p0_weights(P, lds, lgw, nlgw, wave, lane, 1920, I_LAYER - 32);
    } else {
        p0_filter(P, lds, lb, nlb, 72, 136);
        __syncthreads();
        sw_items(P, lds, lb, nlb, 88, 220);
        p0_s5(P, lgw, nlgw, lane, 32, 64);
        p0_weights(P, lds, lgw, nlgw, wave, lane, I_LAYER, 2 * I_LAYER);
    }
    __syncthreads();
}
constexpr int NSP = 9;
constexpr int NPHASE = 1 + 2 * NSP + 1;

__device__ __forceinline__ void run_phase(const PV& P, int ph, LAS unsigned char* lds) {
    const int tid = P.tid, lane = tid & 63, wave = tid >> 6;
    const int blk = blockIdx.x, nblk = gridDim.x, gw = blk * 8 + wave, ngw = nblk * 8;
#ifndef PHMASK
#define PHMASK 0xffff
#endif
    if (ph == 0) {
        if (PHMASK & 1) p0_mod(P, lds, blk, nblk);
        return;
    }
    if (ph == NPHASE - 1) { if (PHMASK & 16) final_norm(P, gw, ngw, lane); return; }
    const int l = (ph - 1) / NSP, sp = (ph - 1) % NSP;
    const bool last = (l == 1);
    const int Mall = MTOT, Mres = last ? MLAT : MTOT;
    pg8::StaticOrder S;
    switch (sp) {
    case 0: if (PHMASK & 16) norm_phase(P, l, 1, Mall, gw, ngw, lane);
            if (l == 0) { __syncthreads(); p0_weights(P, lds, gw, ngw, wave, lane, 0, 1408); }
            break;
    case 1: if (PHMASK & 32) { pg8::Gemm g{(const bf16_t*)(P.ws_() + WS_XN), (const bf16_t*)(P.ws_() + WS_WIN) + (size_t)l * NIN * DM, Mall, NIN, DM};
              EpiU E{(bf16_t*)(P.ws_() + WS_U), (bf16_t*)(P.ws_() + WS_UH)};
              if (l == 0) { S.init(Mall, NIN, nblk, blk); pg8::gemm_phase(lds, g, S, E, P.tid); deferred_work(P, lds, 0, (Mall / 256 * (NIN / 256)) % nblk); }
              else { pg8::LastWinOrder S1; S1.init(nblk, blk); EpiUN E1{(bf16_t*)(P.ws_() + WS_U), (bf16_t*)(P.ws_() + WS_UH), (const float*)(P.ws_() + WS_SSQ2), (const float*)(P.ws_() + WS_SWIN)};
                     pg8::gemm_phase(lds, g, S1, E1, P.tid); } } break;
    case 2: {
#ifndef REP_SUB
#define REP_SUB 0
#endif
        for (int rep = 0; rep < ((REP_SUB == 1 && l == 0) ? 2 : 1); ++rep)
        xbc_prepass(P, l, blk, nblk);
        if (PHMASK & 64) for (int it = blk; it < 256; it += nblk) {
            hyena_seg<SEQ>(P, lds, l, it, 0, SEQ);
            if (!last) hyena_seg<CTX>(P, lds, l, it, MLAT, CTX);
        }
        for (int rep = 0; rep < ((REP_SUB == 3 && l == 0) ? 2 : 1); ++rep)
        if (PHMASK & 256) for (int it = blk; it < 256; it += nblk) s5_block(P, lds, l, it);
        __syncthreads();
    } break;
    case 3:
        if (PHMASK & 128) for (int it = blk; it < 256; it += nblk) { const int kind = it >> 7, r = it & 127; scan_item(P, lds, l, kind, r >> 3, (r >> 1) & 3, r & 1); }
        break;
    case 4: for (int i = blk * 512 + tid; i < MTOT; i += nblk * 512) { ((float*)(P.ws_() + WS_SSQ))[i] = 0.f; if (l == 0) ((float*)(P.ws_() + WS_SSQ2))[i] = 0.f; }
            if (PHMASK & 512) { if (last) { for (int it = blk; it < MLAT / 64; it += nblk) finalize_item<64>(P, lds, l, it * 64); }
                                else { for (int it = blk; it < MTOT / 48; it += nblk) finalize_item<48>(P, lds, l, it * 48); } } break;
    case 5: if (PHMASK & 1024) { pg8::Gemm g{(const bf16_t*)(P.ws_() + WS_XN), (const bf16_t*)(P.ws_() + WS_WOUT) + (size_t)l * DM * DM, Mres, DM, DM};
              S.init(Mres, DM, nblk, blk);
              EpiResN E{l == 0 ? P.in_(I_X) : P.out_(), l == 0 ? P.in_(I_CTX) : (const float*)(P.ws_() + WS_HC), P.out_(), (float*)(P.ws_() + WS_HC), (const float*)(P.ws_() + WS_MOD) + (size_t)l * 17 * 6144 + 2 * DM,
                        P.in_(I_N2G) + l * DM, (const float*)(P.ws_() + WS_MOD) + (size_t)l * 17 * 6144 + 4 * DM, (bf16_t*)(P.ws_() + WS_Y), (float*)(P.ws_() + WS_SSQ)};
              pg8::gemm_phase(lds, g, S, E, P.tid); if (l == 0) deferred_work(P, lds, 1, (Mres / 256 * 4) % nblk); } break;
    case 6: break;
    case 7: if (PHMASK & 2048) { pg8::Gemm g{(const bf16_t*)(P.ws_() + WS_Y), (const bf16_t*)(P.ws_() + WS_WUP) + (size_t)l * 2 * DFF * DM, Mres, 2 * DFF, DM};
              S.init(Mres, 2 * DFF, nblk, blk); EpiSwigluN E{(bf16_t*)(P.ws_() + WS_U), (const float*)(P.ws_() + WS_SSQ), (const float*)(P.ws_() + WS_SWUP) + (size_t)l * 17 * 2 * DFF}; pg8::gemm_phase(lds, g, S, E, P.tid); } break;
    case 8: if (PHMASK & 4096) { pg8::Gemm g{(const bf16_t*)(P.ws_() + WS_U), (const bf16_t*)(P.ws_() + WS_WDN) + (size_t)l * DM * DFF, Mres, DM, DFF};
              S.init(Mres, DM, nblk, blk);
              if (l == 0) {
                  EpiResN E{P.out_(), (const float*)(P.ws_() + WS_HC), P.out_(), (float*)(P.ws_() + WS_HC), (const float*)(P.ws_() + WS_MOD) + (size_t)l * 17 * 6144 + 5 * DM,
                            P.in_(I_N1G) + DM, (const float*)(P.ws_() + WS_MOD) + (size_t)17 * 6144 + 1 * DM, (bf16_t*)(P.ws_() + WS_XN), (float*)(P.ws_() + WS_SSQ2)};
                  pg8::gemm_phase(lds, g, S, E, P.tid); deferred_work(P, lds, 2, (Mres / 256 * 4) % nblk); break; }
              EpiRes E{P.out_(), (const float*)(P.ws_() + WS_HC), P.out_(), (float*)(P.ws_() + WS_HC), (const float*)(P.ws_() + WS_MOD) + (size_t)l * 17 * 6144 + 5 * DM};
              pg8::gemm_phase(lds, g, S, E, P.tid); if (l == 0) deferred_work(P, lds, 2, (Mres / 256 * 4) % nblk); } break;
    }
}


#define XB_TMO      128
#define XB_XCNT(j)  (256  + 64 * (j))
#define XB_XSUB(j)  (1280 + 64 * (j))
#define XB_XGEN(j)  (2304 + 64 * (j))
#define XB_TOP      3328
#define XB_TOPGEN   3392
#define XCD_BAR_WORDS 3456
#define XB_SPIN_CAP (1u << 18)

__device__ __forceinline__ unsigned xb_ld(unsigned* p)              { return __hip_atomic_load(p, __ATOMIC_RELAXED, __HIP_MEMORY_SCOPE_AGENT); }
__device__ __forceinline__ unsigned xb_add(unsigned* p, unsigned v) { return __hip_atomic_fetch_add(p, v, __ATOMIC_RELAXED, __HIP_MEMORY_SCOPE_AGENT); }
__device__ __forceinline__ unsigned xb_xcc_id() { return (unsigned)__builtin_amdgcn_s_getreg((3 << 11) | 20) & 0xFu; }
#define XB_SPIN(cond, bar) do { unsigned _sp = 0; while (cond) { __builtin_amdgcn_s_sleep(1); \
    if ((++_sp & 255u) == 0u) { if (xb_ld(&(bar)[XB_TMO])) break; if (_sp > XB_SPIN_CAP) { atomicAdd(&(bar)[XB_TMO], 1u); break; } } } } while (0)

struct XcdBarrier {
    unsigned* bar; unsigned x;
    volatile LAS unsigned* st;
};

__device__ __forceinline__ XcdBarrier xcd_barrier_post(unsigned* bar, volatile LAS unsigned* st) {
    XcdBarrier b; b.bar = bar; b.x = xb_xcc_id(); b.st = st;
    if (threadIdx.x == 0) (void)xb_add(&bar[XB_XCNT(b.x)], 1u);
    return b;
}
__device__ __forceinline__ void xcd_barrier_complete(unsigned* bar, unsigned x, unsigned& nloc, unsigned& nx) {
    const unsigned G = gridDim.x * gridDim.y * gridDim.z;
    unsigned sum, cnt, mine, sp = 0u;
    for (;;) {
        sum = 0u; cnt = 0u; mine = 0u;
#pragma unroll
        for (unsigned j = 0; j < 16; ++j) { const unsigned c = xb_ld(&bar[XB_XCNT(j)]); sum += c; cnt += (c > 0u) ? 1u : 0u; mine = (j == x) ? c : mine; }
        if (sum == G) break;
        __builtin_amdgcn_s_sleep(1);
        if ((++sp & 255u) == 0u) { if (xb_ld(&bar[XB_TMO])) break; if (sp > XB_SPIN_CAP) { atomicAdd(&bar[XB_TMO], 1u); break; } }
    }
    nloc = mine > 0u ? mine : 1u; nx = cnt > 0u ? cnt : 1u;
}

__device__ __forceinline__ void xcd_barrier(const XcdBarrier& b) {
    asm volatile("s_waitcnt vmcnt(0)" ::: "memory");
    __syncthreads();
    if (threadIdx.x == 0) {
        unsigned* bar = b.bar;
        __builtin_amdgcn_s_waitcnt(0);
        unsigned nloc = b.st[0], nx = b.st[1];
        if (nloc == 0u) { xcd_barrier_complete(bar, b.x, nloc, nx); b.st[0] = nloc; b.st[1] = nx; }
        const unsigned old = xb_add(&bar[XB_XSUB(b.x)], 1u);
        const unsigned gen = old / nloc;
        if (old + 1u == (gen + 1u) * nloc) {
            __builtin_amdgcn_fence(__ATOMIC_RELEASE, "agent");
            asm volatile("s_waitcnt vmcnt(0)" ::: "memory");
            const unsigned og = xb_add(&bar[XB_TOP], 1u);
            const unsigned tg = og / nx;
            if (og + 1u == (tg + 1u) * nx) xb_add(&bar[XB_TOPGEN], 1u);
            else XB_SPIN(xb_ld(&bar[XB_TOPGEN]) == tg, bar);
            __builtin_amdgcn_fence(__ATOMIC_ACQUIRE, "agent");
            xb_add(&bar[XB_XGEN(b.x)], 1u);
            asm volatile("s_waitcnt vmcnt(0)" ::: "memory");
        } else {
            XB_SPIN(xb_ld(&bar[XB_XGEN(b.x)]) == gen, bar);
            __builtin_amdgcn_fence(__ATOMIC_ACQUIRE, "agent");
            asm volatile("s_waitcnt vmcnt(0)" ::: "memory");
        }
    }
    __syncthreads();
}


__device__ __forceinline__ void grid_barrier(unsigned* bar, unsigned k, int tid) {
    asm volatile("s_waitcnt vmcnt(0) lgkmcnt(0)" ::: "memory");
    __builtin_amdgcn_s_barrier();
    if (tid == 0) {
        __builtin_amdgcn_fence(__ATOMIC_RELEASE, "agent");
        asm volatile("s_waitcnt vmcnt(0)" ::: "memory");
        const unsigned old = __hip_atomic_fetch_add(bar, 1u, __ATOMIC_RELAXED, __HIP_MEMORY_SCOPE_AGENT);
        if (old == k * gridDim.x - 1u) __hip_atomic_store(bar + 32, k, __ATOMIC_RELAXED, __HIP_MEMORY_SCOPE_AGENT);
        else {
            unsigned long long t0 = __builtin_amdgcn_s_memrealtime();
            while (__hip_atomic_load(bar + 32, __ATOMIC_RELAXED, __HIP_MEMORY_SCOPE_AGENT) < k) {
                __builtin_amdgcn_s_sleep(2);
                if (__builtin_amdgcn_s_memrealtime() - t0 > 200000000ull) break;
            }
        }
        __builtin_amdgcn_fence(__ATOMIC_ACQUIRE, "agent");
        asm volatile("s_waitcnt vmcnt(0)" ::: "memory");
    }
    asm volatile("" ::: "memory");
    __builtin_amdgcn_s_barrier();
    asm volatile("" ::: "memory");
}
#ifdef DEBUG_CHK
__device__ __forceinline__ void chk_range(const PV& P, int ph, size_t off, size_t bytes, int is_f32, const void* base) {
    const unsigned* p = (const unsigned*)((const unsigned char*)base + off);
    const size_t n = bytes / 4; bool bad = false;
    for (size_t i = (size_t)blockIdx.x * 512 + P.tid; i < n; i += (size_t)gridDim.x * 512) {
        const unsigned v = p[i];
        if (is_f32) { const unsigned e = (v >> 23) & 0xff; if (e >= 127 + 20) bad = true; }
        else { const unsigned e0 = (v >> 7) & 0xff, e1 = (v >> 23) & 0xff; if (e0 >= 127 + 20 || e1 >= 127 + 20) bad = true; }
    }
    if (bad) atomicOr((unsigned*)(P.ws_() + WS_SUM), 1u << ph);
}
__device__ __forceinline__ void chk_phase(const PV& P, int ph) {
    if (ph == 0) {
        chk_range(P, ph, WS_MOD, WS_S5BB - WS_MOD, 1, P.ws_()); chk_range(P, ph, WS_S5BB, WS_GLAT - WS_S5BB, 0, P.ws_());
        chk_range(P, ph, WS_GLAT, WS_WIN - WS_GLAT, 1, P.ws_()); chk_range(P, ph, WS_WIN, WS_HC - WS_WIN, 0, P.ws_()); return; }
    if (ph == NPHASE - 1) { chk_range(P, ph, 0, (size_t)MLAT * DM * 4, 1, P.out_()); return; }
    const int l = (ph - 1) / 8, sp = (ph - 1) % 8; const size_t Mres = l ? MLAT : MTOT;
    switch (sp) {
    case 0: chk_range(P, ph, WS_XN, (size_t)MTOT * DM * 2, 0, P.ws_()); break;
    case 1: chk_range(P, ph, WS_U, (size_t)MTOT * UW * 2 + (size_t)768 * MTOT * 2, 0, P.ws_()); break;
    case 2: chk_range(P, ph, WS_Y, (size_t)6 * MTOT * 256 * 2, 0, P.ws_()); chk_range(P, ph, WS_ZH, l ? (size_t)0 : (size_t)256 * MTOT * 2, 0, P.ws_()); break;
    case 3: case 5: chk_range(P, ph, WS_XN, Mres * DM * 2, 0, P.ws_()); break;
    case 4: case 7: chk_range(P, ph, 0, (size_t)MLAT * DM * 4, 1, P.out_()); if (!l) chk_range(P, ph, WS_HC, (size_t)MCTX * DM * 4, 1, P.ws_()); break;
    case 6: chk_range(P, ph, WS_U, Mres * DFF * 2, 0, P.ws_()); break;
    }
}
#endif
__global__ void __launch_bounds__(512, 2) fwd_mega(Params KP, int ph_lo, int ph_hi) {
    extern __shared__ __attribute__((aligned(16))) unsigned char smem[];
    LAS unsigned char* lds = (LAS unsigned char*)smem;
    if (ph_lo < 0) cg::this_grid().sync();
    unsigned nbar = 0;
    volatile LAS unsigned* xst = (volatile LAS unsigned*)(lds + LDS_BYTES - 16);
    if (threadIdx.x == 0) { xst[0] = 0u; xst[1] = 0u; }
    __syncthreads();
    const XcdBarrier xb = xcd_barrier_post((unsigned*)(KP.ws + WS_XBAR), xst);
    for (int ph = ph_lo; ph < ph_hi; ++ph) {
        if (ph >= 1 && ph < NPHASE - 1 && ((ph - 1) % NSP == 6 || ph == 1 + NSP)) continue;
        int z; asm volatile("s_mov_b32 %0, 0" : "=s"(z));
        int tidv = threadIdx.x; asm volatile("" : "+v"(tidv));
        const PV P{KP, z, tidv};
        run_phase(P, ph, lds);
#ifdef EXTRA_BAR
        if (ph == 9) for (int q = 0; q < EXTRA_BAR; ++q) { ++nbar; grid_barrier((unsigned*)(P.ws_() + WS_SUM), nbar, tidv); }
#endif
#ifdef REP_PHASE
        if (ph == REP_PHASE) { ++nbar; grid_barrier((unsigned*)(P.ws_() + WS_SUM), nbar, tidv); run_phase(P, ph, lds); }
#endif
        if (ph + 1 < ph_hi) { ++nbar; xcd_barrier(xb); }
    }
}


#ifdef DBG2
__global__ void dbg_zero(Params KP) { if (blockIdx.x == 0 && threadIdx.x < 8) ((unsigned*)(KP.ws + WS_SUM))[32 + threadIdx.x] = 0u; }
__global__ void dbg_count(Params KP, size_t off, size_t bytes, int slot, int is_out = 0) {
    const unsigned* p = is_out ? (const unsigned*)KP.out : (const unsigned*)(KP.ws + off); const size_t n = bytes / 4; unsigned bad = 0;
    for (size_t i = (size_t)blockIdx.x * blockDim.x + threadIdx.x; i < n; i += (size_t)gridDim.x * blockDim.x) { const unsigned e = (p[i] >> 23) & 0xff, e2 = (p[i] >> 7) & 0xff; if (e >= 147 || (!is_out && slot < 3 && e2 >= 147)) ++bad; }
    if (bad) atomicAdd((unsigned*)(KP.ws + WS_SUM) + 32 + slot, bad);
}
__global__ void dbg_out(Params KP) {
    const unsigned* c = (const unsigned*)(KP.ws + WS_SUM) + 32;
    float code = 1000.f * (float)(1 + (c[0] ? 1 : 0) + (c[1] ? 2 : 0) + (c[2] ? 4 : 0) + (c[3] ? 8 : 0));
    for (size_t i = (size_t)blockIdx.x * blockDim.x + threadIdx.x; i < (size_t)MLAT * DM; i += (size_t)gridDim.x * blockDim.x) KP.out[i] = (i == 0) ? code : 0.f;
}
#endif
extern "C" void kernel_launch(void* const* d_in, const int* in_sizes, int n_in, void* d_out, int out_size, void* d_ws, size_t ws_size, hipStream_t stream) {
    static int grid = 0;
    if (grid == 0) {
        if (n_in != 39 || out_size != MLAT * DM || ws_size < WS_END) { fprintf(stderr, "kernel_launch: unexpected shapes (n_in %d out %d ws %zu need %zu)\n", n_in, out_size, ws_size, (size_t)WS_END); grid = -1; return; }
        int dev = 0, cus = 0, per_cu = 0;
        hipGetDevice(&dev); hipDeviceGetAttribute(&cus, hipDeviceAttributeMultiprocessorCount, dev);
        hipFuncSetAttribute((const void*)fwd_mega, hipFuncAttributeMaxDynamicSharedMemorySize, LDS_BYTES);
        hipOccupancyMaxActiveBlocksPerMultiprocessor(&per_cu, (const void*)fwd_mega, 512, LDS_BYTES);
        if (per_cu < 1) { fprintf(stderr, "kernel_launch: occupancy query says %d blocks per CU\n", per_cu); per_cu = 1; }
        grid = cus;
        (void)hipGetLastError();
    }
    if (grid < 0) return;
    hipMemsetAsync((unsigned char*)d_ws + WS_SUM, 0, 256, stream);
    hipMemsetAsync((unsigned char*)d_ws + WS_XBAR, 0, 16384, stream);
    Params p{};
    for (int i = 0; i < 39; ++i) p.in[i] = (const float*)d_in[i];
    p.out = (float*)d_out; p.ws = (unsigned char*)d_ws;
#ifdef DBG2
    hipLaunchKernelGGL(dbg_zero, dim3(1), dim3(64), 0, stream, p);
    for (int ph = 0; ph < NPHASE; ++ph) {
        hipLaunchKernelGGL(fwd_mega, dim3(grid), dim3(512), LDS_BYTES, stream, p, ph, ph + 1);
        if (ph == 3) {
            hipLaunchKernelGGL(dbg_count, dim3(256), dim3(256), 0, stream, p, (size_t)WS_Y, (size_t)4 * MTOT * 256 * 2, 0, 0);
            hipLaunchKernelGGL(dbg_count, dim3(256), dim3(256), 0, stream, p, (size_t)WS_Y + (size_t)4 * MTOT * 256 * 2, (size_t)2 * MTOT * 256 * 2, 1, 0);
            hipLaunchKernelGGL(dbg_count, dim3(256), dim3(256), 0, stream, p, (size_t)WS_ZH, (size_t)256 * MTOT * 2, 2, 0);
        }
    }
    hipLaunchKernelGGL(dbg_count, dim3(256), dim3(256), 0, stream, p, (size_t)0, (size_t)MLAT * DM * 4, 3, 1);
    hipLaunchKernelGGL(dbg_out, dim3(256), dim3(256), 0, stream, p);
#elif ONE_LAUNCH
    int lo = 0, hi = NPHASE;
    void* args[] = {&p, &lo, &hi};
    hipError_t e = hipLaunchCooperativeKernel((const void*)fwd_mega, dim3(grid), dim3(512), args, LDS_BYTES, stream);
    if (e != hipSuccess) fprintf(stderr, "cooperative launch failed: %s (grid %d)\n", hipGetErrorString(e), grid);
#else
    for (int ph = 0; ph < NPHASE; ++ph) hipLaunchKernelGGL(fwd_mega, dim3(grid), dim3(512), LDS_BYTES, stream, p, ph, ph + 1);
#endif
}
```

```cpp
#include <hip/hip_runtime.h>
#include <hip/hip_cooperative_groups.h>
#include <cstdio>
#include <cstdint>
namespace cg = cooperative_groups;

#ifndef ONE_LAUNCH
#define ONE_LAUNCH 1
#endif

#define LAS __attribute__((address_space(3)))
typedef unsigned short bf16_t;
typedef short bf16x8 __attribute__((ext_vector_type(8)));
typedef float f32x4 __attribute__((ext_vector_type(4)));
typedef float f32x2 __attribute__((ext_vector_type(2)));
typedef unsigned u32x4 __attribute__((ext_vector_type(4)));
typedef unsigned u32x2 __attribute__((ext_vector_type(2)));

constexpr int DM = 1024, NB = 16, SEQ = 2048, CTX = 256;
constexpr int MLAT = NB * SEQ, MCTX = NB * CTX, MTOT = MLAT + MCTX;
constexpr int D_IN = 2696, NIN = 2816, DFF = 2816, UW = 1928;
constexpr int UC_Z = 0, UC_X = 256, UC_B = 512, UC_C = 576, UC_DT = 640, UC_Q = 648, UC_K = 904, UC_V = 1160, UC_G = 1416, UC_S5 = 1672;

constexpr size_t AL(size_t x) { return (x + 255) & ~(size_t)255; }
constexpr size_t WS_SUM = 0;
constexpr size_t WS_MOD = 8192;
constexpr size_t WS_S5AB = AL(WS_MOD + (size_t)2 * 17 * 6144 * 4);
constexpr size_t WS_S5BB = AL(WS_S5AB + (size_t)2 * 2 * 16 * 64 * 8);
constexpr size_t WS_S5CM = AL(WS_S5BB + (size_t)2 * 2 * 16 * 128 * 16 * 2);
constexpr size_t WS_GLAT = AL(WS_S5CM + (size_t)2 * 2 * 16 * 16 * 128 * 2);
constexpr size_t WS_GCTX = AL(WS_GLAT + (size_t)2 * 2 * 256 * 4096 * 4);
constexpr size_t WS_WIN = AL(WS_GCTX + (size_t)2 * 256 * 512 * 4);
constexpr size_t WS_WOUT = AL(WS_WIN + (size_t)2 * NIN * DM * 2);
constexpr size_t WS_WUP = AL(WS_WOUT + (size_t)2 * DM * DM * 2);
constexpr size_t WS_WDN = AL(WS_WUP + (size_t)2 * 2 * DFF * DM * 2);
constexpr size_t WS_WGLU = AL(WS_WDN + (size_t)2 * DM * DFF * 2);
constexpr size_t WS_HC = AL(WS_WGLU + (size_t)2 * 256 * 256 * 2);
constexpr size_t WS_XN = AL(WS_HC + (size_t)MCTX * DM * 4);
constexpr size_t WS_U = AL(WS_XN + (size_t)MTOT * DM * 2);
constexpr size_t WS_UH = WS_U + (size_t)MTOT * UW * 2;
constexpr size_t WS_Y = AL(WS_U + (size_t)MTOT * DFF * 2);
constexpr size_t WS_ZH = AL(WS_Y + (size_t)6 * MTOT * 256 * 2);
constexpr size_t WS_XBC = AL(WS_ZH + (size_t)256 * MTOT * 2);
constexpr size_t WS_SSQ = AL(WS_XBC + (size_t)MTOT * 384 * 2);
constexpr size_t WS_SWUP = AL(WS_SSQ + (size_t)MTOT * 4);
constexpr size_t WS_SSQ2 = AL(WS_SWUP + (size_t)2 * 17 * 2 * DFF * 4);
constexpr size_t WS_SWIN = AL(WS_SSQ2 + (size_t)MTOT * 4);
constexpr size_t WS_XBAR = AL(WS_SWIN + (size_t)17 * NIN * 4);
constexpr size_t WS_END = AL(WS_XBAR + 16384);
static_assert(WS_UH + (size_t)768 * MTOT * 2 <= WS_Y, "U/UH overlay");

constexpr int LDS_BYTES = 144 * 1024;

struct Params { const float* in[39]; float* out; unsigned char* ws; };
struct PV { const Params& K; int z; int tid;
    __device__ __forceinline__ const float* in_(int i) const { return K.in[i + z]; }
    __device__ __forceinline__ float* out_() const { return K.out + z; }
    __device__ __forceinline__ unsigned char* ws_() const { return K.ws + z; } };
enum { I_X = 0, I_C, I_CTX, I_CCTX, I_MODW, I_MODB, I_N1G, I_N2G, I_WIN, I_WOUT, I_SCW, I_SCB, I_SALOG, I_SDTB, I_SD, I_SNG,
       I_HCW, I_HCB, I_HW1, I_HB1, I_HFREQ, I_HW2, I_HB2, I_HW3, I_HBIAS, I_RDEC, I_5ARE, I_5AIM, I_5LDT, I_5BRE, I_5BIM,
       I_5CRE, I_5CIM, I_5D, I_5GW, I_5GB, I_FUP, I_FDN, I_FNG };

typedef __bf16 bf16x2_t __attribute__((ext_vector_type(2)));
__device__ __forceinline__ unsigned pk2(float lo, float hi) { const f32x2 v = {lo, hi}; const bf16x2_t b = __builtin_convertvector(v, bf16x2_t); return __builtin_bit_cast(unsigned, b); }
__device__ __forceinline__ bf16_t f2bf(float f) { return (bf16_t)(pk2(f, 0.f) & 0xffffu); }
__device__ __forceinline__ float bf2f(bf16_t b) { return __uint_as_float(((unsigned)b) << 16); }
__device__ __forceinline__ float bflo(unsigned w) { return __uint_as_float(w << 16); }
__device__ __forceinline__ float bfhi(unsigned w) { return __uint_as_float(w & 0xffff0000u); }
__device__ __forceinline__ void unpack8(u32x4 w, float* v) {
    v[0] = bflo(w.x); v[1] = bfhi(w.x); v[2] = bflo(w.y); v[3] = bfhi(w.y); v[4] = bflo(w.z); v[5] = bfhi(w.z); v[6] = bflo(w.w); v[7] = bfhi(w.w);
}
__device__ __forceinline__ u32x4 pack8(const float* v) { u32x4 w; w.x = pk2(v[0], v[1]); w.y = pk2(v[2], v[3]); w.z = pk2(v[4], v[5]); w.w = pk2(v[6], v[7]); return w; }
__device__ __forceinline__ float sigmoidf_(float x) { return __builtin_amdgcn_rcpf(1.f + __expf(-x)); }
__device__ __forceinline__ float siluf_(float x) { return x * __builtin_amdgcn_rcpf(1.f + __expf(-x)); }
__device__ __forceinline__ float softplusf_(float x) { return x > 20.f ? x : log1pf(__expf(x)); }
__device__ __forceinline__ float gelu_tanh(float x) { const float u = 0.7978845608f * (x + 0.044715f * x * x * x); return x * __builtin_amdgcn_rcpf(1.f + __expf(-2.f * u)); }
__device__ __forceinline__ float wave_sum(float v) {
#pragma unroll
    for (int o = 1; o < 64; o <<= 1) v += __shfl_xor(v, o);
    return v;
}
#define WAVE_SYNC() do { asm volatile("s_waitcnt lgkmcnt(0)" ::: "memory"); __builtin_amdgcn_wave_barrier(); } while (0)

namespace pg8 {
constexpr int BM = 256, BK = 64, HALF = 128, HTB = HALF * BK * 2, STAGE_BYTES = 8 * HTB, NXCD = 8, WGM = 8;
__host__ __device__ __forceinline__ int lds_byte(int r, int c) { const int st = (r >> 4) * 2 + (c >> 5), rr = r & 15, cc = c & 31, ob = rr * 64 + cc * 2; return st * 1024 + (ob ^ (((ob >> 9) & 1) << 5)); }
__host__ __device__ __forceinline__ void stage_rc(int b, int& R, int& C) { const int st = b / 1024, sb = b % 1024, swz = sb ^ (((sb >> 9) & 1) << 5); R = (st >> 1) * 16 + swz / 64; C = (st & 1) * 32 + (swz % 64) / 2; }
struct Unit { int pm, pn; };
struct Gemm { const bf16_t* A; const bf16_t* Bt; int M, N, K; };
struct StaticOrder {
    int nM, nN, nwg, G, c;
    __host__ __device__ void init(int M, int N, int G_, int c_) { nM = M / BM; nN = N / BM; nwg = nM * nN; G = G_; c = c_; }
    __host__ __device__ bool next(int i, Unit& u) const {
        const long L = (long)i * G + c; if (L >= nwg) return false;
        int wgid = (int)L; { const int q = nwg / NXCD, r = nwg % NXCD, xcd = wgid % NXCD, off = wgid / NXCD; wgid = (xcd < r ? xcd * (q + 1) : r * (q + 1) + (xcd - r) * q) + off; }
        const int nig = WGM * nN, gid = wgid / nig, fm = gid * WGM, gsz = (nM - fm) < WGM ? (nM - fm) : WGM;
        u.pm = fm + ((wgid % nig) % gsz); u.pn = (wgid % nig) / gsz; return true;
    }
};
struct LastWinOrder {
    StaticOrder lat; int G, c;
    __host__ __device__ void init(int G_, int c_) { lat.init(MLAT, NIN, G_, c_); G = G_; c = c_; }
    __host__ __device__ bool next(int i, Unit& u) const {
        const int L = i * G + c;
        if (L < lat.nwg) return lat.next(i, u);
        const int idx = L - lat.nwg; if (idx >= 16 * 8) return false;
        const int k = idx & 7; u.pm = MLAT / 256 + (idx >> 3); u.pn = k == 0 ? 1 : (k == 1 ? 2 : k + 3);
        return true;
    }
};
template <class Epi, class Sched>
__device__ __forceinline__ void gemm_phase(LAS unsigned char* lds, const Gemm g, const Sched& S, const Epi& E, const int tid) {
    const int wid = __builtin_amdgcn_readfirstlane(tid >> 6), lane = tid & 63, wr = wid >> 2, wc = wid & 3, fr = lane & 15, fq = lane >> 4;
    const int K = g.K, nt = K / BK;
    unsigned voffA[2];
#pragma unroll
    for (int i = 0; i < 2; ++i) { int R, C; stage_rc(tid * 16 + i * 8192, R, C); voffA[i] = (unsigned)(R * K + C) * 2u; }
    const size_t kstep = (size_t)(BK * 2);
    const size_t hstep = (size_t)HALF * K * 2;
    const size_t tstep = 2 * hstep;
    const unsigned ldsw = (unsigned)wid * 1024u;
    const int aoff = lds_byte(wr * 64 + fr, fq * 8), boff = lds_byte(wc * 32 + fr, fq * 8);
#define PG8_SA(b, h) (((b) * 2 + (h)) * HTB)
#define PG8_SB(b, h) ((4 + (b) * 2 + (h)) * HTB)
#define PG8_STAGE(bufoff, gbase, voff) do { _Pragma("unroll") for (int _i = 0; _i < 2; ++_i) \
        __builtin_amdgcn_global_load_lds((const unsigned*)((const char*)(gbase) + (voff)[_i]), (LAS unsigned*)(lds + (bufoff) + ldsw + _i * 8192), 16, 0, 0); } while (0)
#define PG8_LDA(dst, b, h) do { _Pragma("unroll") for (int m = 0; m < 4; ++m) _Pragma("unroll") for (int k = 0; k < 2; ++k) dst[m][k] = *(const LAS bf16x8*)(lds + PG8_SA(b, h) + aoff + m * 2048 + k * 1024); } while (0)
#define PG8_LDB(dst, b, h) do { _Pragma("unroll") for (int n = 0; n < 2; ++n) _Pragma("unroll") for (int k = 0; k < 2; ++k) dst[n][k] = *(const LAS bf16x8*)(lds + PG8_SB(b, h) + boff + n * 2048 + k * 1024); } while (0)
#define PG8_MMA(ai, bj, At, Bt) do { __builtin_amdgcn_s_setprio(1); _Pragma("unroll") for (int m = 0; m < 4; ++m) _Pragma("unroll") for (int n = 0; n < 2; ++n) _Pragma("unroll") for (int k = 0; k < 2; ++k) \
        acc[ai][bj][m][n] = __builtin_amdgcn_mfma_f32_16x16x32_bf16(Bt[n][k], At[m][k], acc[ai][bj][m][n], 0, 0, 0); __builtin_amdgcn_s_setprio(0); } while (0)
#define PG8_WAIT_V(n) asm volatile("s_waitcnt vmcnt(" #n ")" ::: "memory")
#define PG8_WAIT_L(n) asm volatile("s_waitcnt lgkmcnt(" #n ")" ::: "memory")
#define PG8_BAR __builtin_amdgcn_s_barrier()
#define PG8_SCHED __builtin_amdgcn_sched_barrier(0)
    Unit cur, nxt; int ui = 0;
    if (!S.next(0, cur)) return;
    f32x4 acc[2][2][4][2];
#pragma unroll
    for (int a = 0; a < 2; ++a)
#pragma unroll
        for (int b = 0; b < 2; ++b)
#pragma unroll
            for (int m = 0; m < 4; ++m)
#pragma unroll
                for (int n = 0; n < 2; ++n) acc[a][b][m][n] = (f32x4){0.f, 0.f, 0.f, 0.f};
    bf16x8 At[4][2], B0[2][2], B1[2][2];
    const char* cA = (const char*)g.A + (size_t)cur.pm * tstep; const char* cB = (const char*)g.Bt + (size_t)cur.pn * tstep;
    PG8_STAGE(PG8_SB(0, 0), cB, voffA); PG8_STAGE(PG8_SA(0, 0), cA, voffA); PG8_STAGE(PG8_SB(0, 1), cB + hstep, voffA); PG8_STAGE(PG8_SA(0, 1), cA + hstep, voffA);
    if (wr == 1) PG8_BAR;
    PG8_WAIT_V(4); PG8_BAR;
    PG8_STAGE(PG8_SB(1, 0), cB + kstep, voffA); PG8_STAGE(PG8_SA(1, 0), cA + kstep, voffA); PG8_STAGE(PG8_SB(1, 1), cB + hstep + kstep, voffA);
    PG8_WAIT_V(6); PG8_BAR;
    for (;;) {
        const bool has_next = S.next(ui + 1, nxt);
        const char* nA = has_next ? (const char*)g.A + (size_t)nxt.pm * tstep : cA; const char* nB = has_next ? (const char*)g.Bt + (size_t)nxt.pn * tstep : cB;
        for (int t = 0; t < nt; t += 2) {
            const bool last = (t == nt - 2);
            const char* a1 = cA + (size_t)(t + 1) * kstep;
            const char* a2 = last ? nA : cA + (size_t)(t + 2) * kstep; const char* b2 = last ? nB : cB + (size_t)(t + 2) * kstep;
            const char* a3 = a2 + kstep; const char* b3 = b2 + kstep;
            PG8_LDB(B0, 0, 0); PG8_SCHED; PG8_LDA(At, 0, 0); PG8_STAGE(PG8_SA(1, 1), a1 + hstep, voffA);
            PG8_WAIT_L(8); PG8_BAR; PG8_WAIT_L(0); PG8_MMA(0, 0, At, B0); PG8_BAR; PG8_SCHED;
            PG8_LDB(B1, 0, 1); PG8_STAGE(PG8_SB(0, 0), b2, voffA);
            PG8_BAR; PG8_WAIT_L(0); PG8_MMA(0, 1, At, B1); PG8_BAR;
            PG8_LDA(At, 0, 1); PG8_STAGE(PG8_SA(0, 0), a2, voffA);
            PG8_BAR; PG8_WAIT_L(0); PG8_MMA(1, 0, At, B0); PG8_BAR; PG8_SCHED;
            PG8_STAGE(PG8_SB(0, 1), b2 + hstep, voffA);
            PG8_WAIT_V(6); PG8_BAR; PG8_MMA(1, 1, At, B1); PG8_BAR;
            PG8_LDB(B0, 1, 0); PG8_SCHED; PG8_LDA(At, 1, 0); PG8_STAGE(PG8_SA(0, 1), a2 + hstep, voffA);
            PG8_WAIT_L(8); PG8_BAR; PG8_WAIT_L(0); PG8_MMA(0, 0, At, B0); PG8_BAR; PG8_SCHED;
            PG8_LDB(B1, 1, 1); PG8_STAGE(PG8_SB(1, 0), b3, voffA);
            PG8_BAR; PG8_WAIT_L(0); PG8_MMA(0, 1, At, B1); PG8_BAR;
            PG8_LDA(At, 1, 1); PG8_STAGE(PG8_SA(1, 0), a3, voffA);
            PG8_BAR; PG8_WAIT_L(0); PG8_MMA(1, 0, At, B0); PG8_BAR; PG8_SCHED;
            PG8_STAGE(PG8_SB(1, 1), b3 + hstep, voffA);
            PG8_WAIT_V(6); PG8_BAR; PG8_MMA(1, 1, At, B1); PG8_BAR;
        }
        E(acc, cur, wr, wc, fr, fq);
        if (!has_next) break;
#pragma unroll
        for (int a = 0; a < 2; ++a)
#pragma unroll
            for (int b = 0; b < 2; ++b)
#pragma unroll
                for (int m = 0; m < 4; ++m)
#pragma unroll
                    for (int n = 0; n < 2; ++n) acc[a][b][m][n] = (f32x4){0.f, 0.f, 0.f, 0.f};
        cur = nxt; cA = nA; cB = nB; ++ui;
    }
    PG8_WAIT_V(0);
    if (wr == 0) PG8_BAR;
    PG8_BAR;
#undef PG8_SA
#undef PG8_SB
#undef PG8_STAGE
#undef PG8_LDA
#undef PG8_LDB
#undef PG8_MMA
#undef PG8_WAIT_V
#undef PG8_WAIT_L
#undef PG8_BAR
#undef PG8_SCHED
}
}
using pg8::Unit;

struct EpiU {
    bf16_t* U; bf16_t* UH;
    __device__ __forceinline__ void operator()(const f32x4 (&acc)[2][2][4][2], const Unit& u, int wr, int wc, int fr, int fq) const {
#pragma unroll
        for (int ai = 0; ai < 2; ++ai)
#pragma unroll
            for (int m = 0; m < 4; ++m) {
                const int row = u.pm * 256 + ai * 128 + wr * 64 + m * 16 + fr;
#pragma unroll
                for (int bj = 0; bj < 2; ++bj)
#pragma unroll
                    for (int n = 0; n < 2; ++n) {
                        const int c = u.pn * 256 + bj * 128 + wc * 32 + n * 16 + 4 * fq;
                        const f32x4 v = acc[ai][bj][m][n];
                        if (c >= D_IN) continue;
                        if (c < 648 || c >= 1416) {
                            const int uc = c < 648 ? c : c - 768;
                            u32x2 w; w.x = pk2(v[0], v[1]); w.y = pk2(v[2], v[3]);
                            *(u32x2*)(U + (size_t)row * UW + uc) = w;
                        } else {
                            const int hc = c - 648;
#pragma unroll
                            for (int j = 0; j < 4; ++j) UH[(size_t)(hc + j) * MTOT + row] = f2bf(v[j]);
                        }
                    }
            }
    }
};
struct EpiRes {
    const float* oldL; const float* oldC; float* newL; float* newC; const float* gate;
    __device__ __forceinline__ void operator()(const f32x4 (&acc)[2][2][4][2], const Unit& u, int wr, int wc, int fr, int fq) const {
        const bool lat = u.pm < MLAT / 256;
        const float* gp = gate + (size_t)(lat ? (u.pm >> 3) : 16) * 6144;
#pragma unroll
        for (int bj = 0; bj < 2; ++bj) {
            f32x4 gt[2];
#pragma unroll
            for (int n = 0; n < 2; ++n) gt[n] = *(const f32x4*)(gp + u.pn * 256 + bj * 128 + wc * 32 + n * 16 + 4 * fq);
#pragma unroll
            for (int ai = 0; ai < 2; ++ai) {
                f32x4 o[4][2];
#pragma unroll
                for (int m = 0; m < 4; ++m) {
                    const int row = u.pm * 256 + ai * 128 + wr * 64 + m * 16 + fr;
                    const float* op = lat ? oldL + (size_t)row * DM : oldC + (size_t)(row - MLAT) * DM;
#pragma unroll
                    for (int n = 0; n < 2; ++n) o[m][n] = *(const f32x4*)(op + u.pn * 256 + bj * 128 + wc * 32 + n * 16 + 4 * fq);
                }
#pragma unroll
                for (int m = 0; m < 4; ++m) {
                    const int row = u.pm * 256 + ai * 128 + wr * 64 + m * 16 + fr;
                    float* np = lat ? newL + (size_t)row * DM : newC + (size_t)(row - MLAT) * DM;
#pragma unroll
                    for (int n = 0; n < 2; ++n) *(f32x4*)(np + u.pn * 256 + bj * 128 + wc * 32 + n * 16 + 4 * fq) = o[m][n] + gt[n] * acc[ai][bj][m][n];
                }
            }
        }
    }
};
struct EpiSwiglu {
    bf16_t* Act;
    __device__ __forceinline__ void operator()(const f32x4 (&acc)[2][2][4][2], const Unit& u, int wr, int wc, int fr, int fq) const {
#pragma unroll
        for (int ai = 0; ai < 2; ++ai)
#pragma unroll
            for (int m = 0; m < 4; ++m) {
                const int row = u.pm * 256 + ai * 128 + wr * 64 + m * 16 + fr;
#pragma unroll
                for (int bj = 0; bj < 2; ++bj) {
                    const int G = u.pn * 128 + bj * 64 + wc * 16 + 4 * fq;
                    const f32x4 g = acc[ai][bj][m][0], up = acc[ai][bj][m][1];
                    u32x2 w; w.x = pk2(siluf_(g[0]) * up[0], siluf_(g[1]) * up[1]); w.y = pk2(siluf_(g[2]) * up[2], siluf_(g[3]) * up[3]);
                    *(u32x2*)(Act + (size_t)row * DFF + G) = w;
                }
            }
    }
};


struct EpiResN {
    const float* oldL; const float* oldC; float* newL; float* newC; const float* gate; const float* g2; const float* scale2; bf16_t* A2; float* ssq;
    __device__ __forceinline__ void operator()(const f32x4 (&acc)[2][2][4][2], const Unit& u, int wr, int wc, int fr, int fq) const {
        const bool lat = u.pm < MLAT / 256;
        const int r = lat ? (u.pm >> 3) : 16;
        const float* gp = gate + (size_t)r * 6144; const float* sp = scale2 + (size_t)r * 6144;
#pragma unroll
        for (int bj = 0; bj < 2; ++bj) {
            f32x4 gt[2], gs[2];
#pragma unroll
            for (int n = 0; n < 2; ++n) { const int c = u.pn * 256 + bj * 128 + wc * 32 + n * 16 + 4 * fq;
                gt[n] = *(const f32x4*)(gp + c); gs[n] = *(const f32x4*)(g2 + c) * (*(const f32x4*)(sp + c) + 1.f); }
#pragma unroll
            for (int ai = 0; ai < 2; ++ai) {
                f32x4 o[4][2];
#pragma unroll
                for (int m = 0; m < 4; ++m) {
                    const int row = u.pm * 256 + ai * 128 + wr * 64 + m * 16 + fr;
                    const float* op = lat ? oldL + (size_t)row * DM : oldC + (size_t)(row - MLAT) * DM;
#pragma unroll
                    for (int n = 0; n < 2; ++n) o[m][n] = *(const f32x4*)(op + u.pn * 256 + bj * 128 + wc * 32 + n * 16 + 4 * fq);
                }
#pragma unroll
                for (int m = 0; m < 4; ++m) {
                    const int row = u.pm * 256 + ai * 128 + wr * 64 + m * 16 + fr;
                    float* np = lat ? newL + (size_t)row * DM : newC + (size_t)(row - MLAT) * DM;
                    float ss = 0.f;
#pragma unroll
                    for (int n = 0; n < 2; ++n) {
                        const int c = u.pn * 256 + bj * 128 + wc * 32 + n * 16 + 4 * fq;
                        const f32x4 hn = o[m][n] + gt[n] * acc[ai][bj][m][n];
                        *(f32x4*)(np + c) = hn;
                        ss += hn.x * hn.x + hn.y * hn.y + hn.z * hn.z + hn.w * hn.w;
                        const f32x4 a2 = hn * gs[n];
                        u32x2 w; w.x = pk2(a2.x, a2.y); w.y = pk2(a2.z, a2.w);
                        *(u32x2*)(A2 + (size_t)row * DM + c) = w;
                    }
                    ss += __shfl_xor(ss, 16); ss += __shfl_xor(ss, 32);
                    if (fq == 0) atomicAdd(ssq + row, ss);
                }
            }
        }
    }
};
struct EpiSwigluN {
    bf16_t* Act; const float* ssq; const float* sw;
    __device__ __forceinline__ void operator()(const f32x4 (&acc)[2][2][4][2], const Unit& u, int wr, int wc, int fr, int fq) const {
        const int r = u.pm < MLAT / 256 ? (u.pm >> 3) : 16;
        f32x4 swg[2], swu[2];
#pragma unroll
        for (int bj = 0; bj < 2; ++bj) { const int G = u.pn * 128 + bj * 64 + wc * 16 + 4 * fq; swg[bj] = *(const f32x4*)(sw + (size_t)r * 2 * DFF + G); swu[bj] = *(const f32x4*)(sw + (size_t)r * 2 * DFF + DFF + G); }
        float rs[2][4];
#pragma unroll
        for (int ai = 0; ai < 2; ++ai)
#pragma unroll
            for (int m = 0; m < 4; ++m) rs[ai][m] = ssq[u.pm * 256 + ai * 128 + wr * 64 + m * 16 + fr];
#pragma unroll
        for (int ai = 0; ai < 2; ++ai)
#pragma unroll
            for (int m = 0; m < 4; ++m) {
                const int row = u.pm * 256 + ai * 128 + wr * 64 + m * 16 + fr;
                const float rstd = rsqrtf(rs[ai][m] * (1.f / DM) + 1e-6f);
#pragma unroll
                for (int bj = 0; bj < 2; ++bj) {
                    const int G = u.pn * 128 + bj * 64 + wc * 16 + 4 * fq;
                    const f32x4 g = acc[ai][bj][m][0] * rstd + swg[bj], up = acc[ai][bj][m][1] * rstd + swu[bj];
                    u32x2 w; w.x = pk2(siluf_(g[0]) * up[0], siluf_(g[1]) * up[1]); w.y = pk2(siluf_(g[2]) * up[2], siluf_(g[3]) * up[3]);
                    *(u32x2*)(Act + (size_t)row * DFF + G) = w;
                }
            }
    }
};

struct EpiUN {
    bf16_t* U; bf16_t* UH; const float* ssq; const float* sw;
    __device__ __forceinline__ void operator()(const f32x4 (&acc)[2][2][4][2], const Unit& u, int wr, int wc, int fr, int fq) const {
        const int r = u.pm < MLAT / 256 ? (u.pm >> 3) : 16;
        f32x4 swv[2][2]; float rs[2][4];
#pragma unroll
        for (int bj = 0; bj < 2; ++bj)
#pragma unroll
            for (int n = 0; n < 2; ++n) swv[bj][n] = *(const f32x4*)(sw + (size_t)r * NIN + u.pn * 256 + bj * 128 + wc * 32 + n * 16 + 4 * fq);
#pragma unroll
        for (int ai = 0; ai < 2; ++ai)
#pragma unroll
            for (int m = 0; m < 4; ++m) rs[ai][m] = ssq[u.pm * 256 + ai * 128 + wr * 64 + m * 16 + fr];
#pragma unroll
        for (int ai = 0; ai < 2; ++ai)
#pragma unroll
            for (int m = 0; m < 4; ++m) {
                const int row = u.pm * 256 + ai * 128 + wr * 64 + m * 16 + fr;
                const float rstd = rsqrtf(rs[ai][m] * (1.f / DM) + 1e-6f);
#pragma unroll
                for (int bj = 0; bj < 2; ++bj)
#pragma unroll
                    for (int n = 0; n < 2; ++n) {
                        const int c = u.pn * 256 + bj * 128 + wc * 32 + n * 16 + 4 * fq;
                        const f32x4 v = acc[ai][bj][m][n] * rstd + swv[bj][n];
                        if (c >= D_IN) continue;
                        if (c < 648 || c >= 1416) {
                            const int uc = c < 648 ? c : c - 768;
                            u32x2 w; w.x = pk2(v[0], v[1]); w.y = pk2(v[2], v[3]);
                            *(u32x2*)(U + (size_t)row * UW + uc) = w;
                        } else {
                            const int hc = c - 648;
#pragma unroll
                            for (int j = 0; j < 4; ++j) UH[(size_t)(hc + j) * MTOT + row] = f2bf(v[j]);
                        }
                    }
            }
    }
};
template <class F>
__device__ __forceinline__ void transpose_item(const float* W, int K, int N, bf16_t* WT, LAS float* scr, int item, int nblk, int lane, F srccol) {
    const int kb = item / nblk, nb = item % nblk, k0 = 64 * kb, n0 = 32 * nb;
    const int sc = srccol(n0 + (lane & 31));
    float tv[32];
#pragma unroll
    for (int i = 0; i < 32; ++i) { const int kk = 2 * i + (lane >> 5); tv[i] = W[(size_t)(k0 + kk) * N + (sc >= 0 ? sc : 0)]; }
#pragma unroll
    for (int i = 0; i < 32; ++i) { const int kk = 2 * i + (lane >> 5); scr[kk * 33 + (lane & 31)] = sc >= 0 ? tv[i] : 0.f; }
    WAVE_SYNC();
    const int c = lane & 7;
#pragma unroll
    for (int j = 0; j < 4; ++j) { const int n = (lane >> 3) + 8 * j; const LAS float* s = scr + (8 * c) * 33 + n;
        u32x4 o; o.x = pk2(s[0 * 33], s[1 * 33]); o.y = pk2(s[2 * 33], s[3 * 33]); o.z = pk2(s[4 * 33], s[5 * 33]); o.w = pk2(s[6 * 33], s[7 * 33]);
        *(u32x4*)(WT + (size_t)(n0 + n) * K + k0 + 8 * c) = o; }
    WAVE_SYNC();
}

__device__ __forceinline__ void p0_weights(const PV& P, LAS unsigned char* lds, int gw, int ngw, int wave, int lane, int it_lo, int it_hi) {
    LAS float* scr = (LAS float*)(lds + wave * 8704);
    constexpr int I_IN = 16 * 88, I_OUT = 16 * 32, I_UP = 16 * 176, I_DN = 44 * 32, I_GLU = 4 * 8, I_LAYER = I_IN + I_OUT + I_UP + I_DN + I_GLU;
    for (int it = it_lo + gw; it < it_hi; it += ngw) {
        const int l = it / I_LAYER; int r = it % I_LAYER;
        if (r < I_IN) { transpose_item(P.in_(I_WIN) + (size_t)l * DM * D_IN, DM, D_IN, (bf16_t*)(P.ws_() + WS_WIN) + (size_t)l * NIN * DM, scr, r, 88, lane, [](int n) { return n < D_IN ? n : -1; }); continue; } r -= I_IN;
        if (r < I_OUT) { transpose_item(P.in_(I_WOUT) + (size_t)l * DM * DM, DM, DM, (bf16_t*)(P.ws_() + WS_WOUT) + (size_t)l * DM * DM, scr, r, 32, lane, [](int n) { return n; }); continue; } r -= I_OUT;
        if (r < I_UP) { transpose_item(P.in_(I_FUP) + (size_t)l * DM * 2 * DFF, DM, 2 * DFF, (bf16_t*)(P.ws_() + WS_WUP) + (size_t)l * 2 * DFF * DM, scr, r, 176, lane,
                                       [](int n) { const int q = n >> 5, rem = n & 31, G = q * 16 + (rem & 15); return rem < 16 ? G : DFF + G; }); continue; } r -= I_UP;
        if (r < I_DN) { transpose_item(P.in_(I_FDN) + (size_t)l * DFF * DM, DFF, DM, (bf16_t*)(P.ws_() + WS_WDN) + (size_t)l * DM * DFF, scr, r, 32, lane, [](int n) { return n; }); continue; } r -= I_DN;
        transpose_item(P.in_(I_5GW) + (size_t)l * 256 * 256, 256, 256, (bf16_t*)(P.ws_() + WS_WGLU) + (size_t)l * 256 * 256, scr, r, 8, lane, [](int n) { return n; });
    }
}

__device__ __forceinline__ void p0_mod(const PV& P, LAS unsigned char* lds, int blk, int nblk) {
    LAS float* sc = (LAS float*)lds;
    LAS float* red = (LAS float*)(lds + 17 * 1024 * 4);
    const int tid = P.tid;
    bool loaded = false;
    for (int it = blk; it < 192; it += nblk) {
        if (!loaded) {
            for (int i = tid; i < 17 * 1024; i += 512) { const float v = i < 16 * 1024 ? P.in_(I_C)[i] : P.in_(I_CCTX)[i - 16 * 1024]; sc[i] = siluf_(v); }
            loaded = true;
        }
        __syncthreads();
        const int l = it / 96, j0 = (it % 96) * 64, col = tid & 63, ks = tid >> 6;
        const float* w = P.in_(I_MODW) + (size_t)l * DM * 6144 + j0 + col;
        float a[17];
#pragma unroll
        for (int r = 0; r < 17; ++r) a[r] = 0.f;
#pragma unroll 1
        for (int k0 = ks * 128; k0 < ks * 128 + 128; k0 += 16) {
            float wv[16];
#pragma unroll
            for (int u = 0; u < 16; ++u) wv[u] = w[(size_t)(k0 + u) * 6144];
#pragma unroll
            for (int u = 0; u < 16; ++u)
#pragma unroll
                for (int r = 0; r < 17; ++r) a[r] += sc[r * 1024 + k0 + u] * wv[u];
        }
#pragma unroll
        for (int r = 0; r < 17; ++r) red[(ks * 17 + r) * 64 + col] = a[r];
        __syncthreads();
        for (int i = tid; i < 17 * 64; i += 512) {
            const int r = i >> 6, c = i & 63; float s = 0.f;
#pragma unroll
            for (int k = 0; k < 8; ++k) s += red[(k * 17 + r) * 64 + c];
            ((float*)(P.ws_() + WS_MOD))[((size_t)l * 17 + r) * 6144 + j0 + c] = s + P.in_(I_MODB)[(size_t)l * 6144 + j0 + c];
        }
    }
    __syncthreads();
}

__device__ __forceinline__ void p0_filter(const PV& P, LAS unsigned char* lds, int blk, int nblk, int it_lo, int it_hi) {
    LAS float* feats = (LAS float*)lds;
    LAS float* h1 = feats + 32 * 33;
    LAS float* h2 = h1 + 32 * 65;
    const int tid = P.tid, pl = tid & 31, part = tid >> 5;
    for (int it2 = 2 * it_lo + blk; it2 < 2 * it_hi; it2 += nblk) {
        const int it = it2 >> 1, half = it2 & 1;
        int l, kind, pb;
        if (it < 64) { l = 0; kind = 0; pb = it; } else if (it < 72) { l = 0; kind = 1; pb = it - 64; } else { l = 1; kind = 0; pb = it - 72; }
        const int L = kind ? CTX : SEQ, pos = pb * 32 + pl;
        const float tt = (float)pos / (float)(L - 1);
        const float w = (6.283185307179586f * (float)pos) / (float)L;
        __syncthreads();
        {
            const float band = 1e-4f + (float)part * ((15.0f - 1e-4f) / 15.0f);
            float sn, cs; sincosf(band * w, &sn, &cs);
            feats[pl * 33 + 1 + part] = cs; feats[pl * 33 + 17 + part] = -sn;
            if (part == 0) feats[pl * 33] = tt;
        }
        __syncthreads();
        const float* w1 = P.in_(I_HW1) + (size_t)l * 33 * 64; const float* b1 = P.in_(I_HB1) + l * 64; const float* fq = P.in_(I_HFREQ) + l * 64;
        const float* w2 = P.in_(I_HW2) + (size_t)l * 64 * 64; const float* b2 = P.in_(I_HB2) + l * 64; const float* w3 = P.in_(I_HW3) + (size_t)l * 64 * 1024;
        {
            float a[4];
#pragma unroll
            for (int o = 0; o < 4; ++o) a[o] = b1[part * 4 + o];
#pragma unroll 1
            for (int f0 = 0; f0 < 33; f0 += 11) {
                f32x4 wv[11];
#pragma unroll
                for (int u = 0; u < 11; ++u) wv[u] = *(const f32x4*)(w1 + (f0 + u) * 64 + part * 4);
#pragma unroll
                for (int u = 0; u < 11; ++u) { const float fv = feats[pl * 33 + f0 + u]; a[0] += fv * wv[u].x; a[1] += fv * wv[u].y; a[2] += fv * wv[u].z; a[3] += fv * wv[u].w; }
            }
#pragma unroll
            for (int o = 0; o < 4; ++o) h1[pl * 65 + part * 4 + o] = sinf(fq[part * 4 + o] * a[o]);
        }
        __syncthreads();
        {
            float a[4];
#pragma unroll
            for (int o = 0; o < 4; ++o) a[o] = b2[part * 4 + o];
#pragma unroll 1
            for (int k0 = 0; k0 < 64; k0 += 16) {
                f32x4 wv[16];
#pragma unroll
                for (int u = 0; u < 16; ++u) wv[u] = *(const f32x4*)(w2 + (k0 + u) * 64 + part * 4);
#pragma unroll
                for (int u = 0; u < 16; ++u) { const float hv = h1[pl * 65 + k0 + u]; a[0] += hv * wv[u].x; a[1] += hv * wv[u].y; a[2] += hv * wv[u].z; a[3] += hv * wv[u].w; }
            }
#pragma unroll
            for (int o = 0; o < 4; ++o) h2[pl * 65 + part * 4 + o] = sinf(fq[part * 4 + o] * a[o]);
        }
        __syncthreads();
        const int dir = part >> 3, order = (part >> 2) & 1;
        float* G = kind ? (float*)(P.ws_() + WS_GCTX) : (float*)(P.ws_() + WS_GLAT) + (size_t)l * 2 * 256 * 4096;
        const int GL = 2 * L;
        const float min_decay = -3.0701134573253945f, max_decay = -15.350567286626972f;
#pragma unroll 1
        for (int ps = 2 * half; ps < 2 * half + 2; ++ps) {
            float a[16];
#pragma unroll
            for (int o = 0; o < 16; ++o) a[o] = 0.f;
            const int c0 = part * 64 + ps * 16;
#pragma unroll 1
            for (int k0 = 0; k0 < 64; k0 += 4) {
                f32x4 wv[4][4];
#pragma unroll
                for (int u = 0; u < 4; ++u)
#pragma unroll
                    for (int q = 0; q < 4; ++q) wv[u][q] = ((const f32x4*)(w3 + (size_t)(k0 + u) * 1024 + c0))[q];
#pragma unroll
                for (int u = 0; u < 4; ++u) { const float hv = h2[pl * 65 + k0 + u];
#pragma unroll
                    for (int q = 0; q < 4; ++q) { a[4 * q] += hv * wv[u][q].x; a[4 * q + 1] += hv * wv[u][q].y; a[4 * q + 2] += hv * wv[u][q].z; a[4 * q + 3] += hv * wv[u][q].w; } }
            }
#pragma unroll
            for (int o = 0; o < 16; ++o) {
                const int col = c0 + o, ch = col & 255;
                const float delta = fabsf(min_decay + (float)col * ((max_decay - min_decay) / 1023.0f));
                float val = a[o] * expf(-tt * delta);
                int x = dir == 0 ? L - pos : L + pos;
                if (dir == 1 && pos == 0) { x = 0; val = 0.f; }
                G[(size_t)(order * 256 + ch) * GL + x] = val;
            }
        }
    }
    __syncthreads();
}

__device__ __forceinline__ void p0_s5(const PV& P, int gw, int ngw, int lane, int it_lo, int it_hi) {
    for (int it = it_lo + gw; it < it_hi; it += ngw) {
        const int l = it >> 5, dir = (it >> 4) & 1, g = it & 15, p = lane;
        const int idx = ((l * 2 + dir) * 16 + g);
        const float dt = expf(P.in_(I_5LDT)[idx]);
        const float are = P.in_(I_5ARE)[idx * 64 + p], aim = P.in_(I_5AIM)[idx * 64 + p];
        const float mag = expf(are * dt); float sn, cs; sincosf(aim * dt, &sn, &cs);
        const float abr = mag * cs, abi = mag * sn, den = are * are + aim * aim;
        const float zr = ((abr - 1.f) * are + abi * aim) / den, zi = (abi * are - (abr - 1.f) * aim) / den;
        ((f32x2*)(P.ws_() + WS_S5AB))[idx * 64 + p] = (f32x2){abr, abi};
        bf16_t* bb = (bf16_t*)(P.ws_() + WS_S5BB) + (size_t)idx * 128 * 16;
        const float* bre = P.in_(I_5BRE) + ((size_t)(l * 16 + g) * 64 + p) * 16; const float* bim = P.in_(I_5BIM) + ((size_t)(l * 16 + g) * 64 + p) * 16;
        for (int c = 0; c < 16; ++c) {
            const float br = bre[c], bi = bim[c];
            bb[p * 16 + c] = f2bf(zr * br - zi * bi);
            bb[(64 + p) * 16 + c] = f2bf(zr * bi + zi * br);
        }
        bf16_t* cm = (bf16_t*)(P.ws_() + WS_S5CM) + (size_t)idx * 16 * 128;
        for (int c = 0; c < 16; ++c) {
            cm[c * 128 + p] = f2bf(P.in_(I_5CRE)[((size_t)idx * 16 + c) * 64 + p]);
            cm[c * 128 + 64 + p] = f2bf(-P.in_(I_5CIM)[((size_t)idx * 16 + c) * 64 + p]);
        }
    }
}

__device__ __forceinline__ void norm_phase(const PV& P, int l, int which, int M, int gw, int ngw, int lane) {
    const float* gam = P.in_(which == 1 ? I_N1G : I_N2G) + l * DM;
    const float* mod = (const float*)(P.ws_() + WS_MOD) + (size_t)l * 17 * 6144;
    const int so = which == 1 ? 0 : 3 * DM, co = which == 1 ? DM : 4 * DM;
    const bool from_in = (l == 0 && which == 1);
    bf16_t* Xn = (bf16_t*)(P.ws_() + WS_XN);
    constexpr int NR = 3;
    auto row_src = [&](int row) __attribute__((always_inline)) {
        const bool lat = row < MLAT;
        return lat ? (from_in ? P.in_(I_X) : P.out_()) + (size_t)row * DM : (from_in ? P.in_(I_CTX) : (const float*)(P.ws_() + WS_HC)) + (size_t)(row - MLAT) * DM;
    };
    f32x4 nx[NR][4];
#pragma unroll
    for (int q = 0; q < NR; ++q) { const int rr = gw + q * ngw; const float* src = row_src(rr < M ? rr : gw);
#pragma unroll
        for (int j = 0; j < 4; ++j) nx[q][j] = *(const f32x4*)(src + 4 * lane + 256 * j); }
    for (int row0 = gw; row0 < M; row0 += NR * ngw) {
        f32x4 v[NR][4]; float ss[NR];
#pragma unroll
        for (int q = 0; q < NR; ++q)
#pragma unroll
            for (int j = 0; j < 4; ++j) v[q][j] = nx[q][j];
        const int nrow0 = row0 + NR * ngw;
        if (nrow0 < M) {
#pragma unroll
            for (int q = 0; q < NR; ++q) { const int rr = nrow0 + q * ngw; const float* src = row_src(rr < M ? rr : nrow0);
#pragma unroll
                for (int j = 0; j < 4; ++j) nx[q][j] = *(const f32x4*)(src + 4 * lane + 256 * j); }
        }
#pragma unroll
        for (int q = 0; q < NR; ++q) { float s_ = 0.f;
#pragma unroll
            for (int j = 0; j < 4; ++j) s_ += v[q][j].x * v[q][j].x + v[q][j].y * v[q][j].y + v[q][j].z * v[q][j].z + v[q][j].w * v[q][j].w;
            ss[q] = s_; }
#pragma unroll
        for (int q = 0; q < NR; ++q) {
            const int row = row0 + q * ngw;
            if (row < M) {
                const bool lat = row < MLAT;
                const float* mr = mod + (size_t)(lat ? (row >> 11) : 16) * 6144;
                const float rstd = rsqrtf(wave_sum(ss[q]) * (1.f / DM) + 1e-6f);
#pragma unroll
                for (int j = 0; j < 4; ++j) {
                    const int c = 4 * lane + 256 * j;
                    const f32x4 g = *(const f32x4*)(gam + c), sh = *(const f32x4*)(mr + so + c), sc = *(const f32x4*)(mr + co + c);
                    const f32x4 y = (v[q][j] * rstd * g) * (sc + 1.f) + sh;
                    u32x2 w; w.x = pk2(y.x, y.y); w.y = pk2(y.z, y.w);
                    *(u32x2*)(Xn + (size_t)row * DM + c) = w;
                }
            }
        }
    }
}

__device__ __forceinline__ void conv8(const bf16_t* Urow, bool hasPrev, bool hasNext, const float* w, int ws, const float* b, float* out) {
    float c0[8], cm[8], cp[8];
    unpack8(*(const u32x4*)Urow, c0);
    if (hasPrev) unpack8(*(const u32x4*)(Urow - UW), cm); else {
#pragma unroll
        for (int e = 0; e < 8; ++e) cm[e] = 0.f; }
    if (hasNext) unpack8(*(const u32x4*)(Urow + UW), cp); else {
#pragma unroll
        for (int e = 0; e < 8; ++e) cp[e] = 0.f; }
#pragma unroll
    for (int e = 0; e < 8; ++e) out[e] = b[e] + w[e] * cm[e] + w[ws + e] * c0[e] + w[2 * ws + e] * cp[e];
}


__device__ __forceinline__ void xbc_prepass(const PV& P, int l, int blk, int nblk) {
    const bf16_t* U = (const bf16_t*)(P.ws_() + WS_U); bf16_t* X = (bf16_t*)(P.ws_() + WS_XBC);
    const float* cw = P.in_(I_SCW) + (size_t)l * 3 * 384; const float* cb = P.in_(I_SCB) + (size_t)l * 384;
    const int c = (P.tid % 48) * 8, rsub = P.tid / 48;
    if (rsub >= 10) return;
    float w0[8], w1[8], w2[8], b8[8];
#pragma unroll
    for (int e = 0; e < 8; ++e) { w0[e] = cw[c + e]; w1[e] = cw[384 + c + e]; w2[e] = cw[768 + c + e]; b8[e] = cb[c + e]; }
    const int step = 2 * nblk * 10;
    auto row_of = [&](int rr, int fallback) __attribute__((always_inline)) { return rr < MTOT ? rr : fallback; };
    u32x4 nx[2][3];
    {
#pragma unroll
        for (int q = 0; q < 2; ++q) {
            const int row = row_of(blk * 10 + rsub + q * nblk * 10, blk * 10 + rsub);
            const bool lat = row < MLAT; const int t = lat ? (row & 2047) : ((row - MLAT) & 255); const bool hp = t > 0, hn = t < (lat ? SEQ : CTX) - 1;
            const bf16_t* Ur = U + (size_t)row * UW + UC_X + c;
            nx[q][1] = *(const u32x4*)Ur; nx[q][0] = *(const u32x4*)(Ur - (hp ? UW : 0)); nx[q][2] = *(const u32x4*)(Ur + (hn ? UW : 0));
        }
    }
    for (int row0 = blk * 10 + rsub; row0 < MTOT; row0 += step) {
        u32x4 r[2][3];
#pragma unroll
        for (int q = 0; q < 2; ++q)
#pragma unroll
            for (int k = 0; k < 3; ++k) r[q][k] = nx[q][k];
        if (row0 + step < MTOT) {
#pragma unroll
            for (int q = 0; q < 2; ++q) {
                const int row = row_of(row0 + step + q * nblk * 10, row0 + step);
                const bool lat = row < MLAT; const int t = lat ? (row & 2047) : ((row - MLAT) & 255); const bool hp = t > 0, hn = t < (lat ? SEQ : CTX) - 1;
                const bf16_t* Ur = U + (size_t)row * UW + UC_X + c;
                nx[q][1] = *(const u32x4*)Ur; nx[q][0] = *(const u32x4*)(Ur - (hp ? UW : 0)); nx[q][2] = *(const u32x4*)(Ur + (hn ? UW : 0));
            }
        }
#pragma unroll
        for (int q = 0; q < 2; ++q) {
            const int rr = row0 + q * nblk * 10; const bool ok = rr < MTOT; const int row = ok ? rr : row0;
            const bool lat = row < MLAT; const int t = lat ? (row & 2047) : ((row - MLAT) & 255); const bool hp = t > 0, hn = t < (lat ? SEQ : CTX) - 1;
            float xm[8], x0[8], xp[8], o[8];
            unpack8(r[q][0], xm); unpack8(r[q][1], x0); unpack8(r[q][2], xp);
#pragma unroll
            for (int e = 0; e < 8; ++e) o[e] = siluf_(b8[e] + w0[e] * (hp ? xm[e] : 0.f) + w1[e] * x0[e] + w2[e] * (hn ? xp[e] : 0.f));
            if (ok) *(u32x4*)(X + (size_t)row * 384 + c) = pack8(o);
        }
    }
}

constexpr int SC_QS = 0, SC_KS = 18432, SC_KT = 36864, SC_VT = 54272, SC_PM = 71680, SC_HT = 106496, SC_CS = 115712, SC_LA = 119808, SC_ROPE = 120320;
__device__ __forceinline__ void scan_item(const PV& P, LAS unsigned char* lds, int l, int kind, int b, int h, int dir) {
    const int tid = P.tid, lane = tid & 63, w = __builtin_amdgcn_readfirstlane(tid >> 6), fr = lane & 15, fq = lane >> 4;
    LAS bf16_t* Qs = (LAS bf16_t*)(lds + SC_QS); LAS bf16_t* Ks = (LAS bf16_t*)(lds + SC_KS); LAS bf16_t* Kt = (LAS bf16_t*)(lds + SC_KT);
    LAS bf16_t* Vt = (LAS bf16_t*)(lds + SC_VT); LAS bf16_t* Pm = (LAS bf16_t*)(lds + SC_PM); LAS bf16_t* Ht = (LAS bf16_t*)(lds + SC_HT);
    LAS float* cs_all = (LAS float*)(lds + SC_CS); LAS float* la = (LAS float*)(lds + SC_LA); LAS float* rope = (LAS float*)(lds + SC_ROPE);
    const bf16_t* U = (const bf16_t*)(P.ws_() + WS_U); const bf16_t* XBC = (const bf16_t*)(P.ws_() + WS_XBC);
    bf16_t* Y = (bf16_t*)(P.ws_() + WS_Y) + (size_t)((kind ? 2 : 0) + dir) * MTOT * 256;
    __syncthreads();
    for (int i = tid; i < 64 * 36; i += 512) ((LAS unsigned*)Ht)[i] = 0u;
    float a_dir = 0.f, dtb = 0.f;
    if (kind == 0) { a_dir = -expf(P.in_(I_SALOG)[(l * 2 + dir) * 4 + h]); dtb = P.in_(I_SDTB)[(l * 2 + dir) * 4 + h]; }
    else {
        a_dir = -expf(P.in_(I_RDEC)[(l * 2 + dir) * 4 + h]);
        for (int i = tid; i < 64 * 16; i += 512) { const int pos = i >> 4, fi = i & 15; const float inv = powf(10000.0f, -(float)fi / 16.0f); float sn, c; sincosf((float)pos * inv, &sn, &c); rope[i] = c; rope[1024 + i] = sn; }
    }
    const float* cw = P.in_(I_SCW) + (size_t)l * 3 * 384; const float* cb = P.in_(I_SCB) + (size_t)l * 384;
    f32x4 hacc[2] = {(f32x4){0.f, 0.f, 0.f, 0.f}, (f32x4){0.f, 0.f, 0.f, 0.f}};
    __syncthreads();
#define SC_DECL(IT) u32x4 rw##IT##a = {0u, 0u, 0u, 0u}, rw##IT##b = {0u, 0u, 0u, 0u}, rw##IT##c = {0u, 0u, 0u, 0u};
    SC_DECL(0) SC_DECL(1) SC_DECL(2) SC_DECL(3) SC_DECL(4) SC_DECL(5)
    bf16_t dtr0 = 0, dtr1 = 0;
#define SC_ISSUE(IT) { \
        const int k2 = (IT) & 1, mat = (IT) >> 1; \
        const int vi = tid + 512 * k2, i = vi >> 3, c8 = (vi & 7) * 8; \
        const int t = dir == 0 ? g_c0 + i : g_c0 + 127 - i; \
        const bf16_t* Ur = U + (size_t)(g_tokbase + t) * UW; \
        if (kind == 0) { \
            const int xcol = (mat == 0 ? h * 64 : (mat == 1 ? 256 : 320)) + c8; \
            rw##IT##a = *(const u32x4*)(XBC + (size_t)(g_tokbase + t) * 384 + xcol); \
            if (mat == 1) { if (k2 == 0) dtr0 = Ur[UC_DT + dir * 4 + h]; else dtr1 = Ur[UC_DT + dir * 4 + h]; } \
        } else { \
            const int ucol = (mat == 0 ? UC_V : (mat == 1 ? UC_K : UC_Q)) + h * 64; \
            rw##IT##a = *(const u32x4*)(Ur + ucol + c8); \
            if (mat != 0) rw##IT##b = *(const u32x4*)(Ur + ucol + (((c8 & 31) < 16) ? c8 + 16 : c8 - 16)); \
        } }
#define SC_ISSUE_ALL(CK) { \
        const int ck_ = (CK); const bool g_isctx = ck_ < 2; \
        const int g_Ls = g_isctx ? CTX : SEQ, g_nck = g_isctx ? 2 : 16, g_cidx = g_isctx ? ck_ : ck_ - 2; \
        const int g_c0 = (dir == 0 ? g_cidx : g_nck - 1 - g_cidx) * 128, g_tokbase = g_isctx ? MLAT + b * CTX : b * SEQ; \
        SC_ISSUE(0) SC_ISSUE(1) SC_ISSUE(2) SC_ISSUE(3) SC_ISSUE(4) SC_ISSUE(5) }
#define SC_PROC(IT) { \
        const int k2 = (IT) & 1, mat = (IT) >> 1; \
        const int vi = tid + 512 * k2, i = vi >> 3, c8 = (vi & 7) * 8; \
        const int t = dir == 0 ? c0 + i : c0 + 127 - i; \
        float x[8]; \
        if (kind == 0) { \
            unpack8(rw##IT##a, x); \
            if (mat == 1) { \
                const float dt = softplusf_(bf2f(k2 == 0 ? dtr0 : dtr1) + dtb); \
                _Pragma("unroll") for (int e = 0; e < 8; ++e) x[e] *= dt; \
                if (c8 == 0) la[i] = dt * a_dir; \
            } \
        } else { \
            unpack8(rw##IT##a, x); \
            if (mat != 0 && !isctx) { \
                const int half = c8 >> 5, e32 = c8 & 31; const bool first = e32 < 16; const int fi0 = e32 & 15; \
                float xp[8]; \
                unpack8(rw##IT##b, xp); \
                const int pos = half == 0 ? (t >> 6) : (t & 63); \
                _Pragma("unroll") for (int e = 0; e < 8; ++e) { \
                    const float c = rope[pos * 16 + fi0 + e], sn = rope[1024 + pos * 16 + fi0 + e]; \
                    x[e] = first ? x[e] * c - xp[e] * sn : xp[e] * sn + x[e] * c; } \
            } \
            if (mat == 1) { \
                _Pragma("unroll") for (int e = 0; e < 8; ++e) x[e] *= 0.125f; \
                if (c8 == 0) la[i] = a_dir; \
            } \
        } \
        if (mat == 0) { _Pragma("unroll") for (int e = 0; e < 8; ++e) Vt[(c8 + e) * 136 + (i ^ (c8 & 56))] = f2bf(x[e]); } \
        else if (mat == 1) *(LAS u32x4*)(Ks + i * 72 + c8) = pack8(x); \
        else *(LAS u32x4*)(Qs + i * 72 + c8) = pack8(x); }
    SC_ISSUE_ALL(0)
    for (int ck = 0; ck < 18; ++ck) {
        const bool isctx = ck < 2;
        const int Ls = isctx ? CTX : SEQ, nck = isctx ? 2 : 16, cidx = isctx ? ck : ck - 2;
        const int c0 = (dir == 0 ? cidx : nck - 1 - cidx) * 128;
        const int tokbase = isctx ? MLAT + b * CTX : b * SEQ;
        SC_PROC(0) SC_PROC(1) SC_PROC(2) SC_PROC(3) SC_PROC(4) SC_PROC(5)
#ifdef XP1
        asm volatile("" ::: "memory"); SC_PROC(0) SC_PROC(1) SC_PROC(2) SC_PROC(3) SC_PROC(4) SC_PROC(5)
#endif
        if (ck + 1 < 18) SC_ISSUE_ALL(ck + 1)
        __syncthreads();
        LAS float* cs = cs_all + w * 128;
        {
            const float a0 = la[2 * lane], a1 = la[2 * lane + 1];
            float s = a0 + a1;
#pragma unroll
            for (int o = 1; o < 64; o <<= 1) { const float tv = __shfl_up(s, o); if (lane >= o) s += tv; }
            cs[2 * lane] = s - a1; cs[2 * lane + 1] = s;
        }
        WAVE_SYNC();
        const float cs_end = cs[127];
#pragma unroll 1
        for (int k2 = 0; k2 < 2; ++k2) {
            const int vi = tid + 512 * k2, i = vi >> 3, c8 = (vi & 7) * 8;
            const float te = __expf(cs_end - cs[i]);
            float kv[8]; { const LAS unsigned* kp = (const LAS unsigned*)(Ks + i * 72 + c8); u32x4 kw; kw.x = kp[0]; kw.y = kp[1]; kw.z = kp[2]; kw.w = kp[3]; unpack8(kw, kv); }
#pragma unroll
            for (int e = 0; e < 8; ++e) Kt[(c8 + e) * 136 + (i ^ (c8 & 56))] = f2bf(kv[e] * te);
        }
#pragma unroll 1
        for (int k5 = 0; k5 < 5; ++k5) {
            const int id = w + 8 * k5;
            const int it = (id >= 2) + (id >= 4) + (id >= 8) + (id >= 12) + (id >= 18) + (id >= 24) + (id >= 32);
            const int cb0 = 2 * (id >= 2) + 2 * (id >= 4) + 4 * (id >= 8) + 4 * (id >= 12) + 6 * (id >= 18) + 6 * (id >= 24) + 8 * (id >= 32);
            const int jt = id - cb0, i0t = 16 * it;
            u32x2 pw;
            if (jt <= it) {
                const float csi = cs[i0t + fr];
                f32x4 acc = {0.f, 0.f, 0.f, 0.f};
#pragma unroll
                for (int kk = 0; kk < 2; ++kk) { const bf16x8 kf = *(const LAS bf16x8*)(Ks + (jt * 16 + fr) * 72 + kk * 32 + fq * 8); const bf16x8 qf = *(const LAS bf16x8*)(Qs + (i0t + fr) * 72 + kk * 32 + fq * 8);
                    acc = __builtin_amdgcn_mfma_f32_16x16x32_bf16(kf, qf, acc, 0, 0, 0); }
                const int j = jt * 16 + 4 * fq, i = i0t + fr;
                float pv[4];
#pragma unroll
                for (int r = 0; r < 4; ++r) pv[r] = (j + r <= i) ? acc[r] * __expf(csi - cs[j + r]) : 0.f;
                pw.x = pk2(pv[0], pv[1]); pw.y = pk2(pv[2], pv[3]);
            } else { pw.x = 0u; pw.y = 0u; }
            *(LAS u32x2*)(Pm + (i0t + fr) * 136 + jt * 16 + 4 * fq) = pw;
        }
        __syncthreads();
#pragma unroll
        for (int hh = 0; hh < 2; ++hh) {
            const int it = hh == 0 ? w : 7 - w, i0t = 16 * it;
            const int nk = (it >> 1) + 1;
            const float ecs = __expf(cs[i0t + fr]);
            const int i = i0t + fr, t = dir == 0 ? c0 + i : c0 + 127 - i;
            bf16_t* yrow = Y + (size_t)(tokbase + t) * 256 + h * 64;
            bf16x8 qf[2];
#pragma unroll
            for (int kk = 0; kk < 2; ++kk) qf[kk] = *(const LAS bf16x8*)(Qs + (i0t + fr) * 72 + kk * 32 + fq * 8);
#pragma unroll
            for (int pp = 0; pp < 2; ++pp) {
                const int pt = 2 * hh + pp;
                f32x4 a1 = {0.f, 0.f, 0.f, 0.f}, a2 = {0.f, 0.f, 0.f, 0.f};
                for (int kk = 0; kk < nk; ++kk) {
                    const bf16x8 vf = *(const LAS bf16x8*)(Vt + (pt * 16 + fr) * 136 + ((kk * 32 + fq * 8) ^ ((pt * 16 + fr) & 56)));
                    const bf16x8 pf = *(const LAS bf16x8*)(Pm + (i0t + fr) * 136 + kk * 32 + fq * 8);
                    a1 = __builtin_amdgcn_mfma_f32_16x16x32_bf16(vf, pf, a1, 0, 0, 0);
                }
#pragma unroll
                for (int kk = 0; kk < 2; ++kk) { const bf16x8 hf = *(const LAS bf16x8*)(Ht + (pt * 16 + fr) * 72 + kk * 32 + fq * 8); a2 = __builtin_amdgcn_mfma_f32_16x16x32_bf16(hf, qf[kk], a2, 0, 0, 0); }
                u32x2 yw; yw.x = pk2(a1[0] + ecs * a2[0], a1[1] + ecs * a2[1]); yw.y = pk2(a1[2] + ecs * a2[2], a1[3] + ecs * a2[3]);
                *(u32x2*)(yrow + pt * 16 + 4 * fq) = yw;
            }
        }
        {
            const float dec = __expf(cs_end);
#pragma unroll
            for (int q2 = 0; q2 < 2; ++q2) {
                const int id = 2 * w + q2, nt = id >> 2, pt = id & 3;
                hacc[q2] = hacc[q2] * dec;
#pragma unroll
                for (int kk = 0; kk < 4; ++kk) {
                    const bf16x8 kf = *(const LAS bf16x8*)(Kt + (nt * 16 + fr) * 136 + ((kk * 32 + fq * 8) ^ ((nt * 16 + fr) & 56)));
                    const bf16x8 vf = *(const LAS bf16x8*)(Vt + (pt * 16 + fr) * 136 + ((kk * 32 + fq * 8) ^ ((pt * 16 + fr) & 56)));
                    hacc[q2] = __builtin_amdgcn_mfma_f32_16x16x32_bf16(kf, vf, hacc[q2], 0, 0, 0);
                }
            }
        }
        __syncthreads();
#pragma unroll
        for (int q2 = 0; q2 < 2; ++q2) {
            const int id = 2 * w + q2, nt = id >> 2, pt = id & 3;
            u32x2 hw; hw.x = pk2(hacc[q2][0], hacc[q2][1]); hw.y = pk2(hacc[q2][2], hacc[q2][3]);
            *(LAS u32x2*)(Ht + (pt * 16 + fr) * 72 + nt * 16 + 4 * fq) = hw;
        }
    }
    __syncthreads();
}

template <bool WITH_Y>
__device__ __forceinline__ void s5_pass(const bf16_t* U, bf16_t* Y, LAS float* buL, LAS bf16_t* hL, const bf16x8 (&bbf)[8], const bf16x8 (&cmf)[4],
                                        const f32x2 ab, float& hre, float& him, int b, int dir, int g, int j0, int lane) {
    const int fr = lane & 15, fq = lane >> 4;
    auto tok_row = [&](int j) { const bool c = j < 16; const int Ls = c ? CTX : SEQ, jb = c ? j : j - 16; const int ti = jb * 16 + fr; return (c ? MLAT + b * CTX : b * SEQ) + (dir == 0 ? ti : Ls - 1 - ti); };
    const bf16_t* ucol = U + UC_S5 + g * 16 + (fq & 1) * 8;
    const unsigned umask = fq < 2 ? 0xffffffffu : 0u;
    u32x4 unext = *(const u32x4*)(ucol + (size_t)tok_row(j0) * UW);
    for (int j = j0; j < j0 + 36; ++j) {
        const int row = tok_row(j);
        u32x4 ucur = unext; ucur.x &= umask; ucur.y &= umask; ucur.z &= umask; ucur.w &= umask;
        unext = *(const u32x4*)(ucol + (size_t)tok_row(j < j0 + 35 ? j + 1 : j) * UW);
        const bf16x8 uf = __builtin_bit_cast(bf16x8, ucur);
#pragma unroll
        for (int T = 0; T < 8; ++T) {
            f32x4 d = {0.f, 0.f, 0.f, 0.f};
            d = __builtin_amdgcn_mfma_f32_16x16x32_bf16(bbf[T], uf, d, 0, 0, 0);
            *(LAS f32x4*)(buL + fr * 132 + 16 * T + 4 * fq) = d;
        }
        WAVE_SYNC();
        float br[16], bi[16];
#pragma unroll
        for (int i = 0; i < 16; ++i) { br[i] = buL[i * 132 + lane]; bi[i] = buL[i * 132 + 64 + lane]; }
#pragma unroll
        for (int i = 0; i < 16; ++i) {
            const float nr = ab.x * hre - ab.y * him + br[i], ni = ab.x * him + ab.y * hre + bi[i];
            hre = nr; him = ni;
            if (WITH_Y) { hL[i * 136 + lane] = f2bf(hre); hL[i * 136 + 64 + lane] = f2bf(him); }
        }
        WAVE_SYNC();
        if (WITH_Y) {
            f32x4 acc = {0.f, 0.f, 0.f, 0.f};
#pragma unroll
            for (int kk = 0; kk < 4; ++kk) { const bf16x8 hf = *(const LAS bf16x8*)(hL + fr * 136 + kk * 32 + fq * 8); acc = __builtin_amdgcn_mfma_f32_16x16x32_bf16(cmf[kk], hf, acc, 0, 0, 0); }
            u32x2 yw; yw.x = pk2(acc[0], acc[1]); yw.y = pk2(acc[2], acc[3]);
            *(u32x2*)(Y + (size_t)row * 256 + g * 16 + 4 * fq) = yw;
            WAVE_SYNC();
        }
    }
}
__device__ __forceinline__ void s5_block(const PV& P, LAS unsigned char* lds, int l, int item) {
    const int tid = P.tid, lane = tid & 63, wave = tid >> 6, fr = lane & 15, fq = lane >> 4;
    const int wi = item * 2 + (wave >> 2), ch = wave & 3, b = wi >> 5, dir = (wi >> 4) & 1, g = wi & 15;
    LAS unsigned char* wl = lds + wave * 12800;
    LAS float* buL = (LAS float*)wl;
    LAS bf16_t* hL = (LAS bf16_t*)(wl + 16 * 132 * 4);
    LAS float* ex = (LAS float*)(lds + 8 * 12800) + (wave >> 2) * 512;
    const int idx = (l * 2 + dir) * 16 + g;
    const f32x2 ab = ((const f32x2*)(P.ws_() + WS_S5AB))[idx * 64 + lane];
    const bf16_t* bb = (const bf16_t*)(P.ws_() + WS_S5BB) + (size_t)idx * 128 * 16;
    const bf16_t* cm = (const bf16_t*)(P.ws_() + WS_S5CM) + (size_t)idx * 16 * 128;
    const bf16x8 zero8 = {0, 0, 0, 0, 0, 0, 0, 0};
    bf16x8 bbf[8], cmf[4];
#pragma unroll
    for (int T = 0; T < 8; ++T) bbf[T] = fq < 2 ? *(const bf16x8*)(bb + (16 * T + fr) * 16 + fq * 8) : zero8;
#pragma unroll
    for (int kk = 0; kk < 4; ++kk) cmf[kk] = *(const bf16x8*)(cm + fr * 128 + kk * 32 + fq * 8);
    const bf16_t* U = (const bf16_t*)(P.ws_() + WS_U);
    bf16_t* Y = (bf16_t*)(P.ws_() + WS_Y) + (size_t)(4 + dir) * MTOT * 256;
    __syncthreads();
    float hre = 0.f, him = 0.f;
    s5_pass<false>(U, Y, buL, hL, bbf, cmf, ab, hre, him, b, dir, g, 36 * ch, lane);
    ex[ch * 128 + lane] = hre; ex[ch * 128 + 64 + lane] = him;
    __syncthreads();
    float ar = ab.x, ai = ab.y, a64r = 0.f, a64i = 0.f;
#pragma unroll
    for (int q = 0; q < 9; ++q) { const float nr = ar * ar - ai * ai, ni = 2.f * ar * ai; ar = nr; ai = ni; if (q == 5) { a64r = ar; a64i = ai; } }
    const float Ar = ar * a64r - ai * a64i, Ai = ar * a64i + ai * a64r;
    float sr = 0.f, si = 0.f;
    for (int j = 0; j < ch; ++j) { const float er = ex[j * 128 + lane], ei = ex[j * 128 + 64 + lane]; const float nr = Ar * sr - Ai * si + er, ni = Ar * si + Ai * sr + ei; sr = nr; si = ni; }
    hre = sr; him = si;
    s5_pass<true>(U, Y, buL, hL, bbf, cmf, ab, hre, him, b, dir, g, 36 * ch, lane);
    __syncthreads();
}

template <int L>
__device__ __forceinline__ void hyena_seg(const PV& P, LAS unsigned char* lds, int l, int ch, int tokbase0, int tokstride) {
    constexpr int TPW = L / 128, NS = L / 32, CPB = (2 * L + 8) * 2, ZROW = (L + 8) * 2, ZOFF = 8 * CPB;
    static_assert(ZOFF + 16 * ZROW <= LDS_BYTES, "hyena LDS");
    const int tid = P.tid, lane = tid & 63, w = __builtin_amdgcn_readfirstlane(tid >> 6), fr = lane & 15, fq = lane >> 4;
    const bf16_t* UH = (const bf16_t*)(P.ws_() + WS_UH);
    bf16_t* ZH = (bf16_t*)(P.ws_() + WS_ZH);
    const float* hcw = P.in_(I_HCW) + (size_t)l * 3 * 768; const float* hcb = P.in_(I_HCB) + (size_t)l * 768;
    LAS bf16_t* cop = (LAS bf16_t*)lds; LAS unsigned char* zs = lds + ZOFF;
    __syncthreads();
    {
        const bf16_t* src = UH + (size_t)(512 + ch) * MTOT;
        const float w0 = hcw[512 + ch], w1 = hcw[768 + 512 + ch], w2 = hcw[2 * 768 + 512 + ch], bz = hcb[512 + ch];
#pragma unroll
        for (int i = tid; i < 16 * L / 8; i += 512) {
            const int b = i / (L / 8), t0 = (i % (L / 8)) * 8; const bf16_t* sp = src + tokbase0 + (size_t)b * tokstride + t0;
            float v[10]; unpack8(*(const u32x4*)sp, v + 1);
            v[0] = t0 > 0 ? bf2f(sp[-1]) : 0.f; v[9] = t0 + 8 < L ? bf2f(sp[8]) : 0.f;
            float o[8];
#pragma unroll
            for (int e = 0; e < 8; ++e) o[e] = bz + w0 * v[e] + w1 * v[e + 1] + w2 * v[e + 2];
            *(LAS u32x4*)(zs + b * ZROW + t0 * 2) = pack8(o);
        }
    }
    for (int order = 0; order < 2; ++order) {
        const float* G = (L == SEQ) ? (const float*)(P.ws_() + WS_GLAT) + ((size_t)(l * 2 + order) * 256 + ch) * 4096 : (const float*)(P.ws_() + WS_GCTX) + ((size_t)order * 256 + ch) * 512;
        LAS float* red = (LAS float*)(lds + LDS_BYTES - 64);
        float sum = 0.f;
        for (int m = tid; m < 2 * L / 8 + 1; m += 512) {
            float gv[16];
#pragma unroll
            for (int q = 0; q < 4; ++q) { const int x0 = 8 * m - 8 + 4 * q; const bool ok = x0 >= 0 && x0 < 2 * L; const f32x4 t4 = ok ? *(const f32x4*)(G + x0) : (f32x4){0.f, 0.f, 0.f, 0.f};
                gv[4 * q] = t4.x; gv[4 * q + 1] = t4.y; gv[4 * q + 2] = t4.z; gv[4 * q + 3] = t4.w; }
#pragma unroll
            for (int e = 8; e < 16; ++e) sum += fabsf(gv[e]);
#pragma unroll
            for (int c = 0; c < 8; ++c) { const int pc = (8 - c) & 7;
                *(LAS u32x4*)((LAS unsigned char*)cop + c * CPB + 16 * m) = pack8(gv + 8 - pc); }
        }
        sum = wave_sum(sum);
        if (lane == 0) red[w] = sum;
        __syncthreads();
        sum = ((red[0] + red[1]) + (red[2] + red[3])) + ((red[4] + red[5]) + (red[6] + red[7]));
        const float inv = 1.f / (sum + 1e-6f);
        f32x4 acc[TPW];
#pragma unroll
        for (int m = 0; m < TPW; ++m) acc[m] = (f32x4){0.f, 0.f, 0.f, 0.f};
        const int cidx = (8 - (fr & 7)) & 7;
        const LAS unsigned char* fbase = lds + cidx * CPB + 2 * (L - (fr & 8) + 8 * fq);
        const LAS unsigned char* zbase = zs + fr * ZROW + fq * 16;
        if constexpr (TPW == 16) {
            bf16x8 fg[16];
#pragma unroll
            for (int m = 2; m < 16; ++m) fg[m] = *(const LAS bf16x8*)(fbase - 32 * (16 * w + m));
            for (int sb = 0; sb < NS / 8; ++sb) {
#pragma unroll
                for (int u = 0; u < 8; ++u) {
                    const int si = sb * 8 + u;
                    fg[(0 - 2 * u) & 15] = *(const LAS bf16x8*)(fbase - 32 * (16 * w - 2 * si));
                    fg[(1 - 2 * u) & 15] = *(const LAS bf16x8*)(fbase - 32 * (16 * w + 1 - 2 * si));
                    const bf16x8 zf = *(const LAS bf16x8*)(zbase + 64 * si);
#pragma unroll
                    for (int m = 0; m < 16; ++m) acc[m] = __builtin_amdgcn_mfma_f32_16x16x32_bf16(fg[(m - 2 * u) & 15], zf, acc[m], 0, 0, 0);
                }
            }
        } else {
            for (int si = 0; si < NS; ++si) {
                const bf16x8 zf = *(const LAS bf16x8*)(zbase + 64 * si);
#pragma unroll
                for (int m = 0; m < TPW; ++m) { const bf16x8 ff = *(const LAS bf16x8*)(fbase - 32 * (TPW * w + m - 2 * si)); acc[m] = __builtin_amdgcn_mfma_f32_16x16x32_bf16(ff, zf, acc[m], 0, 0, 0); }
            }
        }
        __syncthreads();
        {
            const int xc = order * 256 + ch;
            const float w0 = hcw[xc], w1 = hcw[768 + xc], w2 = hcw[2 * 768 + xc], bx = hcb[xc];
            const float bias = P.in_(I_HBIAS)[(size_t)(l * 2 + order) * 256 + ch];
            const bf16_t* xs = UH + (size_t)xc * MTOT + tokbase0 + (size_t)fr * tokstride;
#pragma unroll
            for (int m = 0; m < TPW; ++m) {
                const int t0 = 16 * (TPW * w + m) + 4 * fq;
                float xv[6];
                { const u32x2 xw = *(const u32x2*)(xs + t0); xv[1] = bflo(xw.x); xv[2] = bfhi(xw.x); xv[3] = bflo(xw.y); xv[4] = bfhi(xw.y);
                  xv[0] = t0 > 0 ? bf2f(xs[t0 - 1]) : 0.f; xv[5] = t0 + 4 < L ? bf2f(xs[t0 + 4]) : 0.f; }
                LAS u32x2* zp = (LAS u32x2*)(zs + fr * ZROW + t0 * 2);
                const u32x2 zo = *zp;
                const float zv[4] = {bflo(zo.x), bfhi(zo.x), bflo(zo.y), bfhi(zo.y)};
                float o[4];
#pragma unroll
                for (int r = 0; r < 4; ++r) { const float xg = bx + w0 * xv[r] + w1 * xv[r + 1] + w2 * xv[r + 2]; o[r] = xg * (acc[m][r] * inv + zv[r] * bias); }
                u32x2 ow; ow.x = pk2(o[0], o[1]); ow.y = pk2(o[2], o[3]);
                if (order == 0) *zp = ow;
                else *(u32x2*)(ZH + (size_t)ch * MTOT + tokbase0 + (size_t)fr * tokstride + t0) = ow;
            }
        }
        __syncthreads();
    }
}

constexpr int FZ_T = 0, FZ_V = 256 * 66 * 2;
template <int NROWS>
__device__ __forceinline__ void finalize_item(const PV& P, LAS unsigned char* lds, int l, int row0) {
    constexpr int NPASS = NROWS / 16, NC8 = NROWS / 8;
    const int tid = P.tid, lane = tid & 63, w = __builtin_amdgcn_readfirstlane(tid >> 6), fr = lane & 15, fq = lane >> 4;
    LAS bf16_t* T = (LAS bf16_t*)(lds + FZ_T); LAS bf16_t* Vs = (LAS bf16_t*)(lds + FZ_V);
    const bf16_t* U = (const bf16_t*)(P.ws_() + WS_U);
    const bf16_t* Yb = (const bf16_t*)(P.ws_() + WS_Y); const size_t YS = (size_t)MTOT * 256;
    __syncthreads();
    {
        const bf16_t* ZH = (const bf16_t*)(P.ws_() + WS_ZH);
#pragma unroll
        for (int i = tid; i < 256 * NC8; i += 512) { const int ch = i / NC8, c8 = (i % NC8) * 8; const u32x4 v = *(const u32x4*)(ZH + (size_t)ch * MTOT + row0 + c8);
            LAS unsigned* d = (LAS unsigned*)(T + ch * 66 + c8); d[0] = v.x; d[1] = v.y; d[2] = v.z; d[3] = v.w; }
    }
    __syncthreads();
    const int sub = tid & 31, c = sub * 8;
    const float* cw = P.in_(I_SCW) + (size_t)l * 3 * 384; const float* cb = P.in_(I_SCB) + (size_t)l * 384;
    const float dsk = P.in_(I_SD)[l * 4 + (sub >> 3)];
    const float* ng = P.in_(I_SNG) + l * 256;
    const float* d5 = P.in_(I_5D) + l * 256;
    bf16x8 wf[8][2];
    {
        const bf16_t* Wg0 = (const bf16_t*)(P.ws_() + WS_WGLU) + (size_t)l * 256 * 256;
#pragma unroll
        for (int kk = 0; kk < 8; ++kk)
#pragma unroll
            for (int a = 0; a < 2; ++a) wf[kk][a] = *(const bf16x8*)(Wg0 + (size_t)((2 * w + a) * 16 + fr) * 256 + kk * 32 + fq * 8);
    }
    struct FRaw { u32x4 rx0, rz, rg, ru5, y0, y1, y2, y3, y4, y5; };
    auto load_raw = [&](int pass) __attribute__((always_inline)) {
        const int row = row0 + pass * 16 + (tid >> 5);
        const bf16_t* Ur = U + (size_t)row * UW; const bf16_t* yp = Yb + (size_t)row * 256 + c;
        FRaw f;
        f.rx0 = *(const u32x4*)((const bf16_t*)(P.ws_() + WS_XBC) + (size_t)row * 384 + c);
        f.rz = *(const u32x4*)(Ur + UC_Z + c); f.rg = *(const u32x4*)(Ur + UC_G + c); f.ru5 = *(const u32x4*)(Ur + UC_S5 + c);
        f.y0 = *(const u32x4*)(yp); f.y1 = *(const u32x4*)(yp + YS); f.y2 = *(const u32x4*)(yp + 2 * YS); f.y3 = *(const u32x4*)(yp + 3 * YS); f.y4 = *(const u32x4*)(yp + 4 * YS); f.y5 = *(const u32x4*)(yp + 5 * YS);
        return f;
    };
    float ng8[8], d58[8];
#pragma unroll
    for (int e = 0; e < 8; ++e) { ng8[e] = ng[c + e]; d58[e] = d5[c + e]; }
    FRaw nx = load_raw(0);
#pragma unroll 1
    for (int pass = 0; pass < NPASS; ++pass) {
        const int tk = pass * 16 + (tid >> 5), row = row0 + tk;
        bf16_t* Yc = (bf16_t*)(P.ws_() + WS_XN) + (size_t)row * DM;
        const FRaw cur = nx;
        if (pass + 1 < NPASS) nx = load_raw(pass + 1);
        const u32x4 rx0 = cur.rx0, rz = cur.rz, rg = cur.rg, ru5 = cur.ru5, y0 = cur.y0, y1 = cur.y1, y2 = cur.y2, y3 = cur.y3, y4 = cur.y4, y5 = cur.y5;
        {
            float v[8], x0[8], z[8], yf[8], yb[8]; float ss = 0.f;
            unpack8(rx0, x0); unpack8(rz, z); unpack8(y0, yf); unpack8(y1, yb);
#pragma unroll
            for (int e = 0; e < 8; ++e) { const float y = yf[e] + yb[e] + x0[e] * dsk; const float o = y * siluf_(z[e]); v[e] = o; ss += o * o; }
#pragma unroll
            for (int sh = 1; sh < 32; sh <<= 1) ss += __shfl_xor(ss, sh);
            const float rstd = rsqrtf(ss * (1.f / 256.f) + 1e-6f);
#pragma unroll
            for (int e = 0; e < 8; ++e) v[e] = v[e] * rstd * ng8[e];
            *(u32x4*)(Yc + c) = pack8(v);
        }
        {
            u32x4 o; unsigned short e8[8];
#pragma unroll
            for (int e = 0; e < 8; ++e) e8[e] = T[(c + e) * 66 + tk];
            o.x = e8[0] | ((unsigned)e8[1] << 16); o.y = e8[2] | ((unsigned)e8[3] << 16); o.z = e8[4] | ((unsigned)e8[5] << 16); o.w = e8[6] | ((unsigned)e8[7] << 16);
            *(u32x4*)(Yc + 256 + c) = o;
        }
        {
            float v[8], yf[8], yb[8], g[8]; float sm = 0.f;
            unpack8(y2, yf); unpack8(y3, yb); unpack8(rg, g);
#pragma unroll
            for (int e = 0; e < 8; ++e) { v[e] = yf[e] + yb[e]; sm += v[e]; }
            sm += __shfl_xor(sm, 1); sm += __shfl_xor(sm, 2); sm += __shfl_xor(sm, 4);
            const float mu = sm * (1.f / 64.f); float vs = 0.f;
#pragma unroll
            for (int e = 0; e < 8; ++e) { const float d = v[e] - mu; vs += d * d; }
            vs += __shfl_xor(vs, 1); vs += __shfl_xor(vs, 2); vs += __shfl_xor(vs, 4);
            const float rstd = rsqrtf(vs * (1.f / 64.f) + 1e-6f);
#pragma unroll
            for (int e = 0; e < 8; ++e) v[e] = siluf_(g[e]) * (v[e] - mu) * rstd;
            *(u32x4*)(Yc + 512 + c) = pack8(v);
        }
        {
            float u[8], yf[8], yb[8], o[8];
            unpack8(ru5, u); unpack8(y4, yf); unpack8(y5, yb);
#pragma unroll
            for (int e = 0; e < 8; ++e) o[e] = gelu_tanh(u[e] * d58[e] + yf[e] + yb[e]);
            *(LAS u32x4*)(Vs + tk * 264 + c) = pack8(o);
        }
    }
    __syncthreads();
    {
        const bf16_t* Wg = (const bf16_t*)(P.ws_() + WS_WGLU) + (size_t)l * 256 * 256;
        const float* gb = P.in_(I_5GB) + l * 256;
        f32x4 acc[2][NPASS];
#pragma unroll
        for (int a = 0; a < 2; ++a)
#pragma unroll
            for (int m = 0; m < NPASS; ++m) acc[a][m] = (f32x4){0.f, 0.f, 0.f, 0.f};
#pragma unroll
        for (int kk = 0; kk < 8; ++kk) {
            bf16x8 vf[NPASS];
#pragma unroll
            for (int m = 0; m < NPASS; ++m) vf[m] = *(const LAS bf16x8*)(Vs + (m * 16 + fr) * 264 + kk * 32 + fq * 8);
#pragma unroll
            for (int a = 0; a < 2; ++a)
#pragma unroll
                for (int m = 0; m < NPASS; ++m) acc[a][m] = __builtin_amdgcn_mfma_f32_16x16x32_bf16(wf[kk][a], vf[m], acc[a][m], 0, 0, 0);
        }
#pragma unroll
        for (int a = 0; a < 2; ++a)
#pragma unroll
            for (int m = 0; m < NPASS; ++m) {
                const int n = (2 * w + a) * 16 + 4 * fq, tkk = m * 16 + fr;
                const u32x2 vv = *(const LAS u32x2*)(Vs + tkk * 264 + n);
                const float v4[4] = {bflo(vv.x), bfhi(vv.x), bflo(vv.y), bfhi(vv.y)};
                float o[4];
#pragma unroll
                for (int r = 0; r < 4; ++r) o[r] = v4[r] * sigmoidf_(acc[a][m][r] + gb[n + r]);
                u32x2 ow; ow.x = pk2(o[0], o[1]); ow.y = pk2(o[2], o[3]);
                *(u32x2*)((bf16_t*)(P.ws_() + WS_XN) + (size_t)(row0 + tkk) * DM + 768 + n) = ow;
            }
    }
    __syncthreads();
}

__device__ __forceinline__ void final_norm(const PV& P, int gw, int ngw, int lane) {
    const float* g = P.in_(I_FNG);
    constexpr int NR = 4;
    f32x4 nx[NR][4];
#pragma unroll
    for (int q = 0; q < NR; ++q)
#pragma unroll
        for (int j = 0; j < 4; ++j) nx[q][j] = *(const f32x4*)(P.out_() + (size_t)(gw + q * ngw) * DM + 4 * lane + 256 * j);
    for (int row0 = gw; row0 < MLAT; row0 += NR * ngw) {
        f32x4 v[NR][4]; float ss[NR];
#pragma unroll
        for (int q = 0; q < NR; ++q)
#pragma unroll
            for (int j = 0; j < 4; ++j) v[q][j] = nx[q][j];
        if (row0 + NR * ngw < MLAT) {
#pragma unroll
            for (int q = 0; q < NR; ++q)
#pragma unroll
                for (int j = 0; j < 4; ++j) nx[q][j] = *(const f32x4*)(P.out_() + (size_t)(row0 + NR * ngw + q * ngw) * DM + 4 * lane + 256 * j);
        }
#pragma unroll
        for (int q = 0; q < NR; ++q) { float s_ = 0.f;
#pragma unroll
            for (int j = 0; j < 4; ++j) s_ += v[q][j].x * v[q][j].x + v[q][j].y * v[q][j].y + v[q][j].z * v[q][j].z + v[q][j].w * v[q][j].w;
            ss[q] = s_; }
#pragma unroll
        for (int q = 0; q < NR; ++q) {
            const float rstd = rsqrtf(wave_sum(ss[q]) * (1.f / DM) + 1e-6f);
#pragma unroll
            for (int j = 0; j < 4; ++j) { const f32x4 gg = *(const f32x4*)(g + 4 * lane + 256 * j); *(f32x4*)(P.out_() + (size_t)(row0 + q * ngw) * DM + 4 * lane + 256 * j) = v[q][j] * rstd * gg; }
        }
    }
}

__device__ __forceinline__ void sw_items(const PV& P, LAS unsigned char* lds, int lb, int nlb, int it_lo, int it_hi) {
    LAS float* sc = (LAS float*)lds;
    LAS float* red = (LAS float*)(lds + 17 * 1024 * 4);
    const int tid = P.tid;
    for (int it = it_lo + lb; it < it_hi; it += nlb) {
        const bool win = it >= 176;
        const int l = win ? 1 : it / 88, j0 = (win ? it - 176 : it % 88) * 64, col = tid & 63, ks = tid >> 6;
        const int WN = win ? D_IN : 2 * DFF, soff = win ? 0 : 3 * DM;
        const bool cvalid = j0 + col < WN;
        __syncthreads();
        for (int i = tid; i < 17 * 1024; i += 512) sc[i] = ((const float*)(P.ws_() + WS_MOD))[((size_t)l * 17 + (i >> 10)) * 6144 + soff + (i & 1023)];
        __syncthreads();
        const float* w = (win ? P.in_(I_WIN) + (size_t)DM * D_IN : P.in_(I_FUP) + (size_t)l * DM * 2 * DFF) + (cvalid ? j0 + col : 0);
        float a[17];
#pragma unroll
        for (int r = 0; r < 17; ++r) a[r] = 0.f;
#pragma unroll 1
        for (int k0 = ks * 128; k0 < ks * 128 + 128; k0 += 16) {
            float wv[16];
#pragma unroll
            for (int u = 0; u < 16; ++u) wv[u] = w[(size_t)(k0 + u) * WN];
#pragma unroll
            for (int u = 0; u < 16; ++u)
#pragma unroll
                for (int r = 0; r < 17; ++r) a[r] += sc[r * 1024 + k0 + u] * wv[u];
        }
#pragma unroll
        for (int r = 0; r < 17; ++r) red[(ks * 17 + r) * 64 + col] = a[r];
        __syncthreads();
        for (int i = tid; i < 17 * 64; i += 512) {
            const int r = i >> 6, c = i & 63; float sm = 0.f;
#pragma unroll
            for (int k = 0; k < 8; ++k) sm += red[(k * 17 + r) * 64 + c];
            if (win) ((float*)(P.ws_() + WS_SWIN))[(size_t)r * NIN + j0 + c] = (j0 + c < D_IN) ? sm : 0.f;
            else ((float*)(P.ws_() + WS_SWUP))[((size_t)l * 17 + r) * 2 * DFF + j0 + c] = sm;
        }
    }
    __syncthreads();
}
__device__ __forceinline__ void deferred_work(const PV& P, LAS unsigned char* lds, int which, int first_idle) {
    const int tid = P.tid, lane = tid & 63, wave = tid >> 6, blk = blockIdx.x, nblk = gridDim.x;
    if (blk < first_idle) return;
    const int lb = blk - first_idle, nlb = nblk - first_idle, lgw = lb * 8 + wave, nlgw = nlb * 8;
    constexpr int I_LAYER = 16 * 88 + 16 * 32 + 16 * 176 + 44 * 32 + 4 * 8;
    __syncthreads();
    if (which == 0) {
        p0_filter(P, lds, lb, nlb, 0, 72);
        __syncthreads();
        p0_s5(P, lgw, nlgw, lane, 0, 32);
        p0_weights(P, lds, lgw, nlgw, wave, lane, 1408, 1920);
        p0_weights(P, lds, lgw, nlgw, wave, lane, I_LAYER - 32, I_LAYER);
    } else if (which == 1) {
        p0_weights(P, lds, lgw, nlgw, wave, lane, 1920, I_LAYER - 32);
        __syncthreads();
        sw_items(P, lds, lb, nlb, 0, 88);
    } else {
        p0_filter(P, lds, lb, nlb, 72, 136);
        __syncthreads();
        sw_items(P, lds, lb, nlb, 88, 220);
        p0_s5(P, lgw, nlgw, lane, 32, 64);
        p0_weights(P, lds, lgw, nlgw, wave, lane, I_LAYER, 2 * I_LAYER);
    }
    __syncthreads();
}
constexpr int NSP = 9;
constexpr int NPHASE = 1 + 2 * NSP + 1;

__device__ __forceinline__ void run_phase(const PV& P, int ph, LAS unsigned char* lds) {
    const int tid = P.tid, lane = tid & 63, wave = tid >> 6;
    const int blk = blockIdx.x, nblk = gridDim.x, gw = blk * 8 + wave, ngw = nblk * 8;
#ifndef PHMASK
#define PHMASK 0xffff
#endif
    if (ph == 0) {
        if (PHMASK & 1) p0_mod(P, lds, blk, nblk);
        return;
    }
    if (ph == NPHASE - 1) { if (PHMASK & 16) final_norm(P, gw, ngw, lane); return; }
    const int l = (ph - 1) / NSP, sp = (ph - 1) % NSP;
    const bool last = (l == 1);
    const int Mall = MTOT, Mres = last ? MLAT : MTOT;
    pg8::StaticOrder S;
    switch (sp) {
    case 0: if (PHMASK & 16) norm_phase(P, l, 1, Mall, gw, ngw, lane);
            if (l == 0) { __syncthreads(); p0_weights(P, lds, gw, ngw, wave, lane, 0, 1408); }
            break;
    case 1: if (PHMASK & 32) { pg8::Gemm g{(const bf16_t*)(P.ws_() + WS_XN), (const bf16_t*)(P.ws_() + WS_WIN) + (size_t)l * NIN * DM, Mall, NIN, DM};
              EpiU E{(bf16_t*)(P.ws_() + WS_U), (bf16_t*)(P.ws_() + WS_UH)};
              if (l == 0) { S.init(Mall, NIN, nblk, blk); pg8::gemm_phase(lds, g, S, E, P.tid); deferred_work(P, lds, 0, (Mall / 256 * (NIN / 256)) % nblk); }
              else { pg8::LastWinOrder S1; S1.init(nblk, blk); EpiUN E1{(bf16_t*)(P.ws_() + WS_U), (bf16_t*)(P.ws_() + WS_UH), (const float*)(P.ws_() + WS_SSQ2), (const float*)(P.ws_() + WS_SWIN)};
                     pg8::gemm_phase(lds, g, S1, E1, P.tid); } } break;
    case 2: {
#ifndef REP_SUB
#define REP_SUB 0
#endif
        for (int rep = 0; rep < ((REP_SUB == 1 && l == 0) ? 2 : 1); ++rep)
        xbc_prepass(P, l, blk, nblk);
        if (PHMASK & 64) for (int it = blk; it < 256; it += nblk) {
            hyena_seg<SEQ>(P, lds, l, it, 0, SEQ);
            if (!last) hyena_seg<CTX>(P, lds, l, it, MLAT, CTX);
        }
        for (int rep = 0; rep < ((REP_SUB == 3 && l == 0) ? 2 : 1); ++rep)
        if (PHMASK & 256) for (int it = blk; it < 256; it += nblk) s5_block(P, lds, l, it);
        __syncthreads();
    } break;
    case 3:
        if (PHMASK & 128) for (int it = blk; it < 256; it += nblk) { const int kind = it >> 7, r = it & 127; scan_item(P, lds, l, kind, r >> 3, (r >> 1) & 3, r & 1); }
        break;
    case 4: for (int i = blk * 512 + tid; i < MTOT; i += nblk * 512) { ((float*)(P.ws_() + WS_SSQ))[i] = 0.f; if (l == 0) ((float*)(P.ws_() + WS_SSQ2))[i] = 0.f; }
            if (PHMASK & 512) { if (last) { for (int it = blk; it < MLAT / 64; it += nblk) finalize_item<64>(P, lds, l, it * 64); }
                                else { for (int it = blk; it < MTOT / 48; it += nblk) finalize_item<48>(P, lds, l, it * 48); } } break;
    case 5: if (PHMASK & 1024) { pg8::Gemm g{(const bf16_t*)(P.ws_() + WS_XN), (const bf16_t*)(P.ws_() + WS_WOUT) + (size_t)l * DM * DM, Mres, DM, DM};
              S.init(Mres, DM, nblk, blk);
              EpiResN E{l == 0 ? P.in_(I_X) : P.out_(), l == 0 ? P.in_(I_CTX) : (const float*)(P.ws_() + WS_HC), P.out_(), (float*)(P.ws_() + WS_HC), (const float*)(P.ws_() + WS_MOD) + (size_t)l * 17 * 6144 + 2 * DM,
                        P.in_(I_N2G) + l * DM, (const float*)(P.ws_() + WS_MOD) + (size_t)l * 17 * 6144 + 4 * DM, (bf16_t*)(P.ws_() + WS_Y), (float*)(P.ws_() + WS_SSQ)};
              pg8::gemm_phase(lds, g, S, E, P.tid); if (l == 0) deferred_work(P, lds, 1, (Mres / 256 * 4) % nblk); } break;
    case 6: break;
    case 7: if (PHMASK & 2048) { pg8::Gemm g{(const bf16_t*)(P.ws_() + WS_Y), (const bf16_t*)(P.ws_() + WS_WUP) + (size_t)l * 2 * DFF * DM, Mres, 2 * DFF, DM};
              S.init(Mres, 2 * DFF, nblk, blk); EpiSwigluN E{(bf16_t*)(P.ws_() + WS_U), (const float*)(P.ws_() + WS_SSQ), (const float*)(P.ws_() + WS_SWUP) + (size_t)l * 17 * 2 * DFF}; pg8::gemm_phase(lds, g, S, E, P.tid); } break;
    case 8: if (PHMASK & 4096) { pg8::Gemm g{(const bf16_t*)(P.ws_() + WS_U), (const bf16_t*)(P.ws_() + WS_WDN) + (size_t)l * DM * DFF, Mres, DM, DFF};
              S.init(Mres, DM, nblk, blk);
              if (l == 0) {
                  EpiResN E{P.out_(), (const float*)(P.ws_() + WS_HC), P.out_(), (float*)(P.ws_() + WS_HC), (const float*)(P.ws_() + WS_MOD) + (size_t)l * 17 * 6144 + 5 * DM,
                            P.in_(I_N1G) + DM, (const float*)(P.ws_() + WS_MOD) + (size_t)17 * 6144 + 1 * DM, (bf16_t*)(P.ws_() + WS_XN), (float*)(P.ws_() + WS_SSQ2)};
                  pg8::gemm_phase(lds, g, S, E, P.tid); deferred_work(P, lds, 2, (Mres / 256 * 4) % nblk); break; }
              EpiRes E{P.out_(), (const float*)(P.ws_() + WS_HC), P.out_(), (float*)(P.ws_() + WS_HC), (const float*)(P.ws_() + WS_MOD) + (size_t)l * 17 * 6144 + 5 * DM};
              pg8::gemm_phase(lds, g, S, E, P.tid); if (l == 0) deferred_work(P, lds, 2, (Mres / 256 * 4) % nblk); } break;
    }
}


#define XB_TMO      128
#define XB_XCNT(j)  (256  + 64 * (j))
#define XB_XSUB(j)  (1280 + 64 * (j))
#define XB_XGEN(j)  (2304 + 64 * (j))
#define XB_TOP      3328
#define XB_TOPGEN   3392
#define XCD_BAR_WORDS 3456
#define XB_SPIN_CAP (1u << 18)

__device__ __forceinline__ unsigned xb_ld(unsigned* p)              { return __hip_atomic_load(p, __ATOMIC_RELAXED, __HIP_MEMORY_SCOPE_AGENT); }
__device__ __forceinline__ unsigned xb_add(unsigned* p, unsigned v) { return __hip_atomic_fetch_add(p, v, __ATOMIC_RELAXED, __HIP_MEMORY_SCOPE_AGENT); }
__device__ __forceinline__ unsigned xb_xcc_id() { return (unsigned)__builtin_amdgcn_s_getreg((3 << 11) | 20) & 0xFu; }
#define XB_SPIN(cond, bar) do { unsigned _sp = 0; while (cond) { __builtin_amdgcn_s_sleep(1); \
    if ((++_sp & 255u) == 0u) { if (xb_ld(&(bar)[XB_TMO])) break; if (_sp > XB_SPIN_CAP) { atomicAdd(&(bar)[XB_TMO], 1u); break; } } } } while (0)

struct XcdBarrier {
    unsigned* bar; unsigned x;
    volatile LAS unsigned* st;
};

__device__ __forceinline__ XcdBarrier xcd_barrier_post(unsigned* bar, volatile LAS unsigned* st) {
    XcdBarrier b; b.bar = bar; b.x = xb_xcc_id(); b.st = st;
    if (threadIdx.x == 0) (void)xb_add(&bar[XB_XCNT(b.x)], 1u);
    return b;
}
__device__ __forceinline__ void xcd_barrier_complete(unsigned* bar, unsigned x, unsigned& nloc, unsigned& nx) {
    const unsigned G = gridDim.x * gridDim.y * gridDim.z;
    unsigned sum, cnt, mine, sp = 0u;
    for (;;) {
        sum = 0u; cnt = 0u; mine = 0u;
#pragma unroll
        for (unsigned j = 0; j < 16; ++j) { const unsigned c = xb_ld(&bar[XB_XCNT(j)]); sum += c; cnt += (c > 0u) ? 1u : 0u; mine = (j == x) ? c : mine; }
        if (sum == G) break;
        __builtin_amdgcn_s_sleep(1);
        if ((++sp & 255u) == 0u) { if (xb_ld(&bar[XB_TMO])) break; if (sp > XB_SPIN_CAP) { atomicAdd(&bar[XB_TMO], 1u); break; } }
    }
    nloc = mine > 0u ? mine : 1u; nx = cnt > 0u ? cnt : 1u;
}

__device__ __forceinline__ void xcd_barrier(const XcdBarrier& b) {
    asm volatile("s_waitcnt vmcnt(0)" ::: "memory");
    __syncthreads();
    if (threadIdx.x == 0) {
        unsigned* bar = b.bar;
        __builtin_amdgcn_s_waitcnt(0);
        unsigned nloc = b.st[0], nx = b.st[1];
        if (nloc == 0u) { xcd_barrier_complete(bar, b.x, nloc, nx); b.st[0] = nloc; b.st[1] = nx; }
        const unsigned old = xb_add(&bar[XB_XSUB(b.x)], 1u);
        const unsigned gen = old / nloc;
        if (old + 1u == (gen + 1u) * nloc) {
            __builtin_amdgcn_fence(__ATOMIC_RELEASE, "agent");
            asm volatile("s_waitcnt vmcnt(0)" ::: "memory");
            const unsigned og = xb_add(&bar[XB_TOP], 1u);
            const unsigned tg = og / nx;
            if (og + 1u == (tg + 1u) * nx) xb_add(&bar[XB_TOPGEN], 1u);
            else XB_SPIN(xb_ld(&bar[XB_TOPGEN]) == tg, bar);
            __builtin_amdgcn_fence(__ATOMIC_ACQUIRE, "agent");
            xb_add(&bar[XB_XGEN(b.x)], 1u);
            asm volatile("s_waitcnt vmcnt(0)" ::: "memory");
        } else {
            XB_SPIN(xb_ld(&bar[XB_XGEN(b.x)]) == gen, bar);
            __builtin_amdgcn_fence(__ATOMIC_ACQUIRE, "agent");
            asm volatile("s_waitcnt vmcnt(0)" ::: "memory");
        }
    }
    __syncthreads();
}


__device__ __forceinline__ void grid_barrier(unsigned* bar, unsigned k, int tid) {
    asm volatile("s_waitcnt vmcnt(0) lgkmcnt(0)" ::: "memory");
    __builtin_amdgcn_s_barrier();
    if (tid == 0) {
        __builtin_amdgcn_fence(__ATOMIC_RELEASE, "agent");
        asm volatile("s_waitcnt vmcnt(0)" ::: "memory");
        const unsigned old = __hip_atomic_fetch_add(bar, 1u, __ATOMIC_RELAXED, __HIP_MEMORY_SCOPE_AGENT);
        if (old == k * gridDim.x - 1u) __hip_atomic_store(bar + 32, k, __ATOMIC_RELAXED, __HIP_MEMORY_SCOPE_AGENT);
        else {
            unsigned long long t0 = __builtin_amdgcn_s_memrealtime();
            while (__hip_atomic_load(bar + 32, __ATOMIC_RELAXED, __HIP_MEMORY_SCOPE_AGENT) < k) {
                __builtin_amdgcn_s_sleep(2);
                if (__builtin_amdgcn_s_memrealtime() - t0 > 200000000ull) break;
            }
        }
        __builtin_amdgcn_fence(__ATOMIC_ACQUIRE, "agent");
        asm volatile("s_waitcnt vmcnt(0)" ::: "memory");
    }
    asm volatile("" ::: "memory");
    __builtin_amdgcn_s_barrier();
    asm volatile("" ::: "memory");
}
#ifdef DEBUG_CHK
__device__ __forceinline__ void chk_range(const PV& P, int ph, size_t off, size_t bytes, int is_f32, const void* base) {
    const unsigned* p = (const unsigned*)((const unsigned char*)base + off);
    const size_t n = bytes / 4; bool bad = false;
    for (size_t i = (size_t)blockIdx.x * 512 + P.tid; i < n; i += (size_t)gridDim.x * 512) {
        const unsigned v = p[i];
        if (is_f32) { const unsigned e = (v >> 23) & 0xff; if (e >= 127 + 20) bad = true; }
        else { const unsigned e0 = (v >> 7) & 0xff, e1 = (v >> 23) & 0xff; if (e0 >= 127 + 20 || e1 >= 127 + 20) bad = true; }
    }
    if (bad) atomicOr((unsigned*)(P.ws_() + WS_SUM), 1u << ph);
}
__device__ __forceinline__ void chk_phase(const PV& P, int ph) {
    if (ph == 0) {
        chk_range(P, ph, WS_MOD, WS_S5BB - WS_MOD, 1, P.ws_()); chk_range(P, ph, WS_S5BB, WS_GLAT - WS_S5BB, 0, P.ws_());
        chk_range(P, ph, WS_GLAT, WS_WIN - WS_GLAT, 1, P.ws_()); chk_range(P, ph, WS_WIN, WS_HC - WS_WIN, 0, P.ws_()); return; }
    if (ph == NPHASE - 1) { chk_range(P, ph, 0, (size_t)MLAT * DM * 4, 1, P.out_()); return; }
    const int l = (ph - 1) / 8, sp = (ph - 1) % 8; const size_t Mres = l ? MLAT : MTOT;
    switch (sp) {
    case 0: chk_range(P, ph, WS_XN, (size_t)MTOT * DM * 2, 0, P.ws_()); break;
    case 1: chk_range(P, ph, WS_U, (size_t)MTOT * UW * 2 + (size_t)768 * MTOT * 2, 0, P.ws_()); break;
    case 2: chk_range(P, ph, WS_Y, (size_t)6 * MTOT * 256 * 2, 0, P.ws_()); chk_range(P, ph, WS_ZH, l ? (size_t)0 : (size_t)256 * MTOT * 2, 0, P.ws_()); break;
    case 3: case 5: chk_range(P, ph, WS_XN, Mres * DM * 2, 0, P.ws_()); break;
    case 4: case 7: chk_range(P, ph, 0, (size_t)MLAT * DM * 4, 1, P.out_()); if (!l) chk_range(P, ph, WS_HC, (size_t)MCTX * DM * 4, 1, P.ws_()); break;
    case 6: chk_range(P, ph, WS_U, Mres * DFF * 2, 0, P.ws_()); break;
    }
}
#endif
__global__ void __launch_bounds__(512, 2) fwd_mega(Params KP, int ph_lo, int ph_hi) {
    extern __shared__ __attribute__((aligned(16))) unsigned char smem[];
    LAS unsigned char* lds = (LAS unsigned char*)smem;
    if (ph_lo < 0) cg::this_grid().sync();
    unsigned nbar = 0;
    volatile LAS unsigned* xst = (volatile LAS unsigned*)(lds + LDS_BYTES - 16);
    if (threadIdx.x == 0) { xst[0] = 0u; xst[1] = 0u; }
    __syncthreads();
    const XcdBarrier xb = xcd_barrier_post((unsigned*)(KP.ws + WS_XBAR), xst);
    for (int ph = ph_lo; ph < ph_hi; ++ph) {
        if (ph >= 1 && ph < NPHASE - 1 && ((ph - 1) % NSP == 6 || ph == 1 + NSP)) continue;
        int z; asm volatile("s_mov_b32 %0, 0" : "=s"(z));
        int tidv = threadIdx.x; asm volatile("" : "+v"(tidv));
        const PV P{KP, z, tidv};
        run_phase(P, ph, lds);
#ifdef EXTRA_BAR
        if (ph == 9) for (int q = 0; q < EXTRA_BAR; ++q) { ++nbar; grid_barrier((unsigned*)(P.ws_() + WS_SUM), nbar, tidv); }
#endif
#ifdef REP_PHASE
        if (ph == REP_PHASE) { ++nbar; grid_barrier((unsigned*)(P.ws_() + WS_SUM), nbar, tidv); run_phase(P, ph, lds); }
#endif
        if (ph + 1 < ph_hi) { ++nbar; xcd_barrier(xb); }
    }
}


#ifdef DBG2
__global__ void dbg_zero(Params KP) { if (blockIdx.x == 0 && threadIdx.x < 8) ((unsigned*)(KP.ws + WS_SUM))[32 + threadIdx.x] = 0u; }
__global__ void dbg_count(Params KP, size_t off, size_t bytes, int slot, int is_out = 0) {
    const unsigned* p = is_out ? (const unsigned*)KP.out : (const unsigned*)(KP.ws + off); const size_t n = bytes / 4; unsigned bad = 0;
    for (size_t i = (size_t)blockIdx.x * blockDim.x + threadIdx.x; i < n; i += (size_t)gridDim.x * blockDim.x) { const unsigned e = (p[i] >> 23) & 0xff, e2 = (p[i] >> 7) & 0xff; if (e >= 147 || (!is_out && slot < 3 && e2 >= 147)) ++bad; }
    if (bad) atomicAdd((unsigned*)(KP.ws + WS_SUM) + 32 + slot, bad);
}
__global__ void dbg_out(Params KP) {
    const unsigned* c = (const unsigned*)(KP.ws + WS_SUM) + 32;
    float code = 1000.f * (float)(1 + (c[0] ? 1 : 0) + (c[1] ? 2 : 0) + (c[2] ? 4 : 0) + (c[3] ? 8 : 0));
    for (size_t i = (size_t)blockIdx.x * blockDim.x + threadIdx.x; i < (size_t)MLAT * DM; i += (size_t)gridDim.x * blockDim.x) KP.out[i] = (i == 0) ? code : 0.f;
}
#endif
extern "C" void kernel_launch(void* const* d_in, const int* in_sizes, int n_in, void* d_out, int out_size, void* d_ws, size_t ws_size, hipStream_t stream) {
    static int grid = 0;
    if (grid == 0) {
        if (n_in != 39 || out_size != MLAT * DM || ws_size < WS_END) { fprintf(stderr, "kernel_launch: unexpected shapes (n_in %d out %d ws %zu need %zu)\n", n_in, out_size, ws_size, (size_t)WS_END); grid = -1; return; }
        int dev = 0, cus = 0, per_cu = 0;
        hipGetDevice(&dev); hipDeviceGetAttribute(&cus, hipDeviceAttributeMultiprocessorCount, dev);
        hipFuncSetAttribute((const void*)fwd_mega, hipFuncAttributeMaxDynamicSharedMemorySize, LDS_BYTES);
        hipOccupancyMaxActiveBlocksPerMultiprocessor(&per_cu, (const void*)fwd_mega, 512, LDS_BYTES);
        if (per_cu < 1) { fprintf(stderr, "kernel_launch: occupancy query says %d blocks per CU\n", per_cu); per_cu = 1; }
        grid = cus;
        (void)hipGetLastError();
    }
    if (grid < 0) return;
    hipMemsetAsync((unsigned char*)d_ws + WS_SUM, 0, 256, stream);
    hipMemsetAsync((unsigned char*)d_ws + WS_XBAR, 0, 16384, stream);
    Params p{};
    for (int i = 0; i < 39; ++i) p.in[i] = (const float*)d_in[i];
    p.out = (float*)d_out; p.ws = (unsigned char*)d_ws;
#ifdef DBG2
    hipLaunchKernelGGL(dbg_zero, dim3(1), dim3(64), 0, stream, p);
    for (int ph = 0; ph < NPHASE; ++ph) {
        hipLaunchKernelGGL(fwd_mega, dim3(grid), dim3(512), LDS_BYTES, stream, p, ph, ph + 1);
        if (ph == 3) {
            hipLaunchKernelGGL(dbg_count, dim3(256), dim3(256), 0, stream, p, (size_t)WS_Y, (size_t)4 * MTOT * 256 * 2, 0, 0);
            hipLaunchKernelGGL(dbg_count, dim3(256), dim3(256), 0, stream, p, (size_t)WS_Y + (size_t)4 * MTOT * 256 * 2, (size_t)2 * MTOT * 256 * 2, 1, 0);
            hipLaunchKernelGGL(dbg_count, dim3(256), dim3(256), 0, stream, p, (size_t)WS_ZH, (size_t)256 * MTOT * 2, 2, 0);
        }
    }
    hipLaunchKernelGGL(dbg_count, dim3(256), dim3(256), 0, stream, p, (size_t)0, (size_t)MLAT * DM * 4, 3, 1);
    hipLaunchKernelGGL(dbg_out, dim3(256), dim3(256), 0, stream, p);
#elif ONE_LAUNCH
    int lo = 0, hi = NPHASE;
    void* args[] = {&p, &lo, &hi};
    hipError_t e = hipLaunchCooperativeKernel((const void*)fwd_mega, dim3(grid), dim3(512), args, LDS_BYTES, stream);
    if (e != hipSuccess) fprintf(stderr, "cooperative launch failed: %s (grid %d)\n", hipGetErrorString(e), grid);
#else
    for (int ph = 0; ph < NPHASE; ++ph) hipLaunchKernelGGL(fwd_mega, dim3(grid), dim3(512), LDS_BYTES, stream, p, ph, ph + 1);
#endif
}
```

```cpp
#include <hip/hip_runtime.h>
#include <hip/hip_cooperative_groups.h>
#include <cstdio>
#include <cstdint>
namespace cg = cooperative_groups;

#ifndef ONE_LAUNCH
#define ONE_LAUNCH 1
#endif

#define LAS __attribute__((address_space(3)))
typedef unsigned short bf16_t;
typedef short bf16x8 __attribute__((ext_vector_type(8)));
typedef float f32x4 __attribute__((ext_vector_type(4)));
typedef float f32x2 __attribute__((ext_vector_type(2)));
typedef unsigned u32x4 __attribute__((ext_vector_type(4)));
typedef unsigned u32x2 __attribute__((ext_vector_type(2)));

constexpr int DM = 1024, NB = 16, SEQ = 2048, CTX = 256;
constexpr int MLAT = NB * SEQ, MCTX = NB * CTX, MTOT = MLAT + MCTX;
constexpr int D_IN = 2696, NIN = 2816, DFF = 2816, UW = 1928;
constexpr int UC_Z = 0, UC_X = 256, UC_B = 512, UC_C = 576, UC_DT = 640, UC_Q = 648, UC_K = 904, UC_V = 1160, UC_G = 1416, UC_S5 = 1672;

constexpr size_t AL(size_t x) { return (x + 255) & ~(size_t)255; }
constexpr size_t WS_SUM = 0;
constexpr size_t WS_MOD = 8192;
constexpr size_t WS_S5AB = AL(WS_MOD + (size_t)2 * 17 * 6144 * 4);
constexpr size_t WS_S5BB = AL(WS_S5AB + (size_t)2 * 2 * 16 * 64 * 8);
constexpr size_t WS_S5CM = AL(WS_S5BB + (size_t)2 * 2 * 16 * 128 * 16 * 2);
constexpr size_t WS_GLAT = AL(WS_S5CM + (size_t)2 * 2 * 16 * 16 * 128 * 2);
constexpr size_t WS_GCTX = AL(WS_GLAT + (size_t)2 * 2 * 256 * 4096 * 4);
constexpr size_t WS_WIN = AL(WS_GCTX + (size_t)2 * 256 * 512 * 4);
constexpr size_t WS_WOUT = AL(WS_WIN + (size_t)2 * NIN * DM * 2);
constexpr size_t WS_WUP = AL(WS_WOUT + (size_t)2 * DM * DM * 2);
constexpr size_t WS_WDN = AL(WS_WUP + (size_t)2 * 2 * DFF * DM * 2);
constexpr size_t WS_WGLU = AL(WS_WDN + (size_t)2 * DM * DFF * 2);
constexpr size_t WS_HC = AL(WS_WGLU + (size_t)2 * 256 * 256 * 2);
constexpr size_t WS_XN = AL(WS_HC + (size_t)MCTX * DM * 4);
constexpr size_t WS_U = AL(WS_XN + (size_t)MTOT * DM * 2);
constexpr size_t WS_UH = WS_U + (size_t)MTOT * UW * 2;
constexpr size_t WS_Y = AL(WS_U + (size_t)MTOT * DFF * 2);
constexpr size_t WS_ZH = AL(WS_Y + (size_t)6 * MTOT * 256 * 2);
constexpr size_t WS_XBC = AL(WS_ZH + (size_t)256 * MTOT * 2);
constexpr size_t WS_SSQ = AL(WS_XBC + (size_t)MTOT * 384 * 2);
constexpr size_t WS_SWUP = AL(WS_SSQ + (size_t)MTOT * 4);
constexpr size_t WS_SSQ2 = AL(WS_SWUP + (size_t)2 * 17 * 2 * DFF * 4);
constexpr size_t WS_SWIN = AL(WS_SSQ2 + (size_t)MTOT * 4);
constexpr size_t WS_XBAR = AL(WS_SWIN + (size_t)17 * NIN * 4);
constexpr size_t WS_END = AL(WS_XBAR + 16384);
static_assert(WS_UH + (size_t)768 * MTOT * 2 <= WS_Y, "U/UH overlay");

constexpr int LDS_BYTES = 144 * 1024;

struct Params { const float* in[39]; float* out; unsigned char* ws; };
struct PV { const Params& K; int z; int tid;
    __device__ __forceinline__ const float* in_(int i) const { return K.in[i + z]; }
    __device__ __forceinline__ float* out_() const { return K.out + z; }
    __device__ __forceinline__ unsigned char* ws_() const { return K.ws + z; } };
enum { I_X = 0, I_C, I_CTX, I_CCTX, I_MODW, I_MODB, I_N1G, I_N2G, I_WIN, I_WOUT, I_SCW, I_SCB, I_SALOG, I_SDTB, I_SD, I_SNG,
       I_HCW, I_HCB, I_HW1, I_HB1, I_HFREQ, I_HW2, I_HB2, I_HW3, I_HBIAS, I_RDEC, I_5ARE, I_5AIM, I_5LDT, I_5BRE, I_5BIM,
       I_5CRE, I_5CIM, I_5D, I_5GW, I_5GB, I_FUP, I_FDN, I_FNG };

typedef __bf16 bf16x2_t __attribute__((ext_vector_type(2)));
__device__ __forceinline__ unsigned pk2(float lo, float hi) { const f32x2 v = {lo, hi}; const bf16x2_t b = __builtin_convertvector(v, bf16x2_t); return __builtin_bit_cast(unsigned, b); }
__device__ __forceinline__ bf16_t f2bf(float f) { return (bf16_t)(pk2(f, 0.f) & 0xffffu); }
__device__ __forceinline__ float bf2f(bf16_t b) { return __uint_as_float(((unsigned)b) << 16); }
__device__ __forceinline__ float bflo(unsigned w) { return __uint_as_float(w << 16); }
__device__ __forceinline__ float bfhi(unsigned w) { return __uint_as_float(w & 0xffff0000u); }
__device__ __forceinline__ void unpack8(u32x4 w, float* v) {
    v[0] = bflo(w.x); v[1] = bfhi(w.x); v[2] = bflo(w.y); v[3] = bfhi(w.y); v[4] = bflo(w.z); v[5] = bfhi(w.z); v[6] = bflo(w.w); v[7] = bfhi(w.w);
}
__device__ __forceinline__ u32x4 pack8(const float* v) { u32x4 w; w.x = pk2(v[0], v[1]); w.y = pk2(v[2], v[3]); w.z = pk2(v[4], v[5]); w.w = pk2(v[6], v[7]); return w; }
__device__ __forceinline__ float sigmoidf_(float x) { return __builtin_amdgcn_rcpf(1.f + __expf(-x)); }
__device__ __forceinline__ float siluf_(float x) { return x * __builtin_amdgcn_rcpf(1.f + __expf(-x)); }
__device__ __forceinline__ float softplusf_(float x) { return x > 20.f ? x : log1pf(__expf(x)); }
__device__ __forceinline__ float gelu_tanh(float x) { const float u = 0.7978845608f * (x + 0.044715f * x * x * x); return x * __builtin_amdgcn_rcpf(1.f + __expf(-2.f * u)); }
__device__ __forceinline__ float wave_sum(float v) {
#pragma unroll
    for (int o = 1; o < 64; o <<= 1) v += __shfl_xor(v, o);
    return v;
}
#define WAVE_SYNC() do { asm volatile("s_waitcnt lgkmcnt(0)" ::: "memory"); __builtin_amdgcn_wave_barrier(); } while (0)

namespace pg8 {
constexpr int BM = 256, BK = 64, HALF = 128, HTB = HALF * BK * 2, STAGE_BYTES = 8 * HTB, NXCD = 8, WGM = 8;
__host__ __device__ __forceinline__ int lds_byte(int r, int c) { const int st = (r >> 4) * 2 + (c >> 5), rr = r & 15, cc = c & 31, ob = rr * 64 + cc * 2; return st * 1024 + (ob ^ (((ob >> 9) & 1) << 5)); }
__host__ __device__ __forceinline__ void stage_rc(int b, int& R, int& C) { const int st = b / 1024, sb = b % 1024, swz = sb ^ (((sb >> 9) & 1) << 5); R = (st >> 1) * 16 + swz / 64; C = (st & 1) * 32 + (swz % 64) / 2; }
struct Unit { int pm, pn; };
struct Gemm { const bf16_t* A; const bf16_t* Bt; int M, N, K; };
struct StaticOrder {
    int nM, nN, nwg, G, c;
    __host__ __device__ void init(int M, int N, int G_, int c_) { nM = M / BM; nN = N / BM; nwg = nM * nN; G = G_; c = c_; }
    __host__ __device__ bool next(int i, Unit& u) const {
        const long L = (long)i * G + c; if (L >= nwg) return false;
        int wgid = (int)L; { const int q = nwg / NXCD, r = nwg % NXCD, xcd = wgid % NXCD, off = wgid / NXCD; wgid = (xcd < r ? xcd * (q + 1) : r * (q + 1) + (xcd - r) * q) + off; }
        const int nig = WGM * nN, gid = wgid / nig, fm = gid * WGM, gsz = (nM - fm) < WGM ? (nM - fm) : WGM;
        u.pm = fm + ((wgid % nig) % gsz); u.pn = (wgid % nig) / gsz; return true;
    }
};
struct LastWinOrder {
    StaticOrder lat; int G, c;
    __host__ __device__ void init(int G_, int c_) { lat.init(MLAT, NIN, G_, c_); G = G_; c = c_; }
    __host__ __device__ bool next(int i, Unit& u) const {
        const int L = i * G + c;
        if (L < lat.nwg) return lat.next(i, u);
        const int idx = L - lat.nwg; if (idx >= 16 * 8) return false;
        const int k = idx & 7; u.pm = MLAT / 256 + (idx >> 3); u.pn = k == 0 ? 1 : (k == 1 ? 2 : k + 3);
        return true;
    }
};
template <class Epi, class Sched>
__device__ __forceinline__ void gemm_phase(LAS unsigned char* lds, const Gemm g, const Sched& S, const Epi& E, const int tid) {
    const int wid = __builtin_amdgcn_readfirstlane(tid >> 6), lane = tid & 63, wr = wid >> 2, wc = wid & 3, fr = lane & 15, fq = lane >> 4;
    const int K = g.K, nt = K / BK;
    unsigned voffA[2];
#pragma unroll
    for (int i = 0; i < 2; ++i) { int R, C; stage_rc(tid * 16 + i * 8192, R, C); voffA[i] = (unsigned)(R * K + C) * 2u; }
    const size_t kstep = (size_t)(BK * 2);
    const size_t hstep = (size_t)HALF * K * 2;
    const size_t tstep = 2 * hstep;
    const unsigned ldsw = (unsigned)wid * 1024u;
    const int aoff = lds_byte(wr * 64 + fr, fq * 8), boff = lds_byte(wc * 32 + fr, fq * 8);
#define PG8_SA(b, h) (((b) * 2 + (h)) * HTB)
#define PG8_SB(b, h) ((4 + (b) * 2 + (h)) * HTB)
#define PG8_STAGE(bufoff, gbase, voff) do { _Pragma("unroll") for (int _i = 0; _i < 2; ++_i) \
        __builtin_amdgcn_global_load_lds((const unsigned*)((const char*)(gbase) + (voff)[_i]), (LAS unsigned*)(lds + (bufoff) + ldsw + _i * 8192), 16, 0, 0); } while (0)
#define PG8_LDA(dst, b, h) do { _Pragma("unroll") for (int m = 0; m < 4; ++m) _Pragma("unroll") for (int k = 0; k < 2; ++k) dst[m][k] = *(const LAS bf16x8*)(lds + PG8_SA(b, h) + aoff + m * 2048 + k * 1024); } while (0)
#define PG8_LDB(dst, b, h) do { _Pragma("unroll") for (int n = 0; n < 2; ++n) _Pragma("unroll") for (int k = 0; k < 2; ++k) dst[n][k] = *(const LAS bf16x8*)(lds + PG8_SB(b, h) + boff + n * 2048 + k * 1024); } while (0)
#define PG8_MMA(ai, bj, At, Bt) do { __builtin_amdgcn_s_setprio(1); _Pragma("unroll") for (int m = 0; m < 4; ++m) _Pragma("unroll") for (int n = 0; n < 2; ++n) _Pragma("unroll") for (int k = 0; k < 2; ++k) \
        acc[ai][bj][m][n] = __builtin_amdgcn_mfma_f32_16x16x32_bf16(Bt[n][k], At[m][k], acc[ai][bj][m][n], 0, 0, 0); __builtin_amdgcn_s_setprio(0); } while (0)
#define PG8_WAIT_V(n) asm volatile("s_waitcnt vmcnt(" #n ")" ::: "memory")
#define PG8_WAIT_L(n) asm volatile("s_waitcnt lgkmcnt(" #n ")" ::: "memory")
#define PG8_BAR __builtin_amdgcn_s_barrier()
#define PG8_SCHED __builtin_amdgcn_sched_barrier(0)
    Unit cur, nxt; int ui = 0;
    if (!S.next(0, cur)) return;
    f32x4 acc[2][2][4][2];
#pragma unroll
    for (int a = 0; a < 2; ++a)
#pragma unroll
        for (int b = 0; b < 2; ++b)
#pragma unroll
            for (int m = 0; m < 4; ++m)
#pragma unroll
                for (int n = 0; n < 2; ++n) acc[a][b][m][n] = (f32x4){0.f, 0.f, 0.f, 0.f};
    bf16x8 At[4][2], B0[2][2], B1[2][2];
    const char* cA = (const char*)g.A + (size_t)cur.pm * tstep; const char* cB = (const char*)g.Bt + (size_t)cur.pn * tstep;
    PG8_STAGE(PG8_SB(0, 0), cB, voffA); PG8_STAGE(PG8_SA(0, 0), cA, voffA); PG8_STAGE(PG8_SB(0, 1), cB + hstep, voffA); PG8_STAGE(PG8_SA(0, 1), cA + hstep, voffA);
    if (wr == 1) PG8_BAR;
    PG8_WAIT_V(4); PG8_BAR;
    PG8_STAGE(PG8_SB(1, 0), cB + kstep, voffA); PG8_STAGE(PG8_SA(1, 0), cA + kstep, voffA); PG8_STAGE(PG8_SB(1, 1), cB + hstep + kstep, voffA);
    PG8_WAIT_V(6); PG8_BAR;
    for (;;) {
        const bool has_next = S.next(ui + 1, nxt);
        const char* nA = has_next ? (const char*)g.A + (size_t)nxt.pm * tstep : cA; const char* nB = has_next ? (const char*)g.Bt + (size_t)nxt.pn * tstep : cB;
        for (int t = 0; t < nt; t += 2) {
            const bool last = (t == nt - 2);
            const char* a1 = cA + (size_t)(t + 1) * kstep;
            const char* a2 = last ? nA : cA + (size_t)(t + 2) * kstep; const char* b2 = last ? nB : cB + (size_t)(t + 2) * kstep;
            const char* a3 = a2 + kstep; const char* b3 = b2 + kstep;
            PG8_LDB(B0, 0, 0); PG8_SCHED; PG8_LDA(At, 0, 0); PG8_STAGE(PG8_SA(1, 1), a1 + hstep, voffA);
            PG8_WAIT_L(8); PG8_BAR; PG8_WAIT_L(0); PG8_MMA(0, 0, At, B0); PG8_BAR; PG8_SCHED;
            PG8_LDB(B1, 0, 1); PG8_STAGE(PG8_SB(0, 0), b2, voffA);
            PG8_BAR; PG8_WAIT_L(0); PG8_MMA(0, 1, At, B1); PG8_BAR;
            PG8_LDA(At, 0, 1); PG8_STAGE(PG8_SA(0, 0), a2, voffA);
            PG8_BAR; PG8_WAIT_L(0); PG8_MMA(1, 0, At, B0); PG8_BAR; PG8_SCHED;
            PG8_STAGE(PG8_SB(0, 1), b2 + hstep, voffA);
            PG8_WAIT_V(6); PG8_BAR; PG8_MMA(1, 1, At, B1); PG8_BAR;
            PG8_LDB(B0, 1, 0); PG8_SCHED; PG8_LDA(At, 1, 0); PG8_STAGE(PG8_SA(0, 1), a2 + hstep, voffA);
            PG8_WAIT_L(8); PG8_BAR; PG8_WAIT_L(0); PG8_MMA(0, 0, At, B0); PG8_BAR; PG8_SCHED;
            PG8_LDB(B1, 1, 1); PG8_STAGE(PG8_SB(1, 0), b3, voffA);
            PG8_BAR; PG8_WAIT_L(0); PG8_MMA(0, 1, At, B1); PG8_BAR;
            PG8_LDA(At, 1, 1); PG8_STAGE(PG8_SA(1, 0), a3, voffA);
            PG8_BAR; PG8_WAIT_L(0); PG8_MMA(1, 0, At, B0); PG8_BAR; PG8_SCHED;
            PG8_STAGE(PG8_SB(1, 1), b3 + hstep, voffA);
            PG8_WAIT_V(6); PG8_BAR; PG8_MMA(1, 1, At, B1); PG8_BAR;
        }
        E(acc, cur, wr, wc, fr, fq);
        if (!has_next) break;
#pragma unroll
        for (int a = 0; a < 2; ++a)
#pragma unroll
            for (int b = 0; b < 2; ++b)
#pragma unroll
                for (int m = 0; m < 4; ++m)
#pragma unroll
                    for (int n = 0; n < 2; ++n) acc[a][b][m][n] = (f32x4){0.f, 0.f, 0.f, 0.f};
        cur = nxt; cA = nA; cB = nB; ++ui;
    }
    PG8_WAIT_V(0);
    if (wr == 0) PG8_BAR;
    PG8_BAR;
#undef PG8_SA
#undef PG8_SB
#undef PG8_STAGE
#undef PG8_LDA
#undef PG8_LDB
#undef PG8_MMA
#undef PG8_WAIT_V
#undef PG8_WAIT_L
#undef PG8_BAR
#undef PG8_SCHED
}
}
using pg8::Unit;

struct EpiU {
    bf16_t* U; bf16_t* UH;
    __device__ __forceinline__ void operator()(const f32x4 (&acc)[2][2][4][2], const Unit& u, int wr, int wc, int fr, int fq) const {
#pragma unroll
        for (int ai = 0; ai < 2; ++ai)
#pragma unroll
            for (int m = 0; m < 4; ++m) {
                const int row = u.pm * 256 + ai * 128 + wr * 64 + m * 16 + fr;
#pragma unroll
                for (int bj = 0; bj < 2; ++bj)
#pragma unroll
                    for (int n = 0; n < 2; ++n) {
                        const int c = u.pn * 256 + bj * 128 + wc * 32 + n * 16 + 4 * fq;
                        const f32x4 v = acc[ai][bj][m][n];
                        if (c >= D_IN) continue;
                        if (c < 648 || c >= 1416) {
                            const int uc = c < 648 ? c : c - 768;
                            u32x2 w; w.x = pk2(v[0], v[1]); w.y = pk2(v[2], v[3]);
                            *(u32x2*)(U + (size_t)row * UW + uc) = w;
                        } else {
                            const int hc = c - 648;
#pragma unroll
                            for (int j = 0; j < 4; ++j) UH[(size_t)(hc + j) * MTOT + row] = f2bf(v[j]);
                        }
                    }
            }
    }
};
struct EpiRes {
    const float* oldL; const float* oldC; float* newL; float* newC; const float* gate;
    __device__ __forceinline__ void operator()(const f32x4 (&acc)[2][2][4][2], const Unit& u, int wr, int wc, int fr, int fq) const {
        const bool lat = u.pm < MLAT / 256;
        const float* gp = gate + (size_t)(lat ? (u.pm >> 3) : 16) * 6144;
#pragma unroll
        for (int bj = 0; bj < 2; ++bj) {
            f32x4 gt[2];
#pragma unroll
            for (int n = 0; n < 2; ++n) gt[n] = *(const f32x4*)(gp + u.pn * 256 + bj * 128 + wc * 32 + n * 16 + 4 * fq);
#pragma unroll
            for (int ai = 0; ai < 2; ++ai) {
                f32x4 o[4][2];
#pragma unroll
                for (int m = 0; m < 4; ++m) {
                    const int row = u.pm * 256 + ai * 128 + wr * 64 + m * 16 + fr;
                    const float* op = lat ? oldL + (size_t)row * DM : oldC + (size_t)(row - MLAT) * DM;
#pragma unroll
                    for (int n = 0; n < 2; ++n) o[m][n] = *(const f32x4*)(op + u.pn * 256 + bj * 128 + wc * 32 + n * 16 + 4 * fq);
                }
#pragma unroll
                for (int m = 0; m < 4; ++m) {
                    const int row = u.pm * 256 + ai * 128 + wr * 64 + m * 16 + fr;
                    float* np = lat ? newL + (size_t)row * DM : newC + (size_t)(row - MLAT) * DM;
#pragma unroll
                    for (int n = 0; n < 2; ++n) *(f32x4*)(np + u.pn * 256 + bj * 128 + wc * 32 + n * 16 + 4 * fq) = o[m][n] + gt[n] * acc[ai][bj][m][n];
                }
            }
        }
    }
};
struct EpiSwiglu {
    bf16_t* Act;
    __device__ __forceinline__ void operator()(const f32x4 (&acc)[2][2][4][2], const Unit& u, int wr, int wc, int fr, int fq) const {
#pragma unroll
        for (int ai = 0; ai < 2; ++ai)
#pragma unroll
            for (int m = 0; m < 4; ++m) {
                const int row = u.pm * 256 + ai * 128 + wr * 64 + m * 16 + fr;
#pragma unroll
                for (int bj = 0; bj < 2; ++bj) {
                    const int G = u.pn * 128 + bj * 64 + wc * 16 + 4 * fq;
                    const f32x4 g = acc[ai][bj][m][0], up = acc[ai][bj][m][1];
                    u32x2 w; w.x = pk2(siluf_(g[0]) * up[0], siluf_(g[1]) * up[1]); w.y = pk2(siluf_(g[2]) * up[2], siluf_(g[3]) * up[3]);
                    *(u32x2*)(Act + (size_t)row * DFF + G) = w;
                }
            }
    }
};


struct EpiResN {
    const float* oldL; const float* oldC; float* newL; float* newC; const float* gate; const float* g2; const float* scale2; bf16_t* A2; float* ssq;
    __device__ __forceinline__ void operator()(const f32x4 (&acc)[2][2][4][2], const Unit& u, int wr, int wc, int fr, int fq) const {
        const bool lat = u.pm < MLAT / 256;
        const int r = lat ? (u.pm >> 3) : 16;
        const float* gp = gate + (size_t)r * 6144; const float* sp = scale2 + (size_t)r * 6144;
#pragma unroll
        for (int bj = 0; bj < 2; ++bj) {
            f32x4 gt[2], gs[2];
#pragma unroll
            for (int n = 0; n < 2; ++n) { const int c = u.pn * 256 + bj * 128 + wc * 32 + n * 16 + 4 * fq;
                gt[n] = *(const f32x4*)(gp + c); gs[n] = *(const f32x4*)(g2 + c) * (*(const f32x4*)(sp + c) + 1.f); }
#pragma unroll
            for (int ai = 0; ai < 2; ++ai) {
                f32x4 o[4][2];
#pragma unroll
                for (int m = 0; m < 4; ++m) {
                    const int row = u.pm * 256 + ai * 128 + wr * 64 + m * 16 + fr;
                    const float* op = lat ? oldL + (size_t)row * DM : oldC + (size_t)(row - MLAT) * DM;
#pragma unroll
                    for (int n = 0; n < 2; ++n) o[m][n] = *(const f32x4*)(op + u.pn * 256 + bj * 128 + wc * 32 + n * 16 + 4 * fq);
                }
#pragma unroll
                for (int m = 0; m < 4; ++m) {
                    const int row = u.pm * 256 + ai * 128 + wr * 64 + m * 16 + fr;
                    float* np = lat ? newL + (size_t)row * DM : newC + (size_t)(row - MLAT) * DM;
                    float ss = 0.f;
#pragma unroll
                    for (int n = 0; n < 2; ++n) {
                        const int c = u.pn * 256 + bj * 128 + wc * 32 + n * 16 + 4 * fq;
                        const f32x4 hn = o[m][n] + gt[n] * acc[ai][bj][m][n];
                        *(f32x4*)(np + c) = hn;
                        ss += hn.x * hn.x + hn.y * hn.y + hn.z * hn.z + hn.w * hn.w;
                        const f32x4 a2 = hn * gs[n];
                        u32x2 w; w.x = pk2(a2.x, a2.y); w.y = pk2(a2.z, a2.w);
                        *(u32x2*)(A2 + (size_t)row * DM + c) = w;
                    }
                    ss += __shfl_xor(ss, 16); ss += __shfl_xor(ss, 32);
                    if (fq == 0) atomicAdd(ssq + row, ss);
                }
            }
        }
    }
};
struct EpiSwigluN {
    bf16_t* Act; const float* ssq; const float* sw;
    __device__ __forceinline__ void operator()(const f32x4 (&acc)[2][2][4][2], const Unit& u, int wr, int wc, int fr, int fq) const {
        const int r = u.pm < MLAT / 256 ? (u.pm >> 3) : 16;
        f32x4 swg[2], swu[2];
#pragma unroll
        for (int bj = 0; bj < 2; ++bj) { const int G = u.pn * 128 + bj * 64 + wc * 16 + 4 * fq; swg[bj] = *(const f32x4*)(sw + (size_t)r * 2 * DFF + G); swu[bj] = *(const f32x4*)(sw + (size_t)r * 2 * DFF + DFF + G); }
        float rs[2][4];
#pragma unroll
        for (int ai = 0; ai < 2; ++ai)
#pragma unroll
            for (int m = 0; m < 4; ++m) rs[ai][m] = ssq[u.pm * 256 + ai * 128 + wr * 64 + m * 16 + fr];
#pragma unroll
        for (int ai = 0; ai < 2; ++ai)
#pragma unroll
            for (int m = 0; m < 4; ++m) {
                const int row = u.pm * 256 + ai * 128 + wr * 64 + m * 16 + fr;
                const float rstd = rsqrtf(rs[ai][m] * (1.f / DM) + 1e-6f);
#pragma unroll
                for (int bj = 0; bj < 2; ++bj) {
                    const int G = u.pn * 128 + bj * 64 + wc * 16 + 4 * fq;
                    const f32x4 g = acc[ai][bj][m][0] * rstd + swg[bj], up = acc[ai][bj][m][1] * rstd + swu[bj];
                    u32x2 w; w.x = pk2(siluf_(g[0]) * up[0], siluf_(g[1]) * up[1]); w.y = pk2(siluf_(g[2]) * up[2], siluf_(g[3]) * up[3]);
                    *(u32x2*)(Act + (size_t)row * DFF + G) = w;
                }
            }
    }
};

struct EpiUN {
    bf16_t* U; bf16_t* UH; const float* ssq; const float* sw;
    __device__ __forceinline__ void operator()(const f32x4 (&acc)[2][2][4][2], const Unit& u, int wr, int wc, int fr, int fq) const {
        const int r = u.pm < MLAT / 256 ? (u.pm >> 3) : 16;
        f32x4 swv[2][2]; float rs[2][4];
#pragma unroll
        for (int bj = 0; bj < 2; ++bj)
#pragma unroll
            for (int n = 0; n < 2; ++n) swv[bj][n] = *(const f32x4*)(sw + (size_t)r * NIN + u.pn * 256 + bj * 128 + wc * 32 + n * 16 + 4 * fq);
#pragma unroll
        for (int ai = 0; ai < 2; ++ai)
#pragma unroll
            for (int m = 0; m < 4; ++m) rs[ai][m] = ssq[u.pm * 256 + ai * 128 + wr * 64 + m * 16 + fr];
#pragma unroll
        for (int ai = 0; ai < 2; ++ai)
#pragma unroll
            for (int m = 0; m < 4; ++m) {
                const int row = u.pm * 256 + ai * 128 + wr * 64 + m * 16 + fr;
                const float rstd = rsqrtf(rs[ai][m] * (1.f / DM) + 1e-6f);
#pragma unroll
                for (int bj = 0; bj < 2; ++bj)
#pragma unroll
                    for (int n = 0; n < 2; ++n) {
                        const int c = u.pn * 256 + bj * 128 + wc * 32 + n * 16 + 4 * fq;
                        const f32x4 v = acc[ai][bj][m][n] * rstd + swv[bj][n];
                        if (c >= D_IN) continue;
                        if (c < 648 || c >= 1416) {
                            const int uc = c < 648 ? c : c - 768;
                            u32x2 w; w.x = pk2(v[0], v[1]); w.y = pk2(v[2], v[3]);
                            *(u32x2*)(U + (size_t)row * UW + uc) = w;
                        } else {
                            const int hc = c - 648;
#pragma unroll
                            for (int j = 0; j < 4; ++j) UH[(size_t)(hc + j) * MTOT + row] = f2bf(v[j]);
                        }
                    }
            }
    }
};
template <class F>
__device__ __forceinline__ void transpose_item(const float* W, int K, int N, bf16_t* WT, LAS float* scr, int item, int nblk, int lane, F srccol) {
    const int kb = item / nblk, nb = item % nblk, k0 = 64 * kb, n0 = 32 * nb;
    const int sc = srccol(n0 + (lane & 31));
    float tv[32];
#pragma unroll
    for (int i = 0; i < 32; ++i) { const int kk = 2 * i + (lane >> 5); tv[i] = W[(size_t)(k0 + kk) * N + (sc >= 0 ? sc : 0)]; }
#pragma unroll
    for (int i = 0; i < 32; ++i) { const int kk = 2 * i + (lane >> 5); scr[kk * 33 + (lane & 31)] = sc >= 0 ? tv[i] : 0.f; }
    WAVE_SYNC();
    const int c = lane & 7;
#pragma unroll
    for (int j = 0; j < 4; ++j) { const int n = (lane >> 3) + 8 * j; const LAS float* s = scr + (8 * c) * 33 + n;
        u32x4 o; o.x = pk2(s[0 * 33], s[1 * 33]); o.y = pk2(s[2 * 33], s[3 * 33]); o.z = pk2(s[4 * 33], s[5 * 33]); o.w = pk2(s[6 * 33], s[7 * 33]);
        *(u32x4*)(WT + (size_t)(n0 + n) * K + k0 + 8 * c) = o; }
    WAVE_SYNC();
}

__device__ __forceinline__ void p0_weights(const PV& P, LAS unsigned char* lds, int gw, int ngw, int wave, int lane, int it_lo, int it_hi) {
    LAS float* scr = (LAS float*)(lds + wave * 8704);
    constexpr int I_IN = 16 * 88, I_OUT = 16 * 32, I_UP = 16 * 176, I_DN = 44 * 32, I_GLU = 4 * 8, I_LAYER = I_IN + I_OUT + I_UP + I_DN + I_GLU;
    for (int it = it_lo + gw; it < it_hi; it += ngw) {
        const int l = it / I_LAYER; int r = it % I_LAYER;
        if (r < I_IN) { transpose_item(P.in_(I_WIN) + (size_t)l * DM * D_IN, DM, D_IN, (bf16_t*)(P.ws_() + WS_WIN) + (size_t)l * NIN * DM, scr, r, 88, lane, [](int n) { return n < D_IN ? n : -1; }); continue; } r -= I_IN;
        if (r < I_OUT) { transpose_item(P.in_(I_WOUT) + (size_t)l * DM * DM, DM, DM, (bf16_t*)(P.ws_() + WS_WOUT) + (size_t)l * DM * DM, scr, r, 32, lane, [](int n) { return n; }); continue; } r -= I_OUT;
        if (r < I_UP) { transpose_item(P.in_(I_FUP) + (size_t)l * DM * 2 * DFF, DM, 2 * DFF, (bf16_t*)(P.ws_() + WS_WUP) + (size_t)l * 2 * DFF * DM, scr, r, 176, lane,
                                       [](int n) { const int q = n >> 5, rem = n & 31, G = q * 16 + (rem & 15); return rem < 16 ? G : DFF + G; }); continue; } r -= I_UP;
        if (r < I_DN) { transpose_item(P.in_(I_FDN) + (size_t)l * DFF * DM, DFF, DM, (bf16_t*)(P.ws_() + WS_WDN) + (size_t)l * DM * DFF, scr, r, 32, lane, [](int n) { return n; }); continue; } r -= I_DN;
        transpose_item(P.in_(I_5GW) + (size_t)l * 256 * 256, 256, 256, (bf16_t*)(P.ws_() + WS_WGLU) + (size_t)l * 256 * 256, scr, r, 8, lane, [](int n) { return n; });
    }
}

__device__ __forceinline__ void p0_mod(const PV& P, LAS unsigned char* lds, int blk, int nblk, int it_lo, int it_hi) {
    LAS float* sc = (LAS float*)lds;
    LAS float* red = (LAS float*)(lds + 17 * 1024 * 4);
    const int tid = P.tid;
    bool loaded = false;
    for (int it = it_lo + blk; it < it_hi; it += nblk) {
        __syncthreads();
        if (!loaded) {
            for (int i = tid; i < 17 * 1024; i += 512) { const float v = i < 16 * 1024 ? P.in_(I_C)[i] : P.in_(I_CCTX)[i - 16 * 1024]; sc[i] = siluf_(v); }
            loaded = true;
        }
        __syncthreads();
        const int l = it / 192, j0 = (it % 192) * 32, col = tid & 31, ks = tid >> 5;
        const float* w = P.in_(I_MODW) + (size_t)l * DM * 6144 + j0 + col;
        float a[17];
#pragma unroll
        for (int r = 0; r < 17; ++r) a[r] = 0.f;
#pragma unroll 1
        for (int k0 = ks * 64; k0 < ks * 64 + 64; k0 += 16) {
            float wv[16];
#pragma unroll
            for (int u = 0; u < 16; ++u) wv[u] = w[(size_t)(k0 + u) * 6144];
#pragma unroll
            for (int u = 0; u < 16; ++u)
#pragma unroll
                for (int r = 0; r < 17; ++r) a[r] += sc[r * 1024 + k0 + u] * wv[u];
        }
#pragma unroll
        for (int r = 0; r < 17; ++r) red[(ks * 17 + r) * 32 + col] = a[r];
        __syncthreads();
        for (int i = tid; i < 17 * 32; i += 512) {
            const int r = i >> 5, c = i & 31; float s = 0.f;
#pragma unroll
            for (int k = 0; k < 16; ++k) s += red[(k * 17 + r) * 32 + c];
            ((float*)(P.ws_() + WS_MOD))[((size_t)l * 17 + r) * 6144 + j0 + c] = s + P.in_(I_MODB)[(size_t)l * 6144 + j0 + c];
        }
    }
    __syncthreads();
}

__device__ __forceinline__ void p0_filter(const PV& P, LAS unsigned char* lds, int blk, int nblk, int it_lo, int it_hi) {
    LAS float* feats = (LAS float*)lds;
    LAS float* h1 = feats + 32 * 33;
    LAS float* h2 = h1 + 32 * 65;
    const int tid = P.tid, pl = tid & 31, part = tid >> 5;
    for (int it2 = 2 * it_lo + blk; it2 < 2 * it_hi; it2 += nblk) {
        const int it = it2 >> 1, half = it2 & 1;
        int l, kind, pb;
        if (it < 64) { l = 0; kind = 0; pb = it; } else if (it < 72) { l = 0; kind = 1; pb = it - 64; } else { l = 1; kind = 0; pb = it - 72; }
        const int L = kind ? CTX : SEQ, pos = pb * 32 + pl;
        const float tt = (float)pos / (float)(L - 1);
        const float w = (6.283185307179586f * (float)pos) / (float)L;
        __syncthreads();
        {
            const float band = 1e-4f + (float)part * ((15.0f - 1e-4f) / 15.0f);
            float sn, cs; sincosf(band * w, &sn, &cs);
            feats[pl * 33 + 1 + part] = cs; feats[pl * 33 + 17 + part] = -sn;
            if (part == 0) feats[pl * 33] = tt;
        }
        __syncthreads();
        const float* w1 = P.in_(I_HW1) + (size_t)l * 33 * 64; const float* b1 = P.in_(I_HB1) + l * 64; const float* fq = P.in_(I_HFREQ) + l * 64;
        const float* w2 = P.in_(I_HW2) + (size_t)l * 64 * 64; const float* b2 = P.in_(I_HB2) + l * 64; const float* w3 = P.in_(I_HW3) + (size_t)l * 64 * 1024;
        {
            float a[4];
#pragma unroll
            for (int o = 0; o < 4; ++o) a[o] = b1[part * 4 + o];
#pragma unroll 1
            for (int f0 = 0; f0 < 33; f0 += 11) {
                f32x4 wv[11];
#pragma unroll
                for (int u = 0; u < 11; ++u) wv[u] = *(const f32x4*)(w1 + (f0 + u) * 64 + part * 4);
#pragma unroll
                for (int u = 0; u < 11; ++u) { const float fv = feats[pl * 33 + f0 + u]; a[0] += fv * wv[u].x; a[1] += fv * wv[u].y; a[2] += fv * wv[u].z; a[3] += fv * wv[u].w; }
            }
#pragma unroll
            for (int o = 0; o < 4; ++o) h1[pl * 65 + part * 4 + o] = sinf(fq[part * 4 + o] * a[o]);
        }
        __syncthreads();
        {
            float a[4];
#pragma unroll
            for (int o = 0; o < 4; ++o) a[o] = b2[part * 4 + o];
#pragma unroll 1
            for (int k0 = 0; k0 < 64; k0 += 16) {
                f32x4 wv[16];
#pragma unroll
                for (int u = 0; u < 16; ++u) wv[u] = *(const f32x4*)(w2 + (k0 + u) * 64 + part * 4);
#pragma unroll
                for (int u = 0; u < 16; ++u) { const float hv = h1[pl * 65 + k0 + u]; a[0] += hv * wv[u].x; a[1] += hv * wv[u].y; a[2] += hv * wv[u].z; a[3] += hv * wv[u].w; }
            }
#pragma unroll
            for (int o = 0; o < 4; ++o) h2[pl * 65 + part * 4 + o] = sinf(fq[part * 4 + o] * a[o]);
        }
        __syncthreads();
        const int dir = part >> 3, order = (part >> 2) & 1;
        float* G = kind ? (float*)(P.ws_() + WS_GCTX) : (float*)(P.ws_() + WS_GLAT) + (size_t)l * 2 * 256 * 4096;
        const int GL = 2 * L;
        const float min_decay = -3.0701134573253945f, max_decay = -15.350567286626972f;
#pragma unroll 1
        for (int ps = 2 * half; ps < 2 * half + 2; ++ps) {
            float a[16];
#pragma unroll
            for (int o = 0; o < 16; ++o) a[o] = 0.f;
            const int c0 = part * 64 + ps * 16;
#pragma unroll 1
            for (int k0 = 0; k0 < 64; k0 += 4) {
                f32x4 wv[4][4];
#pragma unroll
                for (int u = 0; u < 4; ++u)
#pragma unroll
                    for (int q = 0; q < 4; ++q) wv[u][q] = ((const f32x4*)(w3 + (size_t)(k0 + u) * 1024 + c0))[q];
#pragma unroll
                for (int u = 0; u < 4; ++u) { const float hv = h2[pl * 65 + k0 + u];
#pragma unroll
                    for (int q = 0; q < 4; ++q) { a[4 * q] += hv * wv[u][q].x; a[4 * q + 1] += hv * wv[u][q].y; a[4 * q + 2] += hv * wv[u][q].z; a[4 * q + 3] += hv * wv[u][q].w; } }
            }
#pragma unroll
            for (int o = 0; o < 16; ++o) {
                const int col = c0 + o, ch = col & 255;
                const float delta = fabsf(min_decay + (float)col * ((max_decay - min_decay) / 1023.0f));
                float val = a[o] * expf(-tt * delta);
                int x = dir == 0 ? L - pos : L + pos;
                if (dir == 1 && pos == 0) { x = 0; val = 0.f; }
                G[(size_t)(order * 256 + ch) * GL + x] = val;
            }
        }
    }
    __syncthreads();
}

__device__ __forceinline__ void p0_s5(const PV& P, int gw, int ngw, int lane, int it_lo, int it_hi) {
    for (int it = it_lo + gw; it < it_hi; it += ngw) {
        const int l = it >> 5, dir = (it >> 4) & 1, g = it & 15, p = lane;
        const int idx = ((l * 2 + dir) * 16 + g);
        const float dt = expf(P.in_(I_5LDT)[idx]);
        const float are = P.in_(I_5ARE)[idx * 64 + p], aim = P.in_(I_5AIM)[idx * 64 + p];
        const float mag = expf(are * dt); float sn, cs; sincosf(aim * dt, &sn, &cs);
        const float abr = mag * cs, abi = mag * sn, den = are * are + aim * aim;
        const float zr = ((abr - 1.f) * are + abi * aim) / den, zi = (abi * are - (abr - 1.f) * aim) / den;
        ((f32x2*)(P.ws_() + WS_S5AB))[idx * 64 + p] = (f32x2){abr, abi};
        bf16_t* bb = (bf16_t*)(P.ws_() + WS_S5BB) + (size_t)idx * 128 * 16;
        const float* bre = P.in_(I_5BRE) + ((size_t)(l * 16 + g) * 64 + p) * 16; const float* bim = P.in_(I_5BIM) + ((size_t)(l * 16 + g) * 64 + p) * 16;
        for (int c = 0; c < 16; ++c) {
            const float br = bre[c], bi = bim[c];
            bb[p * 16 + c] = f2bf(zr * br - zi * bi);
            bb[(64 + p) * 16 + c] = f2bf(zr * bi + zi * br);
        }
        bf16_t* cm = (bf16_t*)(P.ws_() + WS_S5CM) + (size_t)idx * 16 * 128;
        for (int c = 0; c < 16; ++c) {
            cm[c * 128 + p] = f2bf(P.in_(I_5CRE)[((size_t)idx * 16 + c) * 64 + p]);
            cm[c * 128 + 64 + p] = f2bf(-P.in_(I_5CIM)[((size_t)idx * 16 + c) * 64 + p]);
        }
    }
}

__device__ __forceinline__ void norm_phase(const PV& P, int l, int which, int M, int gw, int ngw, int lane) {
    const float* gam = P.in_(which == 1 ? I_N1G : I_N2G) + l * DM;
    const float* mod = (const float*)(P.ws_() + WS_MOD) + (size_t)l * 17 * 6144;
    const int so = which == 1 ? 0 : 3 * DM, co = which == 1 ? DM : 4 * DM;
    const bool from_in = (l == 0 && which == 1);
    bf16_t* Xn = (bf16_t*)(P.ws_() + WS_XN);
    constexpr int NR = 3;
    auto row_src = [&](int row) __attribute__((always_inline)) {
        const bool lat = row < MLAT;
        return lat ? (from_in ? P.in_(I_X) : P.out_()) + (size_t)row * DM : (from_in ? P.in_(I_CTX) : (const float*)(P.ws_() + WS_HC)) + (size_t)(row - MLAT) * DM;
    };
    f32x4 nx[NR][4];
#pragma unroll
    for (int q = 0; q < NR; ++q) { const int rr = gw + q * ngw; const float* src = row_src(rr < M ? rr : gw);
#pragma unroll
        for (int j = 0; j < 4; ++j) nx[q][j] = *(const f32x4*)(src + 4 * lane + 256 * j); }
    for (int row0 = gw; row0 < M; row0 += NR * ngw) {
        f32x4 v[NR][4]; float ss[NR];
#pragma unroll
        for (int q = 0; q < NR; ++q)
#pragma unroll
            for (int j = 0; j < 4; ++j) v[q][j] = nx[q][j];
        const int nrow0 = row0 + NR * ngw;
        if (nrow0 < M) {
#pragma unroll
            for (int q = 0; q < NR; ++q) { const int rr = nrow0 + q * ngw; const float* src = row_src(rr < M ? rr : nrow0);
#pragma unroll
                for (int j = 0; j < 4; ++j) nx[q][j] = *(const f32x4*)(src + 4 * lane + 256 * j); }
        }
#pragma unroll
        for (int q = 0; q < NR; ++q) { float s_ = 0.f;
#pragma unroll
            for (int j = 0; j < 4; ++j) s_ += v[q][j].x * v[q][j].x + v[q][j].y * v[q][j].y + v[q][j].z * v[q][j].z + v[q][j].w * v[q][j].w;
            ss[q] = s_; }
#pragma unroll
        for (int q = 0; q < NR; ++q) {
            const int row = row0 + q * ngw;
            if (row < M) {
                const bool lat = row < MLAT;
                const float* mr = mod + (size_t)(lat ? (row >> 11) : 16) * 6144;
                const float rstd = rsqrtf(wave_sum(ss[q]) * (1.f / DM) + 1e-6f);
#pragma unroll
                for (int j = 0; j < 4; ++j) {
                    const int c = 4 * lane + 256 * j;
                    const f32x4 g = *(const f32x4*)(gam + c), sh = *(const f32x4*)(mr + so + c), sc = *(const f32x4*)(mr + co + c);
                    const f32x4 y = (v[q][j] * rstd * g) * (sc + 1.f) + sh;
                    u32x2 w; w.x = pk2(y.x, y.y); w.y = pk2(y.z, y.w);
                    *(u32x2*)(Xn + (size_t)row * DM + c) = w;
                }
            }
        }
    }
}

__device__ __forceinline__ void conv8(const bf16_t* Urow, bool hasPrev, bool hasNext, const float* w, int ws, const float* b, float* out) {
    float c0[8], cm[8], cp[8];
    unpack8(*(const u32x4*)Urow, c0);
    if (hasPrev) unpack8(*(const u32x4*)(Urow - UW), cm); else {
#pragma unroll
        for (int e = 0; e < 8; ++e) cm[e] = 0.f; }
    if (hasNext) unpack8(*(const u32x4*)(Urow + UW), cp); else {
#pragma unroll
        for (int e = 0; e < 8; ++e) cp[e] = 0.f; }
#pragma unroll
    for (int e = 0; e < 8; ++e) out[e] = b[e] + w[e] * cm[e] + w[ws + e] * c0[e] + w[2 * ws + e] * cp[e];
}


__device__ __forceinline__ void xbc_prepass(const PV& P, int l, int blk, int nblk) {
    const bf16_t* U = (const bf16_t*)(P.ws_() + WS_U); bf16_t* X = (bf16_t*)(P.ws_() + WS_XBC);
    const float* cw = P.in_(I_SCW) + (size_t)l * 3 * 384; const float* cb = P.in_(I_SCB) + (size_t)l * 384;
    const int c = (P.tid % 48) * 8, rsub = P.tid / 48;
    if (rsub >= 10) return;
    float w0[8], w1[8], w2[8], b8[8];
#pragma unroll
    for (int e = 0; e < 8; ++e) { w0[e] = cw[c + e]; w1[e] = cw[384 + c + e]; w2[e] = cw[768 + c + e]; b8[e] = cb[c + e]; }
    const int step = 2 * nblk * 10;
    auto row_of = [&](int rr, int fallback) __attribute__((always_inline)) { return rr < MTOT ? rr : fallback; };
    u32x4 nx[2][3];
    {
#pragma unroll
        for (int q = 0; q < 2; ++q) {
            const int row = row_of(blk * 10 + rsub + q * nblk * 10, blk * 10 + rsub);
            const bool lat = row < MLAT; const int t = lat ? (row & 2047) : ((row - MLAT) & 255); const bool hp = t > 0, hn = t < (lat ? SEQ : CTX) - 1;
            const bf16_t* Ur = U + (size_t)row * UW + UC_X + c;
            nx[q][1] = *(const u32x4*)Ur; nx[q][0] = *(const u32x4*)(Ur - (hp ? UW : 0)); nx[q][2] = *(const u32x4*)(Ur + (hn ? UW : 0));
        }
    }
    for (int row0 = blk * 10 + rsub; row0 < MTOT; row0 += step) {
        u32x4 r[2][3];
#pragma unroll
        for (int q = 0; q < 2; ++q)
#pragma unroll
            for (int k = 0; k < 3; ++k) r[q][k] = nx[q][k];
        if (row0 + step < MTOT) {
#pragma unroll
            for (int q = 0; q < 2; ++q) {
                const int row = row_of(row0 + step + q * nblk * 10, row0 + step);
                const bool lat = row < MLAT; const int t = lat ? (row & 2047) : ((row - MLAT) & 255); const bool hp = t > 0, hn = t < (lat ? SEQ : CTX) - 1;
                const bf16_t* Ur = U + (size_t)row * UW + UC_X + c;
                nx[q][1] = *(const u32x4*)Ur; nx[q][0] = *(const u32x4*)(Ur - (hp ? UW : 0)); nx[q][2] = *(const u32x4*)(Ur + (hn ? UW : 0));
            }
        }
#pragma unroll
        for (int q = 0; q < 2; ++q) {
            const int rr = row0 + q * nblk * 10; const bool ok = rr < MTOT; const int row = ok ? rr : row0;
            const bool lat = row < MLAT; const int t = lat ? (row & 2047) : ((row - MLAT) & 255); const bool hp = t > 0, hn = t < (lat ? SEQ : CTX) - 1;
            float xm[8], x0[8], xp[8], o[8];
            unpack8(r[q][0], xm); unpack8(r[q][1], x0); unpack8(r[q][2], xp);
#pragma unroll
            for (int e = 0; e < 8; ++e) o[e] = siluf_(b8[e] + w0[e] * (hp ? xm[e] : 0.f) + w1[e] * x0[e] + w2[e] * (hn ? xp[e] : 0.f));
            if (ok) *(u32x4*)(X + (size_t)row * 384 + c) = pack8(o);
        }
    }
}

constexpr int SC_QS = 0, SC_KS = 18432, SC_KT = 36864, SC_VT = 54272, SC_PM = 71680, SC_HT = 106496, SC_CS = 115712, SC_LA = 119808, SC_ROPE = 120320;
__device__ __forceinline__ void scan_item(const PV& P, LAS unsigned char* lds, int l, int kind, int b, int h, int dir) {
    const int tid = P.tid, lane = tid & 63, w = __builtin_amdgcn_readfirstlane(tid >> 6), fr = lane & 15, fq = lane >> 4;
    LAS bf16_t* Qs = (LAS bf16_t*)(lds + SC_QS); LAS bf16_t* Ks = (LAS bf16_t*)(lds + SC_KS); LAS bf16_t* Kt = (LAS bf16_t*)(lds + SC_KT);
    LAS bf16_t* Vt = (LAS bf16_t*)(lds + SC_VT); LAS bf16_t* Pm = (LAS bf16_t*)(lds + SC_PM); LAS bf16_t* Ht = (LAS bf16_t*)(lds + SC_HT);
    LAS float* cs_all = (LAS float*)(lds + SC_CS); LAS float* la = (LAS float*)(lds + SC_LA); LAS float* rope = (LAS float*)(lds + SC_ROPE);
    const bf16_t* U = (const bf16_t*)(P.ws_() + WS_U); const bf16_t* XBC = (const bf16_t*)(P.ws_() + WS_XBC);
    bf16_t* Y = (bf16_t*)(P.ws_() + WS_Y) + (size_t)((kind ? 2 : 0) + dir) * MTOT * 256;
    __syncthreads();
    for (int i = tid; i < 64 * 36; i += 512) ((LAS unsigned*)Ht)[i] = 0u;
    float a_dir = 0.f, dtb = 0.f;
    if (kind == 0) { a_dir = -expf(P.in_(I_SALOG)[(l * 2 + dir) * 4 + h]); dtb = P.in_(I_SDTB)[(l * 2 + dir) * 4 + h]; }
    else {
        a_dir = -expf(P.in_(I_RDEC)[(l * 2 + dir) * 4 + h]);
        for (int i = tid; i < 64 * 16; i += 512) { const int pos = i >> 4, fi = i & 15; const float inv = powf(10000.0f, -(float)fi / 16.0f); float sn, c; sincosf((float)pos * inv, &sn, &c); rope[i] = c; rope[1024 + i] = sn; }
    }
    const float* cw = P.in_(I_SCW) + (size_t)l * 3 * 384; const float* cb = P.in_(I_SCB) + (size_t)l * 384;
    f32x4 hacc[2] = {(f32x4){0.f, 0.f, 0.f, 0.f}, (f32x4){0.f, 0.f, 0.f, 0.f}};
    __syncthreads();
#define SC_DECL(IT) u32x4 rw##IT##a = {0u, 0u, 0u, 0u}, rw##IT##b = {0u, 0u, 0u, 0u}, rw##IT##c = {0u, 0u, 0u, 0u};
    SC_DECL(0) SC_DECL(1) SC_DECL(2) SC_DECL(3) SC_DECL(4) SC_DECL(5)
    bf16_t dtr0 = 0, dtr1 = 0;
#define SC_ISSUE(IT) { \
        const int k2 = (IT) & 1, mat = (IT) >> 1; \
        const int vi = tid + 512 * k2, i = vi >> 3, c8 = (vi & 7) * 8; \
        const int t = dir == 0 ? g_c0 + i : g_c0 + 127 - i; \
        const bf16_t* Ur = U + (size_t)(g_tokbase + t) * UW; \
        if (kind == 0) { \
            const int xcol = (mat == 0 ? h * 64 : (mat == 1 ? 256 : 320)) + c8; \
            rw##IT##a = *(const u32x4*)(XBC + (size_t)(g_tokbase + t) * 384 + xcol); \
            if (mat == 1) { if (k2 == 0) dtr0 = Ur[UC_DT + dir * 4 + h]; else dtr1 = Ur[UC_DT + dir * 4 + h]; } \
        } else { \
            const int ucol = (mat == 0 ? UC_V : (mat == 1 ? UC_K : UC_Q)) + h * 64; \
            rw##IT##a = *(const u32x4*)(Ur + ucol + c8); \
            if (mat != 0) rw##IT##b = *(const u32x4*)(Ur + ucol + (((c8 & 31) < 16) ? c8 + 16 : c8 - 16)); \
        } }
#define SC_ISSUE_ALL(CK) { \
        const int ck_ = (CK); const bool g_isctx = ck_ < 2; \
        const int g_Ls = g_isctx ? CTX : SEQ, g_nck = g_isctx ? 2 : 16, g_cidx = g_isctx ? ck_ : ck_ - 2; \
        const int g_c0 = (dir == 0 ? g_cidx : g_nck - 1 - g_cidx) * 128, g_tokbase = g_isctx ? MLAT + b * CTX : b * SEQ; \
        SC_ISSUE(0) SC_ISSUE(1) SC_ISSUE(2) SC_ISSUE(3) SC_ISSUE(4) SC_ISSUE(5) }
#define SC_PROC(IT) { \
        const int k2 = (IT) & 1, mat = (IT) >> 1; \
        const int vi = tid + 512 * k2, i = vi >> 3, c8 = (vi & 7) * 8; \
        const int t = dir == 0 ? c0 + i : c0 + 127 - i; \
        float x[8]; \
        if (kind == 0) { \
            unpack8(rw##IT##a, x); \
            if (mat == 1) { \
                const float dt = softplusf_(bf2f(k2 == 0 ? dtr0 : dtr1) + dtb); \
                _Pragma("unroll") for (int e = 0; e < 8; ++e) x[e] *= dt; \
                if (c8 == 0) la[i] = dt * a_dir; \
            } \
        } else { \
            unpack8(rw##IT##a, x); \
            if (mat != 0 && !isctx) { \
                const int half = c8 >> 5, e32 = c8 & 31; const bool first = e32 < 16; const int fi0 = e32 & 15; \
                float xp[8]; \
                unpack8(rw##IT##b, xp); \
                const int pos = half == 0 ? (t >> 6) : (t & 63); \
                _Pragma("unroll") for (int e = 0; e < 8; ++e) { \
                    const float c = rope[pos * 16 + fi0 + e], sn = rope[1024 + pos * 16 + fi0 + e]; \
                    x[e] = first ? x[e] * c - xp[e] * sn : xp[e] * sn + x[e] * c; } \
            } \
            if (mat == 1) { \
                _Pragma("unroll") for (int e = 0; e < 8; ++e) x[e] *= 0.125f; \
                if (c8 == 0) la[i] = a_dir; \
            } \
        } \
        if (mat == 0) { _Pragma("unroll") for (int e = 0; e < 8; ++e) Vt[(c8 + e) * 136 + (i ^ (c8 & 56))] = f2bf(x[e]); } \
        else if (mat == 1) *(LAS u32x4*)(Ks + i * 72 + c8) = pack8(x); \
        else *(LAS u32x4*)(Qs + i * 72 + c8) = pack8(x); }
    SC_ISSUE_ALL(0)
    for (int ck = 0; ck < 18; ++ck) {
        const bool isctx = ck < 2;
        const int Ls = isctx ? CTX : SEQ, nck = isctx ? 2 : 16, cidx = isctx ? ck : ck - 2;
        const int c0 = (dir == 0 ? cidx : nck - 1 - cidx) * 128;
        const int tokbase = isctx ? MLAT + b * CTX : b * SEQ;
        SC_PROC(0) SC_PROC(1) SC_PROC(2) SC_PROC(3) SC_PROC(4) SC_PROC(5)
#ifdef XP1
        asm volatile("" ::: "memory"); SC_PROC(0) SC_PROC(1) SC_PROC(2) SC_PROC(3) SC_PROC(4) SC_PROC(5)
#endif
        if (ck + 1 < 18) SC_ISSUE_ALL(ck + 1)
        __syncthreads();
        LAS float* cs = cs_all + w * 128;
        {
            const float a0 = la[2 * lane], a1 = la[2 * lane + 1];
            float s = a0 + a1;
#pragma unroll
            for (int o = 1; o < 64; o <<= 1) { const float tv = __shfl_up(s, o); if (lane >= o) s += tv; }
            cs[2 * lane] = s - a1; cs[2 * lane + 1] = s;
        }
        WAVE_SYNC();
        const float cs_end = cs[127];
#pragma unroll 1
        for (int k2 = 0; k2 < 2; ++k2) {
            const int vi = tid + 512 * k2, i = vi >> 3, c8 = (vi & 7) * 8;
            const float te = __expf(cs_end - cs[i]);
            float kv[8]; { const LAS unsigned* kp = (const LAS unsigned*)(Ks + i * 72 + c8); u32x4 kw; kw.x = kp[0]; kw.y = kp[1]; kw.z = kp[2]; kw.w = kp[3]; unpack8(kw, kv); }
#pragma unroll
            for (int e = 0; e < 8; ++e) Kt[(c8 + e) * 136 + (i ^ (c8 & 56))] = f2bf(kv[e] * te);
        }
#pragma unroll 1
        for (int k5 = 0; k5 < 5; ++k5) {
            const int id = w + 8 * k5;
            const int it = (id >= 2) + (id >= 4) + (id >= 8) + (id >= 12) + (id >= 18) + (id >= 24) + (id >= 32);
            const int cb0 = 2 * (id >= 2) + 2 * (id >= 4) + 4 * (id >= 8) + 4 * (id >= 12) + 6 * (id >= 18) + 6 * (id >= 24) + 8 * (id >= 32);
            const int jt = id - cb0, i0t = 16 * it;
            u32x2 pw;
            if (jt <= it) {
                const float csi = cs[i0t + fr];
                f32x4 acc = {0.f, 0.f, 0.f, 0.f};
#pragma unroll
                for (int kk = 0; kk < 2; ++kk) { const bf16x8 kf = *(const LAS bf16x8*)(Ks + (jt * 16 + fr) * 72 + kk * 32 + fq * 8); const bf16x8 qf = *(const LAS bf16x8*)(Qs + (i0t + fr) * 72 + kk * 32 + fq * 8);
                    acc = __builtin_amdgcn_mfma_f32_16x16x32_bf16(kf, qf, acc, 0, 0, 0); }
                const int j = jt * 16 + 4 * fq, i = i0t + fr;
                float pv[4];
#pragma unroll
                for (int r = 0; r < 4; ++r) pv[r] = (j + r <= i) ? acc[r] * __expf(csi - cs[j + r]) : 0.f;
                pw.x = pk2(pv[0], pv[1]); pw.y = pk2(pv[2], pv[3]);
            } else { pw.x = 0u; pw.y = 0u; }
            *(LAS u32x2*)(Pm + (i0t + fr) * 136 + jt * 16 + 4 * fq) = pw;
        }
        __syncthreads();
#pragma unroll
        for (int hh = 0; hh < 2; ++hh) {
            const int it = hh == 0 ? w : 7 - w, i0t = 16 * it;
            const int nk = (it >> 1) + 1;
            const float ecs = __expf(cs[i0t + fr]);
            const int i = i0t + fr, t = dir == 0 ? c0 + i : c0 + 127 - i;
            bf16_t* yrow = Y + (size_t)(tokbase + t) * 256 + h * 64;
            bf16x8 qf[2];
#pragma unroll
            for (int kk = 0; kk < 2; ++kk) qf[kk] = *(const LAS bf16x8*)(Qs + (i0t + fr) * 72 + kk * 32 + fq * 8);
#pragma unroll
            for (int pp = 0; pp < 2; ++pp) {
                const int pt = 2 * hh + pp;
                f32x4 a1 = {0.f, 0.f, 0.f, 0.f}, a2 = {0.f, 0.f, 0.f, 0.f};
                for (int kk = 0; kk < nk; ++kk) {
                    const bf16x8 vf = *(const LAS bf16x8*)(Vt + (pt * 16 + fr) * 136 + ((kk * 32 + fq * 8) ^ ((pt * 16 + fr) & 56)));
                    const bf16x8 pf = *(const LAS bf16x8*)(Pm + (i0t + fr) * 136 + kk * 32 + fq * 8);
                    a1 = __builtin_amdgcn_mfma_f32_16x16x32_bf16(vf, pf, a1, 0, 0, 0);
                }
#pragma unroll
                for (int kk = 0; kk < 2; ++kk) { const bf16x8 hf = *(const LAS bf16x8*)(Ht + (pt * 16 + fr) * 72 + kk * 32 + fq * 8); a2 = __builtin_amdgcn_mfma_f32_16x16x32_bf16(hf, qf[kk], a2, 0, 0, 0); }
                u32x2 yw; yw.x = pk2(a1[0] + ecs * a2[0], a1[1] + ecs * a2[1]); yw.y = pk2(a1[2] + ecs * a2[2], a1[3] + ecs * a2[3]);
                *(u32x2*)(yrow + pt * 16 + 4 * fq) = yw;
            }
        }
        {
            const float dec = __expf(cs_end);
#pragma unroll
            for (int q2 = 0; q2 < 2; ++q2) {
                const int id = 2 * w + q2, nt = id >> 2, pt = id & 3;
                hacc[q2] = hacc[q2] * dec;
#pragma unroll
                for (int kk = 0; kk < 4; ++kk) {
                    const bf16x8 kf = *(const LAS bf16x8*)(Kt + (nt * 16 + fr) * 136 + ((kk * 32 + fq * 8) ^ ((nt * 16 + fr) & 56)));
                    const bf16x8 vf = *(const LAS bf16x8*)(Vt + (pt * 16 + fr) * 136 + ((kk * 32 + fq * 8) ^ ((pt * 16 + fr) & 56)));
                    hacc[q2] = __builtin_amdgcn_mfma_f32_16x16x32_bf16(kf, vf, hacc[q2], 0, 0, 0);
                }
            }
        }
        __syncthreads();
#pragma unroll
        for (int q2 = 0; q2 < 2; ++q2) {
            const int id = 2 * w + q2, nt = id >> 2, pt = id & 3;
            u32x2 hw; hw.x = pk2(hacc[q2][0], hacc[q2][1]); hw.y = pk2(hacc[q2][2], hacc[q2][3]);
            *(LAS u32x2*)(Ht + (pt * 16 + fr) * 72 + nt * 16 + 4 * fq) = hw;
        }
    }
    __syncthreads();
}

template <bool WITH_Y>
__device__ __forceinline__ void s5_pass(const bf16_t* U, bf16_t* Y, LAS float* buL, LAS bf16_t* hL, const bf16x8 (&bbf)[8], const bf16x8 (&cmf)[4],
                                        const f32x2 ab, float& hre, float& him, int b, int dir, int g, int j0, int lane) {
    const int fr = lane & 15, fq = lane >> 4;
    auto tok_row = [&](int j) { const bool c = j < 16; const int Ls = c ? CTX : SEQ, jb = c ? j : j - 16; const int ti = jb * 16 + fr; return (c ? MLAT + b * CTX : b * SEQ) + (dir == 0 ? ti : Ls - 1 - ti); };
    const bf16_t* ucol = U + UC_S5 + g * 16 + (fq & 1) * 8;
    const unsigned umask = fq < 2 ? 0xffffffffu : 0u;
    u32x4 unext = *(const u32x4*)(ucol + (size_t)tok_row(j0) * UW);
    for (int j = j0; j < j0 + 36; ++j) {
        const int row = tok_row(j);
        u32x4 ucur = unext; ucur.x &= umask; ucur.y &= umask; ucur.z &= umask; ucur.w &= umask;
        unext = *(const u32x4*)(ucol + (size_t)tok_row(j < j0 + 35 ? j + 1 : j) * UW);
        const bf16x8 uf = __builtin_bit_cast(bf16x8, ucur);
#pragma unroll
        for (int T = 0; T < 8; ++T) {
            f32x4 d = {0.f, 0.f, 0.f, 0.f};
            d = __builtin_amdgcn_mfma_f32_16x16x32_bf16(bbf[T], uf, d, 0, 0, 0);
            *(LAS f32x4*)(buL + fr * 132 + 16 * T + 4 * fq) = d;
        }
        WAVE_SYNC();
        float br[16], bi[16];
#pragma unroll
        for (int i = 0; i < 16; ++i) { br[i] = buL[i * 132 + lane]; bi[i] = buL[i * 132 + 64 + lane]; }
#pragma unroll
        for (int i = 0; i < 16; ++i) {
            const float nr = ab.x * hre - ab.y * him + br[i], ni = ab.x * him + ab.y * hre + bi[i];
            hre = nr; him = ni;
            if (WITH_Y) { hL[i * 136 + lane] = f2bf(hre); hL[i * 136 + 64 + lane] = f2bf(him); }
        }
        WAVE_SYNC();
        if (WITH_Y) {
            f32x4 acc = {0.f, 0.f, 0.f, 0.f};
#pragma unroll
            for (int kk = 0; kk < 4; ++kk) { const bf16x8 hf = *(const LAS bf16x8*)(hL + fr * 136 + kk * 32 + fq * 8); acc = __builtin_amdgcn_mfma_f32_16x16x32_bf16(cmf[kk], hf, acc, 0, 0, 0); }
            u32x2 yw; yw.x = pk2(acc[0], acc[1]); yw.y = pk2(acc[2], acc[3]);
            *(u32x2*)(Y + (size_t)row * 256 + g * 16 + 4 * fq) = yw;
            WAVE_SYNC();
        }
    }
}
__device__ __forceinline__ void s5_block(const PV& P, LAS unsigned char* lds, int l, int item) {
    const int tid = P.tid, lane = tid & 63, wave = tid >> 6, fr = lane & 15, fq = lane >> 4;
    const int wi = item * 2 + (wave >> 2), ch = wave & 3, b = wi >> 5, dir = (wi >> 4) & 1, g = wi & 15;
    LAS unsigned char* wl = lds + wave * 12800;
    LAS float* buL = (LAS float*)wl;
    LAS bf16_t* hL = (LAS bf16_t*)(wl + 16 * 132 * 4);
    LAS float* ex = (LAS float*)(lds + 8 * 12800) + (wave >> 2) * 512;
    const int idx = (l * 2 + dir) * 16 + g;
    const f32x2 ab = ((const f32x2*)(P.ws_() + WS_S5AB))[idx * 64 + lane];
    const bf16_t* bb = (const bf16_t*)(P.ws_() + WS_S5BB) + (size_t)idx * 128 * 16;
    const bf16_t* cm = (const bf16_t*)(P.ws_() + WS_S5CM) + (size_t)idx * 16 * 128;
    const bf16x8 zero8 = {0, 0, 0, 0, 0, 0, 0, 0};
    bf16x8 bbf[8], cmf[4];
#pragma unroll
    for (int T = 0; T < 8; ++T) bbf[T] = fq < 2 ? *(const bf16x8*)(bb + (16 * T + fr) * 16 + fq * 8) : zero8;
#pragma unroll
    for (int kk = 0; kk < 4; ++kk) cmf[kk] = *(const bf16x8*)(cm + fr * 128 + kk * 32 + fq * 8);
    const bf16_t* U = (const bf16_t*)(P.ws_() + WS_U);
    bf16_t* Y = (bf16_t*)(P.ws_() + WS_Y) + (size_t)(4 + dir) * MTOT * 256;
    __syncthreads();
    float hre = 0.f, him = 0.f;
    s5_pass<false>(U, Y, buL, hL, bbf, cmf, ab, hre, him, b, dir, g, 36 * ch, lane);
    ex[ch * 128 + lane] = hre; ex[ch * 128 + 64 + lane] = him;
    __syncthreads();
    float ar = ab.x, ai = ab.y, a64r = 0.f, a64i = 0.f;
#pragma unroll
    for (int q = 0; q < 9; ++q) { const float nr = ar * ar - ai * ai, ni = 2.f * ar * ai; ar = nr; ai = ni; if (q == 5) { a64r = ar; a64i = ai; } }
    const float Ar = ar * a64r - ai * a64i, Ai = ar * a64i + ai * a64r;
    float sr = 0.f, si = 0.f;
    for (int j = 0; j < ch; ++j) { const float er = ex[j * 128 + lane], ei = ex[j * 128 + 64 + lane]; const float nr = Ar * sr - Ai * si + er, ni = Ar * si + Ai * sr + ei; sr = nr; si = ni; }
    hre = sr; him = si;
    s5_pass<true>(U, Y, buL, hL, bbf, cmf, ab, hre, him, b, dir, g, 36 * ch, lane);
    __syncthreads();
}

template <int L>
__device__ __forceinline__ void hyena_seg(const PV& P, LAS unsigned char* lds, int l, int ch, int tokbase0, int tokstride) {
    constexpr int TPW = L / 128, NS = L / 32, CPB = (2 * L + 8) * 2, ZROW = (L + 8) * 2, ZOFF = 8 * CPB;
    static_assert(ZOFF + 16 * ZROW <= LDS_BYTES, "hyena LDS");
    const int tid = P.tid, lane = tid & 63, w = __builtin_amdgcn_readfirstlane(tid >> 6), fr = lane & 15, fq = lane >> 4;
    const bf16_t* UH = (const bf16_t*)(P.ws_() + WS_UH);
    bf16_t* ZH = (bf16_t*)(P.ws_() + WS_ZH);
    const float* hcw = P.in_(I_HCW) + (size_t)l * 3 * 768; const float* hcb = P.in_(I_HCB) + (size_t)l * 768;
    LAS bf16_t* cop = (LAS bf16_t*)lds; LAS unsigned char* zs = lds + ZOFF;
    __syncthreads();
    {
        const bf16_t* src = UH + (size_t)(512 + ch) * MTOT;
        const float w0 = hcw[512 + ch], w1 = hcw[768 + 512 + ch], w2 = hcw[2 * 768 + 512 + ch], bz = hcb[512 + ch];
#pragma unroll
        for (int i = tid; i < 16 * L / 8; i += 512) {
            const int b = i / (L / 8), t0 = (i % (L / 8)) * 8; const bf16_t* sp = src + tokbase0 + (size_t)b * tokstride + t0;
            float v[10]; unpack8(*(const u32x4*)sp, v + 1);
            v[0] = t0 > 0 ? bf2f(sp[-1]) : 0.f; v[9] = t0 + 8 < L ? bf2f(sp[8]) : 0.f;
            float o[8];
#pragma unroll
            for (int e = 0; e < 8; ++e) o[e] = bz + w0 * v[e] + w1 * v[e + 1] + w2 * v[e + 2];
            *(LAS u32x4*)(zs + b * ZROW + t0 * 2) = pack8(o);
        }
    }
    for (int order = 0; order < 2; ++order) {
        const float* G = (L == SEQ) ? (const float*)(P.ws_() + WS_GLAT) + ((size_t)(l * 2 + order) * 256 + ch) * 4096 : (const float*)(P.ws_() + WS_GCTX) + ((size_t)order * 256 + ch) * 512;
        LAS float* red = (LAS float*)(lds + LDS_BYTES - 64);
        float sum = 0.f;
        for (int m = tid; m < 2 * L / 8 + 1; m += 512) {
            float gv[16];
#pragma unroll
            for (int q = 0; q < 4; ++q) { const int x0 = 8 * m - 8 + 4 * q; const bool ok = x0 >= 0 && x0 < 2 * L; const f32x4 t4 = ok ? *(const f32x4*)(G + x0) : (f32x4){0.f, 0.f, 0.f, 0.f};
                gv[4 * q] = t4.x; gv[4 * q + 1] = t4.y; gv[4 * q + 2] = t4.z; gv[4 * q + 3] = t4.w; }
#pragma unroll
            for (int e = 8; e < 16; ++e) sum += fabsf(gv[e]);
#pragma unroll
            for (int c = 0; c < 8; ++c) { const int pc = (8 - c) & 7;
                *(LAS u32x4*)((LAS unsigned char*)cop + c * CPB + 16 * m) = pack8(gv + 8 - pc); }
        }
        sum = wave_sum(sum);
        if (lane == 0) red[w] = sum;
        __syncthreads();
        sum = ((red[0] + red[1]) + (red[2] + red[3])) + ((red[4] + red[5]) + (red[6] + red[7]));
        const float inv = 1.f / (sum + 1e-6f);
        f32x4 acc[TPW];
#pragma unroll
        for (int m = 0; m < TPW; ++m) acc[m] = (f32x4){0.f, 0.f, 0.f, 0.f};
        const int cidx = (8 - (fr & 7)) & 7;
        const LAS unsigned char* fbase = lds + cidx * CPB + 2 * (L - (fr & 8) + 8 * fq);
        const LAS unsigned char* zbase = zs + fr * ZROW + fq * 16;
        if constexpr (TPW == 16) {
            bf16x8 fg[16];
#pragma unroll
            for (int m = 2; m < 16; ++m) fg[m] = *(const LAS bf16x8*)(fbase - 32 * (16 * w + m));
            for (int sb = 0; sb < NS / 8; ++sb) {
#pragma unroll
                for (int u = 0; u < 8; ++u) {
                    const int si = sb * 8 + u;
                    fg[(0 - 2 * u) & 15] = *(const LAS bf16x8*)(fbase - 32 * (16 * w - 2 * si));
                    fg[(1 - 2 * u) & 15] = *(const LAS bf16x8*)(fbase - 32 * (16 * w + 1 - 2 * si));
                    const bf16x8 zf = *(const LAS bf16x8*)(zbase + 64 * si);
#pragma unroll
                    for (int m = 0; m < 16; ++m) acc[m] = __builtin_amdgcn_mfma_f32_16x16x32_bf16(fg[(m - 2 * u) & 15], zf, acc[m], 0, 0, 0);
                }
            }
        } else {
            for (int si = 0; si < NS; ++si) {
                const bf16x8 zf = *(const LAS bf16x8*)(zbase + 64 * si);
#pragma unroll
                for (int m = 0; m < TPW; ++m) { const bf16x8 ff = *(const LAS bf16x8*)(fbase - 32 * (TPW * w + m - 2 * si)); acc[m] = __builtin_amdgcn_mfma_f32_16x16x32_bf16(ff, zf, acc[m], 0, 0, 0); }
            }
        }
        __syncthreads();
        {
            const int xc = order * 256 + ch;
            const float w0 = hcw[xc], w1 = hcw[768 + xc], w2 = hcw[2 * 768 + xc], bx = hcb[xc];
            const float bias = P.in_(I_HBIAS)[(size_t)(l * 2 + order) * 256 + ch];
            const bf16_t* xs = UH + (size_t)xc * MTOT + tokbase0 + (size_t)fr * tokstride;
#pragma unroll
            for (int m = 0; m < TPW; ++m) {
                const int t0 = 16 * (TPW * w + m) + 4 * fq;
                float xv[6];
                { const u32x2 xw = *(const u32x2*)(xs + t0); xv[1] = bflo(xw.x); xv[2] = bfhi(xw.x); xv[3] = bflo(xw.y); xv[4] = bfhi(xw.y);
                  xv[0] = t0 > 0 ? bf2f(xs[t0 - 1]) : 0.f; xv[5] = t0 + 4 < L ? bf2f(xs[t0 + 4]) : 0.f; }
                LAS u32x2* zp = (LAS u32x2*)(zs + fr * ZROW + t0 * 2);
                const u32x2 zo = *zp;
                const float zv[4] = {bflo(zo.x), bfhi(zo.x), bflo(zo.y), bfhi(zo.y)};
                float o[4];
#pragma unroll
                for (int r = 0; r < 4; ++r) { const float xg = bx + w0 * xv[r] + w1 * xv[r + 1] + w2 * xv[r + 2]; o[r] = xg * (acc[m][r] * inv + zv[r] * bias); }
                u32x2 ow; ow.x = pk2(o[0], o[1]); ow.y = pk2(o[2], o[3]);
                if (order == 0) *zp = ow;
                else *(u32x2*)(ZH + (size_t)ch * MTOT + tokbase0 + (size_t)fr * tokstride + t0) = ow;
            }
        }
        __syncthreads();
    }
}

constexpr int FZ_T = 0, FZ_V = 256 * 66 * 2;
template <int NROWS>
__device__ __forceinline__ void finalize_item(const PV& P, LAS unsigned char* lds, int l, int row0) {
    constexpr int NPASS = NROWS / 16, NC8 = NROWS / 8;
    const int tid = P.tid, lane = tid & 63, w = __builtin_amdgcn_readfirstlane(tid >> 6), fr = lane & 15, fq = lane >> 4;
    LAS bf16_t* T = (LAS bf16_t*)(lds + FZ_T); LAS bf16_t* Vs = (LAS bf16_t*)(lds + FZ_V);
    const bf16_t* U = (const bf16_t*)(P.ws_() + WS_U);
    const bf16_t* Yb = (const bf16_t*)(P.ws_() + WS_Y); const size_t YS = (size_t)MTOT * 256;
    __syncthreads();
    {
        const bf16_t* ZH = (const bf16_t*)(P.ws_() + WS_ZH);
#pragma unroll
        for (int i = tid; i < 256 * NC8; i += 512) { const int ch = i / NC8, c8 = (i % NC8) * 8; const u32x4 v = *(const u32x4*)(ZH + (size_t)ch * MTOT + row0 + c8);
            LAS unsigned* d = (LAS unsigned*)(T + ch * 66 + c8); d[0] = v.x; d[1] = v.y; d[2] = v.z; d[3] = v.w; }
    }
    __syncthreads();
    const int sub = tid & 31, c = sub * 8;
    const float* cw = P.in_(I_SCW) + (size_t)l * 3 * 384; const float* cb = P.in_(I_SCB) + (size_t)l * 384;
    const float dsk = P.in_(I_SD)[l * 4 + (sub >> 3)];
    const float* ng = P.in_(I_SNG) + l * 256;
    const float* d5 = P.in_(I_5D) + l * 256;
    bf16x8 wf[8][2];
    {
        const bf16_t* Wg0 = (const bf16_t*)(P.ws_() + WS_WGLU) + (size_t)l * 256 * 256;
#pragma unroll
        for (int kk = 0; kk < 8; ++kk)
#pragma unroll
            for (int a = 0; a < 2; ++a) wf[kk][a] = *(const bf16x8*)(Wg0 + (size_t)((2 * w + a) * 16 + fr) * 256 + kk * 32 + fq * 8);
    }
    struct FRaw { u32x4 rx0, rz, rg, ru5, y0, y1, y2, y3, y4, y5; };
    auto load_raw = [&](int pass) __attribute__((always_inline)) {
        const int row = row0 + pass * 16 + (tid >> 5);
        const bf16_t* Ur = U + (size_t)row * UW; const bf16_t* yp = Yb + (size_t)row * 256 + c;
        FRaw f;
        f.rx0 = *(const u32x4*)((const bf16_t*)(P.ws_() + WS_XBC) + (size_t)row * 384 + c);
        f.rz = *(const u32x4*)(Ur + UC_Z + c); f.rg = *(const u32x4*)(Ur + UC_G + c); f.ru5 = *(const u32x4*)(Ur + UC_S5 + c);
        f.y0 = *(const u32x4*)(yp); f.y1 = *(const u32x4*)(yp + YS); f.y2 = *(const u32x4*)(yp + 2 * YS); f.y3 = *(const u32x4*)(yp + 3 * YS); f.y4 = *(const u32x4*)(yp + 4 * YS); f.y5 = *(const u32x4*)(yp + 5 * YS);
        return f;
    };
    float ng8[8], d58[8];
#pragma unroll
    for (int e = 0; e < 8; ++e) { ng8[e] = ng[c + e]; d58[e] = d5[c + e]; }
    FRaw nx = load_raw(0);
#pragma unroll 1
    for (int pass = 0; pass < NPASS; ++pass) {
        const int tk = pass * 16 + (tid >> 5), row = row0 + tk;
        bf16_t* Yc = (bf16_t*)(P.ws_() + WS_XN) + (size_t)row * DM;
        const FRaw cur = nx;
        if (pass + 1 < NPASS) nx = load_raw(pass + 1);
        const u32x4 rx0 = cur.rx0, rz = cur.rz, rg = cur.rg, ru5 = cur.ru5, y0 = cur.y0, y1 = cur.y1, y2 = cur.y2, y3 = cur.y3, y4 = cur.y4, y5 = cur.y5;
        {
            float v[8], x0[8], z[8], yf[8], yb[8]; float ss = 0.f;
            unpack8(rx0, x0); unpack8(rz, z); unpack8(y0, yf); unpack8(y1, yb);
#pragma unroll
            for (int e = 0; e < 8; ++e) { const float y = yf[e] + yb[e] + x0[e] * dsk; const float o = y * siluf_(z[e]); v[e] = o; ss += o * o; }
#pragma unroll
            for (int sh = 1; sh < 32; sh <<= 1) ss += __shfl_xor(ss, sh);
            const float rstd = rsqrtf(ss * (1.f / 256.f) + 1e-6f);
#pragma unroll
            for (int e = 0; e < 8; ++e) v[e] = v[e] * rstd * ng8[e];
            *(u32x4*)(Yc + c) = pack8(v);
        }
        {
            u32x4 o; unsigned short e8[8];
#pragma unroll
            for (int e = 0; e < 8; ++e) e8[e] = T[(c + e) * 66 + tk];
            o.x = e8[0] | ((unsigned)e8[1] << 16); o.y = e8[2] | ((unsigned)e8[3] << 16); o.z = e8[4] | ((unsigned)e8[5] << 16); o.w = e8[6] | ((unsigned)e8[7] << 16);
            *(u32x4*)(Yc + 256 + c) = o;
        }
        {
            float v[8], yf[8], yb[8], g[8]; float sm = 0.f;
            unpack8(y2, yf); unpack8(y3, yb); unpack8(rg, g);
#pragma unroll
            for (int e = 0; e < 8; ++e) { v[e] = yf[e] + yb[e]; sm += v[e]; }
            sm += __shfl_xor(sm, 1); sm += __shfl_xor(sm, 2); sm += __shfl_xor(sm, 4);
            const float mu = sm * (1.f / 64.f); float vs = 0.f;
#pragma unroll
            for (int e = 0; e < 8; ++e) { const float d = v[e] - mu; vs += d * d; }
            vs += __shfl_xor(vs, 1); vs += __shfl_xor(vs, 2); vs += __shfl_xor(vs, 4);
            const float rstd = rsqrtf(vs * (1.f / 64.f) + 1e-6f);
#pragma unroll
            for (int e = 0; e < 8; ++e) v[e] = siluf_(g[e]) * (v[e] - mu) * rstd;
            *(u32x4*)(Yc + 512 + c) = pack8(v);
        }
        {
            float u[8], yf[8], yb[8], o[8];
            unpack8(ru5, u); unpack8(y4, yf); unpack8(y5, yb);
#pragma unroll
            for (int e = 0; e < 8; ++e) o[e] = gelu_tanh(u[e] * d58[e] + yf[e] + yb[e]);
            *(LAS u32x4*)(Vs + tk * 264 + c) = pack8(o);
        }
    }
    __syncthreads();
    {
        const bf16_t* Wg = (const bf16_t*)(P.ws_() + WS_WGLU) + (size_t)l * 256 * 256;
        const float* gb = P.in_(I_5GB) + l * 256;
        f32x4 acc[2][NPASS];
#pragma unroll
        for (int a = 0; a < 2; ++a)
#pragma unroll
            for (int m = 0; m < NPASS; ++m) acc[a][m] = (f32x4){0.f, 0.f, 0.f, 0.f};
#pragma unroll
        for (int kk = 0; kk < 8; ++kk) {
            bf16x8 vf[NPASS];
#pragma unroll
            for (int m = 0; m < NPASS; ++m) vf[m] = *(const LAS bf16x8*)(Vs + (m * 16 + fr) * 264 + kk * 32 + fq * 8);
#pragma unroll
            for (int a = 0; a < 2; ++a)
#pragma unroll
                for (int m = 0; m < NPASS; ++m) acc[a][m] = __builtin_amdgcn_mfma_f32_16x16x32_bf16(wf[kk][a], vf[m], acc[a][m], 0, 0, 0);
        }
#pragma unroll
        for (int a = 0; a < 2; ++a)
#pragma unroll
            for (int m = 0; m < NPASS; ++m) {
                const int n = (2 * w + a) * 16 + 4 * fq, tkk = m * 16 + fr;
                const u32x2 vv = *(const LAS u32x2*)(Vs + tkk * 264 + n);
                const float v4[4] = {bflo(vv.x), bfhi(vv.x), bflo(vv.y), bfhi(vv.y)};
                float o[4];
#pragma unroll
                for (int r = 0; r < 4; ++r) o[r] = v4[r] * sigmoidf_(acc[a][m][r] + gb[n + r]);
                u32x2 ow; ow.x = pk2(o[0], o[1]); ow.y = pk2(o[2], o[3]);
                *(u32x2*)((bf16_t*)(P.ws_() + WS_XN) + (size_t)(row0 + tkk) * DM + 768 + n) = ow;
            }
    }
    __syncthreads();
}

__device__ __forceinline__ void final_norm(const PV& P, int gw, int ngw, int lane) {
    const float* g = P.in_(I_FNG);
    constexpr int NR = 4;
    f32x4 nx[NR][4];
#pragma unroll
    for (int q = 0; q < NR; ++q)
#pragma unroll
        for (int j = 0; j < 4; ++j) nx[q][j] = *(const f32x4*)(P.out_() + (size_t)(gw + q * ngw) * DM + 4 * lane + 256 * j);
    for (int row0 = gw; row0 < MLAT; row0 += NR * ngw) {
        f32x4 v[NR][4]; float ss[NR];
#pragma unroll
        for (int q = 0; q < NR; ++q)
#pragma unroll
            for (int j = 0; j < 4; ++j) v[q][j] = nx[q][j];
        if (row0 + NR * ngw < MLAT) {
#pragma unroll
            for (int q = 0; q < NR; ++q)
#pragma unroll
                for (int j = 0; j < 4; ++j) nx[q][j] = *(const f32x4*)(P.out_() + (size_t)(row0 + NR * ngw + q * ngw) * DM + 4 * lane + 256 * j);
        }
#pragma unroll
        for (int q = 0; q < NR; ++q) { float s_ = 0.f;
#pragma unroll
            for (int j = 0; j < 4; ++j) s_ += v[q][j].x * v[q][j].x + v[q][j].y * v[q][j].y + v[q][j].z * v[q][j].z + v[q][j].w * v[q][j].w;
            ss[q] = s_; }
#pragma unroll
        for (int q = 0; q < NR; ++q) {
            const float rstd = rsqrtf(wave_sum(ss[q]) * (1.f / DM) + 1e-6f);
#pragma unroll
            for (int j = 0; j < 4; ++j) { const f32x4 gg = *(const f32x4*)(g + 4 * lane + 256 * j); *(f32x4*)(P.out_() + (size_t)(row0 + q * ngw) * DM + 4 * lane + 256 * j) = v[q][j] * rstd * gg; }
        }
    }
}

__device__ __forceinline__ void sw_items(const PV& P, LAS unsigned char* lds, int lb, int nlb, int it_lo, int it_hi) {
    LAS float* sc = (LAS float*)lds;
    LAS float* red = (LAS float*)(lds + 17 * 1024 * 4);
    const int tid = P.tid;
    for (int it = it_lo + lb; it < it_hi; it += nlb) {
        const bool win = it >= 176;
        const int l = win ? 1 : it / 88, j0 = (win ? it - 176 : it % 88) * 64, col = tid & 63, ks = tid >> 6;
        const int WN = win ? D_IN : 2 * DFF, soff = win ? 0 : 3 * DM;
        const bool cvalid = j0 + col < WN;
        __syncthreads();
        for (int i = tid; i < 17 * 1024; i += 512) sc[i] = ((const float*)(P.ws_() + WS_MOD))[((size_t)l * 17 + (i >> 10)) * 6144 + soff + (i & 1023)];
        __syncthreads();
        const float* w = (win ? P.in_(I_WIN) + (size_t)DM * D_IN : P.in_(I_FUP) + (size_t)l * DM * 2 * DFF) + (cvalid ? j0 + col : 0);
        float a[17];
#pragma unroll
        for (int r = 0; r < 17; ++r) a[r] = 0.f;
#pragma unroll 1
        for (int k0 = ks * 128; k0 < ks * 128 + 128; k0 += 16) {
            float wv[16];
#pragma unroll
            for (int u = 0; u < 16; ++u) wv[u] = w[(size_t)(k0 + u) * WN];
#pragma unroll
            for (int u = 0; u < 16; ++u)
#pragma unroll
                for (int r = 0; r < 17; ++r) a[r] += sc[r * 1024 + k0 + u] * wv[u];
        }
#pragma unroll
        for (int r = 0; r < 17; ++r) red[(ks * 17 + r) * 64 + col] = a[r];
        __syncthreads();
        for (int i = tid; i < 17 * 64; i += 512) {
            const int r = i >> 6, c = i & 63; float sm = 0.f;
#pragma unroll
            for (int k = 0; k < 8; ++k) sm += red[(k * 17 + r) * 64 + c];
            if (win) ((float*)(P.ws_() + WS_SWIN))[(size_t)r * NIN + j0 + c] = (j0 + c < D_IN) ? sm : 0.f;
            else ((float*)(P.ws_() + WS_SWUP))[((size_t)l * 17 + r) * 2 * DFF + j0 + c] = sm;
        }
    }
    __syncthreads();
}
__device__ __forceinline__ void deferred_work(const PV& P, LAS unsigned char* lds, int which, int first_idle) {
    const int tid = P.tid, lane = tid & 63, wave = tid >> 6, blk = blockIdx.x, nblk = gridDim.x;
    if (blk < first_idle) return;
    const int lb = blk - first_idle, nlb = nblk - first_idle, lgw = lb * 8 + wave, nlgw = nlb * 8;
    constexpr int I_LAYER = 16 * 88 + 16 * 32 + 16 * 176 + 44 * 32 + 4 * 8;
    __syncthreads();
    if (which == 0) {
        p0_filter(P, lds, lb, nlb, 0, 72);
        __syncthreads();
        p0_s5(P, lgw, nlgw, lane, 0, 32);
        p0_weights(P, lds, lgw, nlgw, wave, lane, 1408, 1920);
        p0_weights(P, lds, lgw, nlgw, wave, lane, I_LAYER - 32, I_LAYER);
    } else if (which == 1) {
        p0_weights(P, lds, lgw, nlgw, wave, lane, 1920, I_LAYER - 32);
        __syncthreads();
        sw_items(P, lds, lb, nlb, 0, 88);
        if (lb >= 88) p0_mod(P, lds, lb - 88, nlb - 88, 192, 384);
    } else {
        p0_filter(P, lds, lb, nlb, 72, 136);
        __syncthreads();
        sw_items(P, lds, lb, nlb, 88, 220);
        p0_s5(P, lgw, nlgw, lane, 32, 64);
        p0_weights(P, lds, lgw, nlgw, wave, lane, I_LAYER, 2 * I_LAYER);
    }
    __syncthreads();
}
constexpr int NSP = 9;
constexpr int NPHASE = 1 + 2 * NSP + 1;

__device__ __forceinline__ void run_phase(const PV& P, int ph, LAS unsigned char* lds) {
    const int tid = P.tid, lane = tid & 63, wave = tid >> 6;
    const int blk = blockIdx.x, nblk = gridDim.x, gw = blk * 8 + wave, ngw = nblk * 8;
#ifndef PHMASK
#define PHMASK 0xffff
#endif
    if (ph == 0) {
        if (PHMASK & 1) p0_mod(P, lds, blk, nblk, 0, 192);
        return;
    }
    if (ph == NPHASE - 1) { if (PHMASK & 16) final_norm(P, gw, ngw, lane); return; }
    const int l = (ph - 1) / NSP, sp = (ph - 1) % NSP;
    const bool last = (l == 1);
    const int Mall = MTOT, Mres = last ? MLAT : MTOT;
    pg8::StaticOrder S;
    switch (sp) {
    case 0: if (PHMASK & 16) norm_phase(P, l, 1, Mall, gw, ngw, lane);
            if (l == 0) { __syncthreads(); p0_weights(P, lds, gw, ngw, wave, lane, 0, 1408); }
            break;
    case 1: if (PHMASK & 32) { pg8::Gemm g{(const bf16_t*)(P.ws_() + WS_XN), (const bf16_t*)(P.ws_() + WS_WIN) + (size_t)l * NIN * DM, Mall, NIN, DM};
              EpiU E{(bf16_t*)(P.ws_() + WS_U), (bf16_t*)(P.ws_() + WS_UH)};
              if (l == 0) { S.init(Mall, NIN, nblk, blk); pg8::gemm_phase(lds, g, S, E, P.tid); deferred_work(P, lds, 0, (Mall / 256 * (NIN / 256)) % nblk); }
              else { pg8::LastWinOrder S1; S1.init(nblk, blk); EpiUN E1{(bf16_t*)(P.ws_() + WS_U), (bf16_t*)(P.ws_() + WS_UH), (const float*)(P.ws_() + WS_SSQ2), (const float*)(P.ws_() + WS_SWIN)};
                     pg8::gemm_phase(lds, g, S1, E1, P.tid); } } break;
    case 2: {
#ifndef REP_SUB
#define REP_SUB 0
#endif
        for (int rep = 0; rep < ((REP_SUB == 1 && l == 0) ? 2 : 1); ++rep)
        xbc_prepass(P, l, blk, nblk);
        if (PHMASK & 64) for (int it = blk; it < 256; it += nblk) {
            hyena_seg<SEQ>(P, lds, l, it, 0, SEQ);
            if (!last) hyena_seg<CTX>(P, lds, l, it, MLAT, CTX);
        }
        for (int rep = 0; rep < ((REP_SUB == 3 && l == 0) ? 2 : 1); ++rep)
        if (PHMASK & 256) for (int it = blk; it < 256; it += nblk) s5_block(P, lds, l, it);
        __syncthreads();
    } break;
    case 3:
        if (PHMASK & 128) for (int it = blk; it < 256; it += nblk) { const int kind = it >> 7, r = it & 127; scan_item(P, lds, l, kind, r >> 3, (r >> 1) & 3, r & 1); }
        break;
    case 4: for (int i = blk * 512 + tid; i < MTOT; i += nblk * 512) { ((float*)(P.ws_() + WS_SSQ))[i] = 0.f; if (l == 0) ((float*)(P.ws_() + WS_SSQ2))[i] = 0.f; }
            if (PHMASK & 512) { if (last) { for (int it = blk; it < MLAT / 64; it += nblk) finalize_item<64>(P, lds, l, it * 64); }
                                else { for (int it = blk; it < MTOT / 48; it += nblk) finalize_item<48>(P, lds, l, it * 48); } } break;
    case 5: if (PHMASK & 1024) { pg8::Gemm g{(const bf16_t*)(P.ws_() + WS_XN), (const bf16_t*)(P.ws_() + WS_WOUT) + (size_t)l * DM * DM, Mres, DM, DM};
              S.init(Mres, DM, nblk, blk);
              EpiResN E{l == 0 ? P.in_(I_X) : P.out_(), l == 0 ? P.in_(I_CTX) : (const float*)(P.ws_() + WS_HC), P.out_(), (float*)(P.ws_() + WS_HC), (const float*)(P.ws_() + WS_MOD) + (size_t)l * 17 * 6144 + 2 * DM,
                        P.in_(I_N2G) + l * DM, (const float*)(P.ws_() + WS_MOD) + (size_t)l * 17 * 6144 + 4 * DM, (bf16_t*)(P.ws_() + WS_Y), (float*)(P.ws_() + WS_SSQ)};
              pg8::gemm_phase(lds, g, S, E, P.tid); if (l == 0) deferred_work(P, lds, 1, (Mres / 256 * 4) % nblk); } break;
    case 6: break;
    case 7: if (PHMASK & 2048) { pg8::Gemm g{(const bf16_t*)(P.ws_() + WS_Y), (const bf16_t*)(P.ws_() + WS_WUP) + (size_t)l * 2 * DFF * DM, Mres, 2 * DFF, DM};
              S.init(Mres, 2 * DFF, nblk, blk); EpiSwigluN E{(bf16_t*)(P.ws_() + WS_U), (const float*)(P.ws_() + WS_SSQ), (const float*)(P.ws_() + WS_SWUP) + (size_t)l * 17 * 2 * DFF}; pg8::gemm_phase(lds, g, S, E, P.tid); } break;
    case 8: if (PHMASK & 4096) { pg8::Gemm g{(const bf16_t*)(P.ws_() + WS_U), (const bf16_t*)(P.ws_() + WS_WDN) + (size_t)l * DM * DFF, Mres, DM, DFF};
              S.init(Mres, DM, nblk, blk);
              if (l == 0) {
                  EpiResN E{P.out_(), (const float*)(P.ws_() + WS_HC), P.out_(), (float*)(P.ws_() + WS_HC), (const float*)(P.ws_() + WS_MOD) + (size_t)l * 17 * 6144 + 5 * DM,
                            P.in_(I_N1G) + DM, (const float*)(P.ws_() + WS_MOD) + (size_t)17 * 6144 + 1 * DM, (bf16_t*)(P.ws_() + WS_XN), (float*)(P.ws_() + WS_SSQ2)};
                  pg8::gemm_phase(lds, g, S, E, P.tid); deferred_work(P, lds, 2, (Mres / 256 * 4) % nblk); break; }
              EpiRes E{P.out_(), (const float*)(P.ws_() + WS_HC), P.out_(), (float*)(P.ws_() + WS_HC), (const float*)(P.ws_() + WS_MOD) + (size_t)l * 17 * 6144 + 5 * DM};
              pg8::gemm_phase(lds, g, S, E, P.tid); if (l == 0) deferred_work(P, lds, 2, (Mres / 256 * 4) % nblk); } break;
    }
}


#define XB_TMO      128
#define XB_XCNT(j)  (256  + 64 * (j))
#define XB_XSUB(j)  (1280 + 64 * (j))
#define XB_XGEN(j)  (2304 + 64 * (j))
#define XB_TOP      3328
#define XB_TOPGEN   3392
#define XCD_BAR_WORDS 3456
#define XB_SPIN_CAP (1u << 18)

__device__ __forceinline__ unsigned xb_ld(unsigned* p)              { return __hip_atomic_load(p, __ATOMIC_RELAXED, __HIP_MEMORY_SCOPE_AGENT); }
__device__ __forceinline__ unsigned xb_add(unsigned* p, unsigned v) { return __hip_atomic_fetch_add(p, v, __ATOMIC_RELAXED, __HIP_MEMORY_SCOPE_AGENT); }
__device__ __forceinline__ unsigned xb_xcc_id() { return (unsigned)__builtin_amdgcn_s_getreg((3 << 11) | 20) & 0xFu; }
#define XB_SPIN(cond, bar) do { unsigned _sp = 0; while (cond) { __builtin_amdgcn_s_sleep(1); \
    if ((++_sp & 255u) == 0u) { if (xb_ld(&(bar)[XB_TMO])) break; if (_sp > XB_SPIN_CAP) { atomicAdd(&(bar)[XB_TMO], 1u); break; } } } } while (0)

struct XcdBarrier {
    unsigned* bar; unsigned x;
    volatile LAS unsigned* st;
};

__device__ __forceinline__ XcdBarrier xcd_barrier_post(unsigned* bar, volatile LAS unsigned* st) {
    XcdBarrier b; b.bar = bar; b.x = xb_xcc_id(); b.st = st;
    if (threadIdx.x == 0) (void)xb_add(&bar[XB_XCNT(b.x)], 1u);
    return b;
}
__device__ __forceinline__ void xcd_barrier_complete(unsigned* bar, unsigned x, unsigned& nloc, unsigned& nx) {
    const unsigned G = gridDim.x * gridDim.y * gridDim.z;
    unsigned sum, cnt, mine, sp = 0u;
    for (;;) {
        sum = 0u; cnt = 0u; mine = 0u;
#pragma unroll
        for (unsigned j = 0; j < 16; ++j) { const unsigned c = xb_ld(&bar[XB_XCNT(j)]); sum += c; cnt += (c > 0u) ? 1u : 0u; mine = (j == x) ? c : mine; }
        if (sum == G) break;
        __builtin_amdgcn_s_sleep(1);
        if ((++sp & 255u) == 0u) { if (xb_ld(&bar[XB_TMO])) break; if (sp > XB_SPIN_CAP) { atomicAdd(&bar[XB_TMO], 1u); break; } }
    }
    nloc = mine > 0u ? mine : 1u; nx = cnt > 0u ? cnt : 1u;
}

__device__ __forceinline__ void xcd_barrier(const XcdBarrier& b) {
    asm volatile("s_waitcnt vmcnt(0)" ::: "memory");
    __syncthreads();
    if (threadIdx.x == 0) {
        unsigned* bar = b.bar;
        __builtin_amdgcn_s_waitcnt(0);
        unsigned nloc = b.st[0], nx = b.st[1];
        if (nloc == 0u) { xcd_barrier_complete(bar, b.x, nloc, nx); b.st[0] = nloc; b.st[1] = nx; }
        const unsigned old = xb_add(&bar[XB_XSUB(b.x)], 1u);
        const unsigned gen = old / nloc;
        if (old + 1u == (gen + 1u) * nloc) {
            __builtin_amdgcn_fence(__ATOMIC_RELEASE, "agent");
            asm volatile("s_waitcnt vmcnt(0)" ::: "memory");
            const unsigned og = xb_add(&bar[XB_TOP], 1u);
            const unsigned tg = og / nx;
            if (og + 1u == (tg + 1u) * nx) xb_add(&bar[XB_TOPGEN], 1u);
            else XB_SPIN(xb_ld(&bar[XB_TOPGEN]) == tg, bar);
            __builtin_amdgcn_fence(__ATOMIC_ACQUIRE, "agent");
            xb_add(&bar[XB_XGEN(b.x)], 1u);
            asm volatile("s_waitcnt vmcnt(0)" ::: "memory");
        } else {
            XB_SPIN(xb_ld(&bar[XB_XGEN(b.x)]) == gen, bar);
            __builtin_amdgcn_fence(__ATOMIC_ACQUIRE, "agent");
            asm volatile("s_waitcnt vmcnt(0)" ::: "memory");
        }
    }
    __syncthreads();
}


__device__ __forceinline__ void grid_barrier(unsigned* bar, unsigned k, int tid) {
    asm volatile("s_waitcnt vmcnt(0) lgkmcnt(0)" ::: "memory");
    __builtin_amdgcn_s_barrier();
    if (tid == 0) {
        __builtin_amdgcn_fence(__ATOMIC_RELEASE, "agent");
        asm volatile("s_waitcnt vmcnt(0)" ::: "memory");
        const unsigned old = __hip_atomic_fetch_add(bar, 1u, __ATOMIC_RELAXED, __HIP_MEMORY_SCOPE_AGENT);
        if (old == k * gridDim.x - 1u) __hip_atomic_store(bar + 32, k, __ATOMIC_RELAXED, __HIP_MEMORY_SCOPE_AGENT);
        else {
            unsigned long long t0 = __builtin_amdgcn_s_memrealtime();
            while (__hip_atomic_load(bar + 32, __ATOMIC_RELAXED, __HIP_MEMORY_SCOPE_AGENT) < k) {
                __builtin_amdgcn_s_sleep(2);
                if (__builtin_amdgcn_s_memrealtime() - t0 > 200000000ull) break;
            }
        }
        __builtin_amdgcn_fence(__ATOMIC_ACQUIRE, "agent");
        asm volatile("s_waitcnt vmcnt(0)" ::: "memory");
    }
    asm volatile("" ::: "memory");
    __builtin_amdgcn_s_barrier();
    asm volatile("" ::: "memory");
}
#ifdef DEBUG_CHK
__device__ __forceinline__ void chk_range(const PV& P, int ph, size_t off, size_t bytes, int is_f32, const void* base) {
    const unsigned* p = (const unsigned*)((const unsigned char*)base + off);
    const size_t n = bytes / 4; bool bad = false;
    for (size_t i = (size_t)blockIdx.x * 512 + P.tid; i < n; i += (size_t)gridDim.x * 512) {
        const unsigned v = p[i];
        if (is_f32) { const unsigned e = (v >> 23) & 0xff; if (e >= 127 + 20) bad = true; }
        else { const unsigned e0 = (v >> 7) & 0xff, e1 = (v >> 23) & 0xff; if (e0 >= 127 + 20 || e1 >= 127 + 20) bad = true; }
    }
    if (bad) atomicOr((unsigned*)(P.ws_() + WS_SUM), 1u << ph);
}
__device__ __forceinline__ void chk_phase(const PV& P, int ph) {
    if (ph == 0) {
        chk_range(P, ph, WS_MOD, WS_S5BB - WS_MOD, 1, P.ws_()); chk_range(P, ph, WS_S5BB, WS_GLAT - WS_S5BB, 0, P.ws_());
        chk_range(P, ph, WS_GLAT, WS_WIN - WS_GLAT, 1, P.ws_()); chk_range(P, ph, WS_WIN, WS_HC - WS_WIN, 0, P.ws_()); return; }
    if (ph == NPHASE - 1) { chk_range(P, ph, 0, (size_t)MLAT * DM * 4, 1, P.out_()); return; }
    const int l = (ph - 1) / 8, sp = (ph - 1) % 8; const size_t Mres = l ? MLAT : MTOT;
    switch (sp) {
    case 0: chk_range(P, ph, WS_XN, (size_t)MTOT * DM * 2, 0, P.ws_()); break;
    case 1: chk_range(P, ph, WS_U, (size_t)MTOT * UW * 2 + (size_t)768 * MTOT * 2, 0, P.ws_()); break;
    case 2: chk_range(P, ph, WS_Y, (size_t)6 * MTOT * 256 * 2, 0, P.ws_()); chk_range(P, ph, WS_ZH, l ? (size_t)0 : (size_t)256 * MTOT * 2, 0, P.ws_()); break;
    case 3: case 5: chk_range(P, ph, WS_XN, Mres * DM * 2, 0, P.ws_()); break;
    case 4: case 7: chk_range(P, ph, 0, (size_t)MLAT * DM * 4, 1, P.out_()); if (!l) chk_range(P, ph, WS_HC, (size_t)MCTX * DM * 4, 1, P.ws_()); break;
    case 6: chk_range(P, ph, WS_U, Mres * DFF * 2, 0, P.ws_()); break;
    }
}
#endif
__global__ void __launch_bounds__(512, 2) fwd_mega(Params KP, int ph_lo, int ph_hi) {
    extern __shared__ __attribute__((aligned(16))) unsigned char smem[];
    LAS unsigned char* lds = (LAS unsigned char*)smem;
    if (ph_lo < 0) cg::this_grid().sync();
    unsigned nbar = 0;
    volatile LAS unsigned* xst = (volatile LAS unsigned*)(lds + LDS_BYTES - 16);
    if (threadIdx.x == 0) { xst[0] = 0u; xst[1] = 0u; }
    __syncthreads();
    const XcdBarrier xb = xcd_barrier_post((unsigned*)(KP.ws + WS_XBAR), xst);
    for (int ph = ph_lo; ph < ph_hi; ++ph) {
        if (ph >= 1 && ph < NPHASE - 1 && ((ph - 1) % NSP == 6 || ph == 1 + NSP)) continue;
        int z; asm volatile("s_mov_b32 %0, 0" : "=s"(z));
        int tidv = threadIdx.x; asm volatile("" : "+v"(tidv));
        const PV P{KP, z, tidv};
        run_phase(P, ph, lds);
#ifdef EXTRA_BAR
        if (ph == 9) for (int q = 0; q < EXTRA_BAR; ++q) { ++nbar; grid_barrier((unsigned*)(P.ws_() + WS_SUM), nbar, tidv); }
#endif
#ifdef REP_PHASE
        if (ph == REP_PHASE) { ++nbar; grid_barrier((unsigned*)(P.ws_() + WS_SUM), nbar, tidv); run_phase(P, ph, lds); }
#endif
        if (ph + 1 < ph_hi) { ++nbar; xcd_barrier(xb); }
    }
}


#ifdef DBG2
__global__ void dbg_zero(Params KP) { if (blockIdx.x == 0 && threadIdx.x < 8) ((unsigned*)(KP.ws + WS_SUM))[32 + threadIdx.x] = 0u; }
__global__ void dbg_count(Params KP, size_t off, size_t bytes, int slot, int is_out = 0) {
    const unsigned* p = is_out ? (const unsigned*)KP.out : (const unsigned*)(KP.ws + off); const size_t n = bytes / 4; unsigned bad = 0;
    for (size_t i = (size_t)blockIdx.x * blockDim.x + threadIdx.x; i < n; i += (size_t)gridDim.x * blockDim.x) { const unsigned e = (p[i] >> 23) & 0xff, e2 = (p[i] >> 7) & 0xff; if (e >= 147 || (!is_out && slot < 3 && e2 >= 147)) ++bad; }
    if (bad) atomicAdd((unsigned*)(KP.ws + WS_SUM) + 32 + slot, bad);
}
__global__ void dbg_out(Params KP) {
    const unsigned* c = (const unsigned*)(KP.ws + WS_SUM) + 32;
    float code = 1000.f * (float)(1 + (c[0] ? 1 : 0) + (c[1] ? 2 : 0) + (c[2] ? 4 : 0) + (c[3] ? 8 : 0));
    for (size_t i = (size_t)blockIdx.x * blockDim.x + threadIdx.x; i < (size_t)MLAT * DM; i += (size_t)gridDim.x * blockDim.x) KP.out[i] = (i == 0) ? code : 0.f;
}
#endif
extern "C" void kernel_launch(void* const* d_in, const int* in_sizes, int n_in, void* d_out, int out_size, void* d_ws, size_t ws_size, hipStream_t stream) {
    static int grid = 0;
    if (grid == 0) {
        if (n_in != 39 || out_size != MLAT * DM || ws_size < WS_END) { fprintf(stderr, "kernel_launch: unexpected shapes (n_in %d out %d ws %zu need %zu)\n", n_in, out_size, ws_size, (size_t)WS_END); grid = -1; return; }
        int dev = 0, cus = 0, per_cu = 0;
        hipGetDevice(&dev); hipDeviceGetAttribute(&cus, hipDeviceAttributeMultiprocessorCount, dev);
        hipFuncSetAttribute((const void*)fwd_mega, hipFuncAttributeMaxDynamicSharedMemorySize, LDS_BYTES);
        hipOccupancyMaxActiveBlocksPerMultiprocessor(&per_cu, (const void*)fwd_mega, 512, LDS_BYTES);
        if (per_cu < 1) { fprintf(stderr, "kernel_launch: occupancy query says %d blocks per CU\n", per_cu); per_cu = 1; }
        grid = cus;
        (void)hipGetLastError();
    }
    if (grid < 0) return;
    hipMemsetAsync((unsigned char*)d_ws + WS_SUM, 0, 256, stream);
    hipMemsetAsync((unsigned char*)d_ws + WS_XBAR, 0, 16384, stream);
    Params p{};
    for (int i = 0; i < 39; ++i) p.in[i] = (const float*)d_in[i];
    p.out = (float*)d_out; p.ws = (unsigned char*)d_ws;
#ifdef DBG2
    hipLaunchKernelGGL(dbg_zero, dim3(1), dim3(64), 0, stream, p);
    for (int ph = 0; ph < NPHASE; ++ph) {
        hipLaunchKernelGGL(fwd_mega, dim3(grid), dim3(512), LDS_BYTES, stream, p, ph, ph + 1);
        if (ph == 3) {
            hipLaunchKernelGGL(dbg_count, dim3(256), dim3(256), 0, stream, p, (size_t)WS_Y, (size_t)4 * MTOT * 256 * 2, 0, 0);
            hipLaunchKernelGGL(dbg_count, dim3(256), dim3(256), 0, stream, p, (size_t)WS_Y + (size_t)4 * MTOT * 256 * 2, (size_t)2 * MTOT * 256 * 2, 1, 0);
            hipLaunchKernelGGL(dbg_count, dim3(256), dim3(256), 0, stream, p, (size_t)WS_ZH, (size_t)256 * MTOT * 2, 2, 0);
        }
    }
    hipLaunchKernelGGL(dbg_count, dim3(256), dim3(256), 0, stream, p, (size_t)0, (size_t)MLAT * DM * 4, 3, 1);
    hipLaunchKernelGGL(dbg_out, dim3(256), dim3(256), 0, stream, p);
#elif ONE_LAUNCH
    int lo = 0, hi = NPHASE;
    void* args[] = {&p, &lo, &hi};
    hipError_t e = hipLaunchCooperativeKernel((const void*)fwd_mega, dim3(grid), dim3(512), args, LDS_BYTES, stream);
    if (e != hipSuccess) fprintf(stderr, "cooperative launch failed: %s (grid %d)\n", hipGetErrorString(e), grid);
#else
    for (int ph = 0; ph < NPHASE; ++ph) hipLaunchKernelGGL(fwd_mega, dim3(grid), dim3(512), LDS_BYTES, stream, p, ph, ph + 1);
#endif
}
```

```cpp
#include <hip/hip_runtime.h>
#include <hip/hip_cooperative_groups.h>
#include <cstdio>
#include <cstdint>
namespace cg = cooperative_groups;

#ifndef ONE_LAUNCH
#define ONE_LAUNCH 1
#endif

#define LAS __attribute__((address_space(3)))
typedef unsigned short bf16_t;
typedef short bf16x8 __attribute__((ext_vector_type(8)));
typedef float f32x4 __attribute__((ext_vector_type(4)));
typedef float f32x2 __attribute__((ext_vector_type(2)));
typedef unsigned u32x4 __attribute__((ext_vector_type(4)));
typedef unsigned u32x2 __attribute__((ext_vector_type(2)));

constexpr int DM = 1024, NB = 16, SEQ = 2048, CTX = 256;
constexpr int MLAT = NB * SEQ, MCTX = NB * CTX, MTOT = MLAT + MCTX;
constexpr int D_IN = 2696, NIN = 2816, DFF = 2816, UW = 1928;
constexpr int UC_Z = 0, UC_X = 256, UC_B = 512, UC_C = 576, UC_DT = 640, UC_Q = 648, UC_K = 904, UC_V = 1160, UC_G = 1416, UC_S5 = 1672;

constexpr size_t AL(size_t x) { return (x + 255) & ~(size_t)255; }
constexpr size_t WS_SUM = 0;
constexpr size_t WS_MOD = 8192;
constexpr size_t WS_S5AB = AL(WS_MOD + (size_t)2 * 17 * 6144 * 4);
constexpr size_t WS_S5BB = AL(WS_S5AB + (size_t)2 * 2 * 16 * 64 * 8);
constexpr size_t WS_S5CM = AL(WS_S5BB + (size_t)2 * 2 * 16 * 128 * 16 * 2);
constexpr size_t WS_GLAT = AL(WS_S5CM + (size_t)2 * 2 * 16 * 16 * 128 * 2);
constexpr size_t WS_GCTX = AL(WS_GLAT + (size_t)2 * 2 * 256 * 4096 * 4);
constexpr size_t WS_WIN = AL(WS_GCTX + (size_t)2 * 256 * 512 * 4);
constexpr size_t WS_WOUT = AL(WS_WIN + (size_t)2 * NIN * DM * 2);
constexpr size_t WS_WUP = AL(WS_WOUT + (size_t)2 * DM * DM * 2);
constexpr size_t WS_WDN = AL(WS_WUP + (size_t)2 * 2 * DFF * DM * 2);
constexpr size_t WS_WGLU = AL(WS_WDN + (size_t)2 * DM * DFF * 2);
constexpr size_t WS_HC = AL(WS_WGLU + (size_t)2 * 256 * 256 * 2);
constexpr size_t WS_XN = AL(WS_HC + (size_t)MCTX * DM * 4);
constexpr size_t WS_U = AL(WS_XN + (size_t)MTOT * DM * 2);
constexpr size_t WS_UH = WS_U + (size_t)MTOT * UW * 2;
constexpr size_t WS_Y = AL(WS_U + (size_t)MTOT * DFF * 2);
constexpr size_t WS_ZH = AL(WS_Y + (size_t)6 * MTOT * 256 * 2);
constexpr size_t WS_XBC = AL(WS_ZH + (size_t)256 * MTOT * 2);
constexpr size_t WS_SSQ = AL(WS_XBC + (size_t)MTOT * 384 * 2);
constexpr size_t WS_SWUP = AL(WS_SSQ + (size_t)MTOT * 4);
constexpr size_t WS_SSQ2 = AL(WS_SWUP + (size_t)2 * 17 * 2 * DFF * 4);
constexpr size_t WS_SWIN = AL(WS_SSQ2 + (size_t)MTOT * 4);
constexpr size_t WS_XBAR = AL(WS_SWIN + (size_t)17 * NIN * 4);
constexpr size_t WS_END = AL(WS_XBAR + 16384);
static_assert(WS_UH + (size_t)768 * MTOT * 2 <= WS_Y, "U/UH overlay");

constexpr int LDS_BYTES = 144 * 1024;

struct Params { const float* in[39]; float* out; unsigned char* ws; };
struct PV { const Params& K; int z; int tid;
    __device__ __forceinline__ const float* in_(int i) const { return K.in[i + z]; }
    __device__ __forceinline__ float* out_() const { return K.out + z; }
    __device__ __forceinline__ unsigned char* ws_() const { return K.ws + z; } };
enum { I_X = 0, I_C, I_CTX, I_CCTX, I_MODW, I_MODB, I_N1G, I_N2G, I_WIN, I_WOUT, I_SCW, I_SCB, I_SALOG, I_SDTB, I_SD, I_SNG,
       I_HCW, I_HCB, I_HW1, I_HB1, I_HFREQ, I_HW2, I_HB2, I_HW3, I_HBIAS, I_RDEC, I_5ARE, I_5AIM, I_5LDT, I_5BRE, I_5BIM,
       I_5CRE, I_5CIM, I_5D, I_5GW, I_5GB, I_FUP, I_FDN, I_FNG };

typedef __bf16 bf16x2_t __attribute__((ext_vector_type(2)));
__device__ __forceinline__ unsigned pk2(float lo, float hi) { const f32x2 v = {lo, hi}; const bf16x2_t b = __builtin_convertvector(v, bf16x2_t); return __builtin_bit_cast(unsigned, b); }
__device__ __forceinline__ bf16_t f2bf(float f) { return (bf16_t)(pk2(f, 0.f) & 0xffffu); }
__device__ __forceinline__ float bf2f(bf16_t b) { return __uint_as_float(((unsigned)b) << 16); }
__device__ __forceinline__ float bflo(unsigned w) { return __uint_as_float(w << 16); }
__device__ __forceinline__ float bfhi(unsigned w) { return __uint_as_float(w & 0xffff0000u); }
__device__ __forceinline__ void unpack8(u32x4 w, float* v) {
    v[0] = bflo(w.x); v[1] = bfhi(w.x); v[2] = bflo(w.y); v[3] = bfhi(w.y); v[4] = bflo(w.z); v[5] = bfhi(w.z); v[6] = bflo(w.w); v[7] = bfhi(w.w);
}
__device__ __forceinline__ u32x4 pack8(const float* v) { u32x4 w; w.x = pk2(v[0], v[1]); w.y = pk2(v[2], v[3]); w.z = pk2(v[4], v[5]); w.w = pk2(v[6], v[7]); return w; }
__device__ __forceinline__ float sigmoidf_(float x) { return __builtin_amdgcn_rcpf(1.f + __expf(-x)); }
__device__ __forceinline__ float siluf_(float x) { return x * __builtin_amdgcn_rcpf(1.f + __expf(-x)); }
__device__ __forceinline__ float softplusf_(float x) { return x > 20.f ? x : log1pf(__expf(x)); }
__device__ __forceinline__ float gelu_tanh(float x) { const float u = 0.7978845608f * (x + 0.044715f * x * x * x); return x * __builtin_amdgcn_rcpf(1.f + __expf(-2.f * u)); }
__device__ __forceinline__ float wave_sum(float v) {
#pragma unroll
    for (int o = 1; o < 64; o <<= 1) v += __shfl_xor(v, o);
    return v;
}
#define WAVE_SYNC() do { asm volatile("s_waitcnt lgkmcnt(0)" ::: "memory"); __builtin_amdgcn_wave_barrier(); } while (0)

namespace pg8 {
constexpr int BM = 256, BK = 64, HALF = 128, HTB = HALF * BK * 2, STAGE_BYTES = 8 * HTB, NXCD = 8, WGM = 8;
__host__ __device__ __forceinline__ int lds_byte(int r, int c) { const int st = (r >> 4) * 2 + (c >> 5), rr = r & 15, cc = c & 31, ob = rr * 64 + cc * 2; return st * 1024 + (ob ^ (((ob >> 9) & 1) << 5)); }
__host__ __device__ __forceinline__ void stage_rc(int b, int& R, int& C) { const int st = b / 1024, sb = b % 1024, swz = sb ^ (((sb >> 9) & 1) << 5); R = (st >> 1) * 16 + swz / 64; C = (st & 1) * 32 + (swz % 64) / 2; }
struct Unit { int pm, pn; };
struct Gemm { const bf16_t* A; const bf16_t* Bt; int M, N, K; };
struct StaticOrder {
    int nM, nN, nwg, G, c;
    __host__ __device__ void init(int M, int N, int G_, int c_) { nM = M / BM; nN = N / BM; nwg = nM * nN; G = G_; c = c_; }
    __host__ __device__ bool next(int i, Unit& u) const {
        const long L = (long)i * G + c; if (L >= nwg) return false;
        int wgid = (int)L; { const int q = nwg / NXCD, r = nwg % NXCD, xcd = wgid % NXCD, off = wgid / NXCD; wgid = (xcd < r ? xcd * (q + 1) : r * (q + 1) + (xcd - r) * q) + off; }
        const int nig = WGM * nN, gid = wgid / nig, fm = gid * WGM, gsz = (nM - fm) < WGM ? (nM - fm) : WGM;
        u.pm = fm + ((wgid % nig) % gsz); u.pn = (wgid % nig) / gsz; return true;
    }
};
struct LastWinOrder {
    StaticOrder lat; int G, c;
    __host__ __device__ void init(int G_, int c_) { lat.init(MLAT, NIN, G_, c_); G = G_; c = c_; }
    __host__ __device__ bool next(int i, Unit& u) const {
        const int L = i * G + c;
        if (L < lat.nwg) return lat.next(i, u);
        const int idx = L - lat.nwg; if (idx >= 16 * 8) return false;
        const int k = idx & 7; u.pm = MLAT / 256 + (idx >> 3); u.pn = k == 0 ? 1 : (k == 1 ? 2 : k + 3);
        return true;
    }
};
template <class Epi, class Sched>
__device__ __forceinline__ void gemm_phase(LAS unsigned char* lds, const Gemm g, const Sched& S, const Epi& E, const int tid) {
    const int wid = __builtin_amdgcn_readfirstlane(tid >> 6), lane = tid & 63, wr = wid >> 2, wc = wid & 3, fr = lane & 15, fq = lane >> 4;
    const int K = g.K, nt = K / BK;
    unsigned voffA[2];
#pragma unroll
    for (int i = 0; i < 2; ++i) { int R, C; stage_rc(tid * 16 + i * 8192, R, C); voffA[i] = (unsigned)(R * K + C) * 2u; }
    const size_t kstep = (size_t)(BK * 2);
    const size_t hstep = (size_t)HALF * K * 2;
    const size_t tstep = 2 * hstep;
    const unsigned ldsw = (unsigned)wid * 1024u;
    const int aoff = lds_byte(wr * 64 + fr, fq * 8), boff = lds_byte(wc * 32 + fr, fq * 8);
#define PG8_SA(b, h) (((b) * 2 + (h)) * HTB)
#define PG8_SB(b, h) ((4 + (b) * 2 + (h)) * HTB)
#define PG8_STAGE(bufoff, gbase, voff) do { _Pragma("unroll") for (int _i = 0; _i < 2; ++_i) \
        __builtin_amdgcn_global_load_lds((const unsigned*)((const char*)(gbase) + (voff)[_i]), (LAS unsigned*)(lds + (bufoff) + ldsw + _i * 8192), 16, 0, 0); } while (0)
#define PG8_LDA(dst, b, h) do { _Pragma("unroll") for (int m = 0; m < 4; ++m) _Pragma("unroll") for (int k = 0; k < 2; ++k) dst[m][k] = *(const LAS bf16x8*)(lds + PG8_SA(b, h) + aoff + m * 2048 + k * 1024); } while (0)
#define PG8_LDB(dst, b, h) do { _Pragma("unroll") for (int n = 0; n < 2; ++n) _Pragma("unroll") for (int k = 0; k < 2; ++k) dst[n][k] = *(const LAS bf16x8*)(lds + PG8_SB(b, h) + boff + n * 2048 + k * 1024); } while (0)
#define PG8_MMA(ai, bj, At, Bt) do { __builtin_amdgcn_s_setprio(1); _Pragma("unroll") for (int m = 0; m < 4; ++m) _Pragma("unroll") for (int n = 0; n < 2; ++n) _Pragma("unroll") for (int k = 0; k < 2; ++k) \
        acc[ai][bj][m][n] = __builtin_amdgcn_mfma_f32_16x16x32_bf16(Bt[n][k], At[m][k], acc[ai][bj][m][n], 0, 0, 0); __builtin_amdgcn_s_setprio(0); } while (0)
#define PG8_WAIT_V(n) asm volatile("s_waitcnt vmcnt(" #n ")" ::: "memory")
#define PG8_WAIT_L(n) asm volatile("s_waitcnt lgkmcnt(" #n ")" ::: "memory")
#define PG8_BAR __builtin_amdgcn_s_barrier()
#define PG8_SCHED __builtin_amdgcn_sched_barrier(0)
    Unit cur, nxt; int ui = 0;
    if (!S.next(0, cur)) return;
    f32x4 acc[2][2][4][2];
#pragma unroll
    for (int a = 0; a < 2; ++a)
#pragma unroll
        for (int b = 0; b < 2; ++b)
#pragma unroll
            for (int m = 0; m < 4; ++m)
#pragma unroll
                for (int n = 0; n < 2; ++n) acc[a][b][m][n] = (f32x4){0.f, 0.f, 0.f, 0.f};
    bf16x8 At[4][2], B0[2][2], B1[2][2];
    const char* cA = (const char*)g.A + (size_t)cur.pm * tstep; const char* cB = (const char*)g.Bt + (size_t)cur.pn * tstep;
    PG8_STAGE(PG8_SB(0, 0), cB, voffA); PG8_STAGE(PG8_SA(0, 0), cA, voffA); PG8_STAGE(PG8_SB(0, 1), cB + hstep, voffA); PG8_STAGE(PG8_SA(0, 1), cA + hstep, voffA);
    if (wr == 1) PG8_BAR;
    PG8_WAIT_V(4); PG8_BAR;
    PG8_STAGE(PG8_SB(1, 0), cB + kstep, voffA); PG8_STAGE(PG8_SA(1, 0), cA + kstep, voffA); PG8_STAGE(PG8_SB(1, 1), cB + hstep + kstep, voffA);
    PG8_WAIT_V(6); PG8_BAR;
    for (;;) {
        const bool has_next = S.next(ui + 1, nxt);
        const char* nA = has_next ? (const char*)g.A + (size_t)nxt.pm * tstep : cA; const char* nB = has_next ? (const char*)g.Bt + (size_t)nxt.pn * tstep : cB;
        for (int t = 0; t < nt; t += 2) {
            const bool last = (t == nt - 2);
            const char* a1 = cA + (size_t)(t + 1) * kstep;
            const char* a2 = last ? nA : cA + (size_t)(t + 2) * kstep; const char* b2 = last ? nB : cB + (size_t)(t + 2) * kstep;
            const char* a3 = a2 + kstep; const char* b3 = b2 + kstep;
            PG8_LDB(B0, 0, 0); PG8_SCHED; PG8_LDA(At, 0, 0); PG8_STAGE(PG8_SA(1, 1), a1 + hstep, voffA);
            PG8_WAIT_L(8); PG8_BAR; PG8_WAIT_L(0); PG8_MMA(0, 0, At, B0); PG8_BAR; PG8_SCHED;
            PG8_LDB(B1, 0, 1); PG8_STAGE(PG8_SB(0, 0), b2, voffA);
            PG8_BAR; PG8_WAIT_L(0); PG8_MMA(0, 1, At, B1); PG8_BAR;
            PG8_LDA(At, 0, 1); PG8_STAGE(PG8_SA(0, 0), a2, voffA);
            PG8_BAR; PG8_WAIT_L(0); PG8_MMA(1, 0, At, B0); PG8_BAR; PG8_SCHED;
            PG8_STAGE(PG8_SB(0, 1), b2 + hstep, voffA);
            PG8_WAIT_V(6); PG8_BAR; PG8_MMA(1, 1, At, B1); PG8_BAR;
            PG8_LDB(B0, 1, 0); PG8_SCHED; PG8_LDA(At, 1, 0); PG8_STAGE(PG8_SA(0, 1), a2 + hstep, voffA);
            PG8_WAIT_L(8); PG8_BAR; PG8_WAIT_L(0); PG8_MMA(0, 0, At, B0); PG8_BAR; PG8_SCHED;
            PG8_LDB(B1, 1, 1); PG8_STAGE(PG8_SB(1, 0), b3, voffA);
            PG8_BAR; PG8_WAIT_L(0); PG8_MMA(0, 1, At, B1); PG8_BAR;
            PG8_LDA(At, 1, 1); PG8_STAGE(PG8_SA(1, 0), a3, voffA);
            PG8_BAR; PG8_WAIT_L(0); PG8_MMA(1, 0, At, B0); PG8_BAR; PG8_SCHED;
            PG8_STAGE(PG8_SB(1, 1), b3 + hstep, voffA);
            PG8_WAIT_V(6); PG8_BAR; PG8_MMA(1, 1, At, B1); PG8_BAR;
        }
        E(acc, cur, wr, wc, fr, fq);
        if (!has_next) break;
#pragma unroll
        for (int a = 0; a < 2; ++a)
#pragma unroll
            for (int b = 0; b < 2; ++b)
#pragma unroll
                for (int m = 0; m < 4; ++m)
#pragma unroll
                    for (int n = 0; n < 2; ++n) acc[a][b][m][n] = (f32x4){0.f, 0.f, 0.f, 0.f};
        cur = nxt; cA = nA; cB = nB; ++ui;
    }
    PG8_WAIT_V(0);
    if (wr == 0) PG8_BAR;
    PG8_BAR;
#undef PG8_SA
#undef PG8_SB
#undef PG8_STAGE
#undef PG8_LDA
#undef PG8_LDB
#undef PG8_MMA
#undef PG8_WAIT_V
#undef PG8_WAIT_L
#undef PG8_BAR
#undef PG8_SCHED
}
}
using pg8::Unit;

struct EpiU {
    bf16_t* U; bf16_t* UH;
    __device__ __forceinline__ void operator()(const f32x4 (&acc)[2][2][4][2], const Unit& u, int wr, int wc, int fr, int fq) const {
#pragma unroll
        for (int ai = 0; ai < 2; ++ai)
#pragma unroll
            for (int m = 0; m < 4; ++m) {
                const int row = u.pm * 256 + ai * 128 + wr * 64 + m * 16 + fr;
#pragma unroll
                for (int bj = 0; bj < 2; ++bj)
#pragma unroll
                    for (int n = 0; n < 2; ++n) {
                        const int c = u.pn * 256 + bj * 128 + wc * 32 + n * 16 + 4 * fq;
                        const f32x4 v = acc[ai][bj][m][n];
                        if (c >= D_IN) continue;
                        if (c < 648 || c >= 1416) {
                            const int uc = c < 648 ? c : c - 768;
                            u32x2 w; w.x = pk2(v[0], v[1]); w.y = pk2(v[2], v[3]);
                            *(u32x2*)(U + (size_t)row * UW + uc) = w;
                        } else {
                            const int hc = c - 648;
#pragma unroll
                            for (int j = 0; j < 4; ++j) UH[(size_t)(hc + j) * MTOT + row] = f2bf(v[j]);
                        }
                    }
            }
    }
};
struct EpiRes {
    const float* oldL; const float* oldC; float* newL; float* newC; const float* gate;
    __device__ __forceinline__ void operator()(const f32x4 (&acc)[2][2][4][2], const Unit& u, int wr, int wc, int fr, int fq) const {
        const bool lat = u.pm < MLAT / 256;
        const float* gp = gate + (size_t)(lat ? (u.pm >> 3) : 16) * 6144;
#pragma unroll
        for (int bj = 0; bj < 2; ++bj) {
            f32x4 gt[2];
#pragma unroll
            for (int n = 0; n < 2; ++n) gt[n] = *(const f32x4*)(gp + u.pn * 256 + bj * 128 + wc * 32 + n * 16 + 4 * fq);
#pragma unroll
            for (int ai = 0; ai < 2; ++ai) {
                f32x4 o[4][2];
#pragma unroll
                for (int m = 0; m < 4; ++m) {
                    const int row = u.pm * 256 + ai * 128 + wr * 64 + m * 16 + fr;
                    const float* op = lat ? oldL + (size_t)row * DM : oldC + (size_t)(row - MLAT) * DM;
#pragma unroll
                    for (int n = 0; n < 2; ++n) o[m][n] = *(const f32x4*)(op + u.pn * 256 + bj * 128 + wc * 32 + n * 16 + 4 * fq);
                }
#pragma unroll
                for (int m = 0; m < 4; ++m) {
                    const int row = u.pm * 256 + ai * 128 + wr * 64 + m * 16 + fr;
                    float* np = lat ? newL + (size_t)row * DM : newC + (size_t)(row - MLAT) * DM;
#pragma unroll
                    for (int n = 0; n < 2; ++n) *(f32x4*)(np + u.pn * 256 + bj * 128 + wc * 32 + n * 16 + 4 * fq) = o[m][n] + gt[n] * acc[ai][bj][m][n];
                }
            }
        }
    }
};
struct EpiSwiglu {
    bf16_t* Act;
    __device__ __forceinline__ void operator()(const f32x4 (&acc)[2][2][4][2], const Unit& u, int wr, int wc, int fr, int fq) const {
#pragma unroll
        for (int ai = 0; ai < 2; ++ai)
#pragma unroll
            for (int m = 0; m < 4; ++m) {
                const int row = u.pm * 256 + ai * 128 + wr * 64 + m * 16 + fr;
#pragma unroll
                for (int bj = 0; bj < 2; ++bj) {
                    const int G = u.pn * 128 + bj * 64 + wc * 16 + 4 * fq;
                    const f32x4 g = acc[ai][bj][m][0], up = acc[ai][bj][m][1];
                    u32x2 w; w.x = pk2(siluf_(g[0]) * up[0], siluf_(g[1]) * up[1]); w.y = pk2(siluf_(g[2]) * up[2], siluf_(g[3]) * up[3]);
                    *(u32x2*)(Act + (size_t)row * DFF + G) = w;
                }
            }
    }
};


struct EpiResN {
    const float* oldL; const float* oldC; float* newL; float* newC; const float* gate; const float* g2; const float* scale2; bf16_t* A2; float* ssq;
    __device__ __forceinline__ void operator()(const f32x4 (&acc)[2][2][4][2], const Unit& u, int wr, int wc, int fr, int fq) const {
        const bool lat = u.pm < MLAT / 256;
        const int r = lat ? (u.pm >> 3) : 16;
        const float* gp = gate + (size_t)r * 6144; const float* sp = scale2 + (size_t)r * 6144;
#pragma unroll
        for (int bj = 0; bj < 2; ++bj) {
            f32x4 gt[2], gs[2];
#pragma unroll
            for (int n = 0; n < 2; ++n) { const int c = u.pn * 256 + bj * 128 + wc * 32 + n * 16 + 4 * fq;
                gt[n] = *(const f32x4*)(gp + c); gs[n] = *(const f32x4*)(g2 + c) * (*(const f32x4*)(sp + c) + 1.f); }
#pragma unroll
            for (int ai = 0; ai < 2; ++ai) {
                f32x4 o[4][2];
#pragma unroll
                for (int m = 0; m < 4; ++m) {
                    const int row = u.pm * 256 + ai * 128 + wr * 64 + m * 16 + fr;
                    const float* op = lat ? oldL + (size_t)row * DM : oldC + (size_t)(row - MLAT) * DM;
#pragma unroll
                    for (int n = 0; n < 2; ++n) o[m][n] = *(const f32x4*)(op + u.pn * 256 + bj * 128 + wc * 32 + n * 16 + 4 * fq);
                }
#pragma unroll
                for (int m = 0; m < 4; ++m) {
                    const int row = u.pm * 256 + ai * 128 + wr * 64 + m * 16 + fr;
                    float* np = lat ? newL + (size_t)row * DM : newC + (size_t)(row - MLAT) * DM;
                    float ss = 0.f;
#pragma unroll
                    for (int n = 0; n < 2; ++n) {
                        const int c = u.pn * 256 + bj * 128 + wc * 32 + n * 16 + 4 * fq;
                        const f32x4 hn = o[m][n] + gt[n] * acc[ai][bj][m][n];
                        *(f32x4*)(np + c) = hn;
                        ss += hn.x * hn.x + hn.y * hn.y + hn.z * hn.z + hn.w * hn.w;
                        const f32x4 a2 = hn * gs[n];
                        u32x2 w; w.x = pk2(a2.x, a2.y); w.y = pk2(a2.z, a2.w);
                        *(u32x2*)(A2 + (size_t)row * DM + c) = w;
                    }
                    ss += __shfl_xor(ss, 16); ss += __shfl_xor(ss, 32);
                    if (fq == 0) atomicAdd(ssq + row, ss);
                }
            }
        }
    }
};
struct EpiSwigluN {
    bf16_t* Act; const float* ssq; const float* sw;
    __device__ __forceinline__ void operator()(const f32x4 (&acc)[2][2][4][2], const Unit& u, int wr, int wc, int fr, int fq) const {
        const int r = u.pm < MLAT / 256 ? (u.pm >> 3) : 16;
        f32x4 swg[2], swu[2];
#pragma unroll
        for (int bj = 0; bj < 2; ++bj) { const int G = u.pn * 128 + bj * 64 + wc * 16 + 4 * fq; swg[bj] = *(const f32x4*)(sw + (size_t)r * 2 * DFF + G); swu[bj] = *(const f32x4*)(sw + (size_t)r * 2 * DFF + DFF + G); }
        float rs[2][4];
#pragma unroll
        for (int ai = 0; ai < 2; ++ai)
#pragma unroll
            for (int m = 0; m < 4; ++m) rs[ai][m] = ssq[u.pm * 256 + ai * 128 + wr * 64 + m * 16 + fr];
#pragma unroll
        for (int ai = 0; ai < 2; ++ai)
#pragma unroll
            for (int m = 0; m < 4; ++m) {
                const int row = u.pm * 256 + ai * 128 + wr * 64 + m * 16 + fr;
                const float rstd = rsqrtf(rs[ai][m] * (1.f / DM) + 1e-6f);
#pragma unroll
                for (int bj = 0; bj < 2; ++bj) {
                    const int G = u.pn * 128 + bj * 64 + wc * 16 + 4 * fq;
                    const f32x4 g = acc[ai][bj][m][0] * rstd + swg[bj], up = acc[ai][bj][m][1] * rstd + swu[bj];
                    u32x2 w; w.x = pk2(siluf_(g[0]) * up[0], siluf_(g[1]) * up[1]); w.y = pk2(siluf_(g[2]) * up[2], siluf_(g[3]) * up[3]);
                    *(u32x2*)(Act + (size_t)row * DFF + G) = w;
                }
            }
    }
};

struct EpiUN {
    bf16_t* U; bf16_t* UH; const float* ssq; const float* sw;
    __device__ __forceinline__ void operator()(const f32x4 (&acc)[2][2][4][2], const Unit& u, int wr, int wc, int fr, int fq) const {
        const int r = u.pm < MLAT / 256 ? (u.pm >> 3) : 16;
        f32x4 swv[2][2]; float rs[2][4];
#pragma unroll
        for (int bj = 0; bj < 2; ++bj)
#pragma unroll
            for (int n = 0; n < 2; ++n) swv[bj][n] = *(const f32x4*)(sw + (size_t)r * NIN + u.pn * 256 + bj * 128 + wc * 32 + n * 16 + 4 * fq);
#pragma unroll
        for (int ai = 0; ai < 2; ++ai)
#pragma unroll
            for (int m = 0; m < 4; ++m) rs[ai][m] = ssq[u.pm * 256 + ai * 128 + wr * 64 + m * 16 + fr];
#pragma unroll
        for (int ai = 0; ai < 2; ++ai)
#pragma unroll
            for (int m = 0; m < 4; ++m) {
                const int row = u.pm * 256 + ai * 128 + wr * 64 + m * 16 + fr;
                const float rstd = rsqrtf(rs[ai][m] * (1.f / DM) + 1e-6f);
#pragma unroll
                for (int bj = 0; bj < 2; ++bj)
#pragma unroll
                    for (int n = 0; n < 2; ++n) {
                        const int c = u.pn * 256 + bj * 128 + wc * 32 + n * 16 + 4 * fq;
                        const f32x4 v = acc[ai][bj][m][n] * rstd + swv[bj][n];
                        if (c >= D_IN) continue;
                        if (c < 648 || c >= 1416) {
                            const int uc = c < 648 ? c : c - 768;
                            u32x2 w; w.x = pk2(v[0], v[1]); w.y = pk2(v[2], v[3]);
                            *(u32x2*)(U + (size_t)row * UW + uc) = w;
                        } else {
                            const int hc = c - 648;
#pragma unroll
                            for (int j = 0; j < 4; ++j) UH[(size_t)(hc + j) * MTOT + row] = f2bf(v[j]);
                        }
                    }
            }
    }
};
template <class F>
__device__ __forceinline__ void transpose_item(const float* W, int K, int N, bf16_t* WT, LAS float* scr, int item, int nblk, int lane, F srccol) {
    const int kb = item / nblk, nb = item % nblk, k0 = 64 * kb, n0 = 32 * nb;
    const int sc = srccol(n0 + (lane & 31));
    float tv[32];
#pragma unroll
    for (int i = 0; i < 32; ++i) { const int kk = 2 * i + (lane >> 5); tv[i] = W[(size_t)(k0 + kk) * N + (sc >= 0 ? sc : 0)]; }
#pragma unroll
    for (int i = 0; i < 32; ++i) { const int kk = 2 * i + (lane >> 5); scr[kk * 33 + (lane & 31)] = sc >= 0 ? tv[i] : 0.f; }
    WAVE_SYNC();
    const int c = lane & 7;
#pragma unroll
    for (int j = 0; j < 4; ++j) { const int n = (lane >> 3) + 8 * j; const LAS float* s = scr + (8 * c) * 33 + n;
        u32x4 o; o.x = pk2(s[0 * 33], s[1 * 33]); o.y = pk2(s[2 * 33], s[3 * 33]); o.z = pk2(s[4 * 33], s[5 * 33]); o.w = pk2(s[6 * 33], s[7 * 33]);
        *(u32x4*)(WT + (size_t)(n0 + n) * K + k0 + 8 * c) = o; }
    WAVE_SYNC();
}

__device__ __forceinline__ void p0_weights(const PV& P, LAS unsigned char* lds, int gw, int ngw, int wave, int lane, int it_lo, int it_hi) {
    LAS float* scr = (LAS float*)(lds + wave * 8704);
    constexpr int I_IN = 16 * 88, I_OUT = 16 * 32, I_UP = 16 * 176, I_DN = 44 * 32, I_GLU = 4 * 8, I_LAYER = I_IN + I_OUT + I_UP + I_DN + I_GLU;
    for (int it = it_lo + gw; it < it_hi; it += ngw) {
        const int l = it / I_LAYER; int r = it % I_LAYER;
        if (r < I_IN) { transpose_item(P.in_(I_WIN) + (size_t)l * DM * D_IN, DM, D_IN, (bf16_t*)(P.ws_() + WS_WIN) + (size_t)l * NIN * DM, scr, r, 88, lane, [](int n) { return n < D_IN ? n : -1; }); continue; } r -= I_IN;
        if (r < I_OUT) { transpose_item(P.in_(I_WOUT) + (size_t)l * DM * DM, DM, DM, (bf16_t*)(P.ws_() + WS_WOUT) + (size_t)l * DM * DM, scr, r, 32, lane, [](int n) { return n; }); continue; } r -= I_OUT;
        if (r < I_UP) { transpose_item(P.in_(I_FUP) + (size_t)l * DM * 2 * DFF, DM, 2 * DFF, (bf16_t*)(P.ws_() + WS_WUP) + (size_t)l * 2 * DFF * DM, scr, r, 176, lane,
                                       [](int n) { const int q = n >> 5, rem = n & 31, G = q * 16 + (rem & 15); return rem < 16 ? G : DFF + G; }); continue; } r -= I_UP;
        if (r < I_DN) { transpose_item(P.in_(I_FDN) + (size_t)l * DFF * DM, DFF, DM, (bf16_t*)(P.ws_() + WS_WDN) + (size_t)l * DM * DFF, scr, r, 32, lane, [](int n) { return n; }); continue; } r -= I_DN;
        transpose_item(P.in_(I_5GW) + (size_t)l * 256 * 256, 256, 256, (bf16_t*)(P.ws_() + WS_WGLU) + (size_t)l * 256 * 256, scr, r, 8, lane, [](int n) { return n; });
    }
}

__device__ __forceinline__ void p0_mod(const PV& P, LAS unsigned char* lds, int blk, int nblk, int it_lo, int it_hi) {
    LAS float* sc = (LAS float*)lds;
    LAS float* red = (LAS float*)(lds + 17 * 1024 * 4);
    const int tid = P.tid;
    bool loaded = false;
    for (int it = it_lo + blk; it < it_hi; it += nblk) {
        __syncthreads();
        if (!loaded) {
            for (int i = tid; i < 17 * 1024; i += 512) { const float v = i < 16 * 1024 ? P.in_(I_C)[i] : P.in_(I_CCTX)[i - 16 * 1024]; sc[i] = siluf_(v); }
            loaded = true;
        }
        __syncthreads();
        const int l = it / 192, j0 = (it % 192) * 32, col = tid & 31, ks = tid >> 5;
        const float* w = P.in_(I_MODW) + (size_t)l * DM * 6144 + j0 + col;
        float a[17];
#pragma unroll
        for (int r = 0; r < 17; ++r) a[r] = 0.f;
#pragma unroll 1
        for (int k0 = ks * 64; k0 < ks * 64 + 64; k0 += 16) {
            float wv[16];
#pragma unroll
            for (int u = 0; u < 16; ++u) wv[u] = w[(size_t)(k0 + u) * 6144];
#pragma unroll
            for (int u = 0; u < 16; ++u)
#pragma unroll
                for (int r = 0; r < 17; ++r) a[r] += sc[r * 1024 + k0 + u] * wv[u];
        }
#pragma unroll
        for (int r = 0; r < 17; ++r) red[(ks * 17 + r) * 32 + col] = a[r];
        __syncthreads();
        for (int i = tid; i < 17 * 32; i += 512) {
            const int r = i >> 5, c = i & 31; float s = 0.f;
#pragma unroll
            for (int k = 0; k < 16; ++k) s += red[(k * 17 + r) * 32 + c];
            ((float*)(P.ws_() + WS_MOD))[((size_t)l * 17 + r) * 6144 + j0 + c] = s + P.in_(I_MODB)[(size_t)l * 6144 + j0 + c];
        }
    }
    __syncthreads();
}

__device__ __forceinline__ void p0_filter(const PV& P, LAS unsigned char* lds, int blk, int nblk, int it_lo, int it_hi) {
    LAS float* feats = (LAS float*)lds;
    LAS float* h1 = feats + 32 * 33;
    LAS float* h2 = h1 + 32 * 65;
    const int tid = P.tid, pl = tid & 31, part = tid >> 5;
    for (int it2 = 2 * it_lo + blk; it2 < 2 * it_hi; it2 += nblk) {
        const int it = it2 >> 1, half = it2 & 1;
        int l, kind, pb;
        if (it < 64) { l = 0; kind = 0; pb = it; } else if (it < 72) { l = 0; kind = 1; pb = it - 64; } else { l = 1; kind = 0; pb = it - 72; }
        const int L = kind ? CTX : SEQ, pos = pb * 32 + pl;
        const float tt = (float)pos / (float)(L - 1);
        const float w = (6.283185307179586f * (float)pos) / (float)L;
        __syncthreads();
        {
            const float band = 1e-4f + (float)part * ((15.0f - 1e-4f) / 15.0f);
            float sn, cs; sincosf(band * w, &sn, &cs);
            feats[pl * 33 + 1 + part] = cs; feats[pl * 33 + 17 + part] = -sn;
            if (part == 0) feats[pl * 33] = tt;
        }
        __syncthreads();
        const float* w1 = P.in_(I_HW1) + (size_t)l * 33 * 64; const float* b1 = P.in_(I_HB1) + l * 64; const float* fq = P.in_(I_HFREQ) + l * 64;
        const float* w2 = P.in_(I_HW2) + (size_t)l * 64 * 64; const float* b2 = P.in_(I_HB2) + l * 64; const float* w3 = P.in_(I_HW3) + (size_t)l * 64 * 1024;
        {
            float a[4];
#pragma unroll
            for (int o = 0; o < 4; ++o) a[o] = b1[part * 4 + o];
#pragma unroll 1
            for (int f0 = 0; f0 < 33; f0 += 11) {
                f32x4 wv[11];
#pragma unroll
                for (int u = 0; u < 11; ++u) wv[u] = *(const f32x4*)(w1 + (f0 + u) * 64 + part * 4);
#pragma unroll
                for (int u = 0; u < 11; ++u) { const float fv = feats[pl * 33 + f0 + u]; a[0] += fv * wv[u].x; a[1] += fv * wv[u].y; a[2] += fv * wv[u].z; a[3] += fv * wv[u].w; }
            }
#pragma unroll
            for (int o = 0; o < 4; ++o) h1[pl * 65 + part * 4 + o] = sinf(fq[part * 4 + o] * a[o]);
        }
        __syncthreads();
        {
            float a[4];
#pragma unroll
            for (int o = 0; o < 4; ++o) a[o] = b2[part * 4 + o];
#pragma unroll 1
            for (int k0 = 0; k0 < 64; k0 += 16) {
                f32x4 wv[16];
#pragma unroll
                for (int u = 0; u < 16; ++u) wv[u] = *(const f32x4*)(w2 + (k0 + u) * 64 + part * 4);
#pragma unroll
                for (int u = 0; u < 16; ++u) { const float hv = h1[pl * 65 + k0 + u]; a[0] += hv * wv[u].x; a[1] += hv * wv[u].y; a[2] += hv * wv[u].z; a[3] += hv * wv[u].w; }
            }
#pragma unroll
            for (int o = 0; o < 4; ++o) h2[pl * 65 + part * 4 + o] = sinf(fq[part * 4 + o] * a[o]);
        }
        __syncthreads();
        const int dir = part >> 3, order = (part >> 2) & 1;
        float* G = kind ? (float*)(P.ws_() + WS_GCTX) : (float*)(P.ws_() + WS_GLAT) + (size_t)l * 2 * 256 * 4096;
        const int GL = 2 * L;
        const float min_decay = -3.0701134573253945f, max_decay = -15.350567286626972f;
#pragma unroll 1
        for (int ps = 2 * half; ps < 2 * half + 2; ++ps) {
            float a[16];
#pragma unroll
            for (int o = 0; o < 16; ++o) a[o] = 0.f;
            const int c0 = part * 64 + ps * 16;
#pragma unroll 1
            for (int k0 = 0; k0 < 64; k0 += 4) {
                f32x4 wv[4][4];
#pragma unroll
                for (int u = 0; u < 4; ++u)
#pragma unroll
                    for (int q = 0; q < 4; ++q) wv[u][q] = ((const f32x4*)(w3 + (size_t)(k0 + u) * 1024 + c0))[q];
#pragma unroll
                for (int u = 0; u < 4; ++u) { const float hv = h2[pl * 65 + k0 + u];
#pragma unroll
                    for (int q = 0; q < 4; ++q) { a[4 * q] += hv * wv[u][q].x; a[4 * q + 1] += hv * wv[u][q].y; a[4 * q + 2] += hv * wv[u][q].z; a[4 * q + 3] += hv * wv[u][q].w; } }
            }
#pragma unroll
            for (int o = 0; o < 16; ++o) {
                const int col = c0 + o, ch = col & 255;
                const float delta = fabsf(min_decay + (float)col * ((max_decay - min_decay) / 1023.0f));
                float val = a[o] * expf(-tt * delta);
                int x = dir == 0 ? L - pos : L + pos;
                if (dir == 1 && pos == 0) { x = 0; val = 0.f; }
                G[(size_t)(order * 256 + ch) * GL + x] = val;
            }
        }
    }
    __syncthreads();
}

__device__ __forceinline__ void p0_s5(const PV& P, int gw, int ngw, int lane, int it_lo, int it_hi) {
    for (int it = it_lo + gw; it < it_hi; it += ngw) {
        const int l = it >> 5, dir = (it >> 4) & 1, g = it & 15, p = lane;
        const int idx = ((l * 2 + dir) * 16 + g);
        const float dt = expf(P.in_(I_5LDT)[idx]);
        const float are = P.in_(I_5ARE)[idx * 64 + p], aim = P.in_(I_5AIM)[idx * 64 + p];
        const float mag = expf(are * dt); float sn, cs; sincosf(aim * dt, &sn, &cs);
        const float abr = mag * cs, abi = mag * sn, den = are * are + aim * aim;
        const float zr = ((abr - 1.f) * are + abi * aim) / den, zi = (abi * are - (abr - 1.f) * aim) / den;
        ((f32x2*)(P.ws_() + WS_S5AB))[idx * 64 + p] = (f32x2){abr, abi};
        bf16_t* bb = (bf16_t*)(P.ws_() + WS_S5BB) + (size_t)idx * 128 * 16;
        const float* bre = P.in_(I_5BRE) + ((size_t)(l * 16 + g) * 64 + p) * 16; const float* bim = P.in_(I_5BIM) + ((size_t)(l * 16 + g) * 64 + p) * 16;
        for (int c = 0; c < 16; ++c) {
            const float br = bre[c], bi = bim[c];
            bb[p * 16 + c] = f2bf(zr * br - zi * bi);
            bb[(64 + p) * 16 + c] = f2bf(zr * bi + zi * br);
        }
        bf16_t* cm = (bf16_t*)(P.ws_() + WS_S5CM) + (size_t)idx * 16 * 128;
        for (int c = 0; c < 16; ++c) {
            cm[c * 128 + p] = f2bf(P.in_(I_5CRE)[((size_t)idx * 16 + c) * 64 + p]);
            cm[c * 128 + 64 + p] = f2bf(-P.in_(I_5CIM)[((size_t)idx * 16 + c) * 64 + p]);
        }
    }
}

__device__ __forceinline__ void norm_phase(const PV& P, int l, int which, int M, int gw, int ngw, int lane) {
    const float* gam = P.in_(which == 1 ? I_N1G : I_N2G) + l * DM;
    const float* mod = (const float*)(P.ws_() + WS_MOD) + (size_t)l * 17 * 6144;
    const int so = which == 1 ? 0 : 3 * DM, co = which == 1 ? DM : 4 * DM;
    const bool from_in = (l == 0 && which == 1);
    bf16_t* Xn = (bf16_t*)(P.ws_() + WS_XN);
    constexpr int NR = 3;
    auto row_src = [&](int row) __attribute__((always_inline)) {
        const bool lat = row < MLAT;
        return lat ? (from_in ? P.in_(I_X) : P.out_()) + (size_t)row * DM : (from_in ? P.in_(I_CTX) : (const float*)(P.ws_() + WS_HC)) + (size_t)(row - MLAT) * DM;
    };
    f32x4 nx[NR][4];
#pragma unroll
    for (int q = 0; q < NR; ++q) { const int rr = gw + q * ngw; const float* src = row_src(rr < M ? rr : gw);
#pragma unroll
        for (int j = 0; j < 4; ++j) nx[q][j] = *(const f32x4*)(src + 4 * lane + 256 * j); }
    for (int row0 = gw; row0 < M; row0 += NR * ngw) {
        f32x4 v[NR][4]; float ss[NR];
#pragma unroll
        for (int q = 0; q < NR; ++q)
#pragma unroll
            for (int j = 0; j < 4; ++j) v[q][j] = nx[q][j];
        const int nrow0 = row0 + NR * ngw;
        if (nrow0 < M) {
#pragma unroll
            for (int q = 0; q < NR; ++q) { const int rr = nrow0 + q * ngw; const float* src = row_src(rr < M ? rr : nrow0);
#pragma unroll
                for (int j = 0; j < 4; ++j) nx[q][j] = *(const f32x4*)(src + 4 * lane + 256 * j); }
        }
#pragma unroll
        for (int q = 0; q < NR; ++q) { float s_ = 0.f;
#pragma unroll
            for (int j = 0; j < 4; ++j) s_ += v[q][j].x * v[q][j].x + v[q][j].y * v[q][j].y + v[q][j].z * v[q][j].z + v[q][j].w * v[q][j].w;
            ss[q] = s_; }
#pragma unroll
        for (int q = 0; q < NR; ++q) {
            const int row = row0 + q * ngw;
            if (row < M) {
                const bool lat = row < MLAT;
                const float* mr = mod + (size_t)(lat ? (row >> 11) : 16) * 6144;
                const float rstd = rsqrtf(wave_sum(ss[q]) * (1.f / DM) + 1e-6f);
#pragma unroll
                for (int j = 0; j < 4; ++j) {
                    const int c = 4 * lane + 256 * j;
                    const f32x4 g = *(const f32x4*)(gam + c), sh = *(const f32x4*)(mr + so + c), sc = *(const f32x4*)(mr + co + c);
                    const f32x4 y = (v[q][j] * rstd * g) * (sc + 1.f) + sh;
                    u32x2 w; w.x = pk2(y.x, y.y); w.y = pk2(y.z, y.w);
                    *(u32x2*)(Xn + (size_t)row * DM + c) = w;
                }
            }
        }
    }
}

__device__ __forceinline__ void conv8(const bf16_t* Urow, bool hasPrev, bool hasNext, const float* w, int ws, const float* b, float* out) {
    float c0[8], cm[8], cp[8];
    unpack8(*(const u32x4*)Urow, c0);
    if (hasPrev) unpack8(*(const u32x4*)(Urow - UW), cm); else {
#pragma unroll
        for (int e = 0; e < 8; ++e) cm[e] = 0.f; }
    if (hasNext) unpack8(*(const u32x4*)(Urow + UW), cp); else {
#pragma unroll
        for (int e = 0; e < 8; ++e) cp[e] = 0.f; }
#pragma unroll
    for (int e = 0; e < 8; ++e) out[e] = b[e] + w[e] * cm[e] + w[ws + e] * c0[e] + w[2 * ws + e] * cp[e];
}


__device__ __forceinline__ void xbc_prepass(const PV& P, int l, int blk, int nblk) {
    const bf16_t* U = (const bf16_t*)(P.ws_() + WS_U); bf16_t* X = (bf16_t*)(P.ws_() + WS_XBC);
    const float* cw = P.in_(I_SCW) + (size_t)l * 3 * 384; const float* cb = P.in_(I_SCB) + (size_t)l * 384;
    const int c = (P.tid % 48) * 8, rsub = P.tid / 48;
    if (rsub >= 10) return;
    float w0[8], w1[8], w2[8], b8[8];
#pragma unroll
    for (int e = 0; e < 8; ++e) { w0[e] = cw[c + e]; w1[e] = cw[384 + c + e]; w2[e] = cw[768 + c + e]; b8[e] = cb[c + e]; }
    const int step = 2 * nblk * 10;
    auto row_of = [&](int rr, int fallback) __attribute__((always_inline)) { return rr < MTOT ? rr : fallback; };
    u32x4 nx[2][3];
    {
#pragma unroll
        for (int q = 0; q < 2; ++q) {
            const int row = row_of(blk * 10 + rsub + q * nblk * 10, blk * 10 + rsub);
            const bool lat = row < MLAT; const int t = lat ? (row & 2047) : ((row - MLAT) & 255); const bool hp = t > 0, hn = t < (lat ? SEQ : CTX) - 1;
            const bf16_t* Ur = U + (size_t)row * UW + UC_X + c;
            nx[q][1] = *(const u32x4*)Ur; nx[q][0] = *(const u32x4*)(Ur - (hp ? UW : 0)); nx[q][2] = *(const u32x4*)(Ur + (hn ? UW : 0));
        }
    }
    for (int row0 = blk * 10 + rsub; row0 < MTOT; row0 += step) {
        u32x4 r[2][3];
#pragma unroll
        for (int q = 0; q < 2; ++q)
#pragma unroll
            for (int k = 0; k < 3; ++k) r[q][k] = nx[q][k];
        if (row0 + step < MTOT) {
#pragma unroll
            for (int q = 0; q < 2; ++q) {
                const int row = row_of(row0 + step + q * nblk * 10, row0 + step);
                const bool lat = row < MLAT; const int t = lat ? (row & 2047) : ((row - MLAT) & 255); const bool hp = t > 0, hn = t < (lat ? SEQ : CTX) - 1;
                const bf16_t* Ur = U + (size_t)row * UW + UC_X + c;
                nx[q][1] = *(const u32x4*)Ur; nx[q][0] = *(const u32x4*)(Ur - (hp ? UW : 0)); nx[q][2] = *(const u32x4*)(Ur + (hn ? UW : 0));
            }
        }
#pragma unroll
        for (int q = 0; q < 2; ++q) {
            const int rr = row0 + q * nblk * 10; const bool ok = rr < MTOT; const int row = ok ? rr : row0;
            const bool lat = row < MLAT; const int t = lat ? (row & 2047) : ((row - MLAT) & 255); const bool hp = t > 0, hn = t < (lat ? SEQ : CTX) - 1;
            float xm[8], x0[8], xp[8], o[8];
            unpack8(r[q][0], xm); unpack8(r[q][1], x0); unpack8(r[q][2], xp);
#pragma unroll
            for (int e = 0; e < 8; ++e) o[e] = siluf_(b8[e] + w0[e] * (hp ? xm[e] : 0.f) + w1[e] * x0[e] + w2[e] * (hn ? xp[e] : 0.f));
            if (ok) *(u32x4*)(X + (size_t)row * 384 + c) = pack8(o);
        }
    }
}

constexpr int SC_QS = 0, SC_KS = 18432, SC_KT = 36864, SC_VT = 54272, SC_PM = 71680, SC_HT = 106496, SC_CS = 115712, SC_LA = 119808, SC_ROPE = 120320;
__device__ __forceinline__ void scan_item(const PV& P, LAS unsigned char* lds, int l, int kind, int b, int h, int dir) {
    const int tid = P.tid, lane = tid & 63, w = __builtin_amdgcn_readfirstlane(tid >> 6), fr = lane & 15, fq = lane >> 4;
    LAS bf16_t* Qs = (LAS bf16_t*)(lds + SC_QS); LAS bf16_t* Ks = (LAS bf16_t*)(lds + SC_KS); LAS bf16_t* Kt = (LAS bf16_t*)(lds + SC_KT);
    LAS bf16_t* Vt = (LAS bf16_t*)(lds + SC_VT); LAS bf16_t* Pm = (LAS bf16_t*)(lds + SC_PM); LAS bf16_t* Ht = (LAS bf16_t*)(lds + SC_HT);
    LAS float* cs_all = (LAS float*)(lds + SC_CS); LAS float* la = (LAS float*)(lds + SC_LA); LAS float* rope = (LAS float*)(lds + SC_ROPE);
    const bf16_t* U = (const bf16_t*)(P.ws_() + WS_U); const bf16_t* XBC = (const bf16_t*)(P.ws_() + WS_XBC);
    bf16_t* Y = (bf16_t*)(P.ws_() + WS_Y) + (size_t)((kind ? 2 : 0) + dir) * MTOT * 256;
    __syncthreads();
    for (int i = tid; i < 64 * 36; i += 512) ((LAS unsigned*)Ht)[i] = 0u;
    float a_dir = 0.f, dtb = 0.f;
    if (kind == 0) { a_dir = -expf(P.in_(I_SALOG)[(l * 2 + dir) * 4 + h]); dtb = P.in_(I_SDTB)[(l * 2 + dir) * 4 + h]; }
    else {
        a_dir = -expf(P.in_(I_RDEC)[(l * 2 + dir) * 4 + h]);
        for (int i = tid; i < 64 * 16; i += 512) { const int pos = i >> 4, fi = i & 15; const float inv = powf(10000.0f, -(float)fi / 16.0f); float sn, c; sincosf((float)pos * inv, &sn, &c); rope[i] = c; rope[1024 + i] = sn; }
    }
    const float* cw = P.in_(I_SCW) + (size_t)l * 3 * 384; const float* cb = P.in_(I_SCB) + (size_t)l * 384;
    f32x4 hacc[2] = {(f32x4){0.f, 0.f, 0.f, 0.f}, (f32x4){0.f, 0.f, 0.f, 0.f}};
    __syncthreads();
#define SC_DECL(IT) u32x4 rw##IT##a = {0u, 0u, 0u, 0u}, rw##IT##b = {0u, 0u, 0u, 0u}, rw##IT##c = {0u, 0u, 0u, 0u};
    SC_DECL(0) SC_DECL(1) SC_DECL(2) SC_DECL(3) SC_DECL(4) SC_DECL(5)
    bf16_t dtr0 = 0, dtr1 = 0;
#define SC_ISSUE(IT) { \
        const int k2 = (IT) & 1, mat = (IT) >> 1; \
        const int vi = tid + 512 * k2, i = vi >> 3, c8 = (vi & 7) * 8; \
        const int t = dir == 0 ? g_c0 + i : g_c0 + 127 - i; \
        const bf16_t* Ur = U + (size_t)(g_tokbase + t) * UW; \
        if (kind == 0) { \
            const int xcol = (mat == 0 ? h * 64 : (mat == 1 ? 256 : 320)) + c8; \
            rw##IT##a = *(const u32x4*)(XBC + (size_t)(g_tokbase + t) * 384 + xcol); \
            if (mat == 1) { if (k2 == 0) dtr0 = Ur[UC_DT + dir * 4 + h]; else dtr1 = Ur[UC_DT + dir * 4 + h]; } \
        } else { \
            const int ucol = (mat == 0 ? UC_V : (mat == 1 ? UC_K : UC_Q)) + h * 64; \
            rw##IT##a = *(const u32x4*)(Ur + ucol + c8); \
            if (mat != 0) rw##IT##b = *(const u32x4*)(Ur + ucol + (((c8 & 31) < 16) ? c8 + 16 : c8 - 16)); \
        } }
#define SC_ISSUE_ALL(CK) { \
        const int ck_ = (CK); const bool g_isctx = ck_ < 2; \
        const int g_Ls = g_isctx ? CTX : SEQ, g_nck = g_isctx ? 2 : 16, g_cidx = g_isctx ? ck_ : ck_ - 2; \
        const int g_c0 = (dir == 0 ? g_cidx : g_nck - 1 - g_cidx) * 128, g_tokbase = g_isctx ? MLAT + b * CTX : b * SEQ; \
        SC_ISSUE(0) SC_ISSUE(1) SC_ISSUE(2) SC_ISSUE(3) SC_ISSUE(4) SC_ISSUE(5) }
#define SC_PROC(IT) { \
        const int k2 = (IT) & 1, mat = (IT) >> 1; \
        const int vi = tid + 512 * k2, i = vi >> 3, c8 = (vi & 7) * 8; \
        const int t = dir == 0 ? c0 + i : c0 + 127 - i; \
        float x[8]; \
        if (kind == 0) { \
            unpack8(rw##IT##a, x); \
            if (mat == 1) { \
                const float dt = softplusf_(bf2f(k2 == 0 ? dtr0 : dtr1) + dtb); \
                _Pragma("unroll") for (int e = 0; e < 8; ++e) x[e] *= dt; \
                if (c8 == 0) la[i] = dt * a_dir; \
            } \
        } else { \
            unpack8(rw##IT##a, x); \
            if (mat != 0 && !isctx) { \
                const int half = c8 >> 5, e32 = c8 & 31; const bool first = e32 < 16; const int fi0 = e32 & 15; \
                float xp[8]; \
                unpack8(rw##IT##b, xp); \
                const int pos = half == 0 ? (t >> 6) : (t & 63); \
                _Pragma("unroll") for (int e = 0; e < 8; ++e) { \
                    const float c = rope[pos * 16 + fi0 + e], sn = rope[1024 + pos * 16 + fi0 + e]; \
                    x[e] = first ? x[e] * c - xp[e] * sn : xp[e] * sn + x[e] * c; } \
            } \
            if (mat == 1) { \
                _Pragma("unroll") for (int e = 0; e < 8; ++e) x[e] *= 0.125f; \
                if (c8 == 0) la[i] = a_dir; \
            } \
        } \
        if (mat == 0) { _Pragma("unroll") for (int e = 0; e < 8; ++e) Vt[(c8 + e) * 136 + (i ^ (c8 & 56))] = f2bf(x[e]); } \
        else if (mat == 1) *(LAS u32x4*)(Ks + i * 72 + c8) = pack8(x); \
        else *(LAS u32x4*)(Qs + i * 72 + c8) = pack8(x); }
    SC_ISSUE_ALL(0)
    for (int ck = 0; ck < 18; ++ck) {
        const bool isctx = ck < 2;
        const int Ls = isctx ? CTX : SEQ, nck = isctx ? 2 : 16, cidx = isctx ? ck : ck - 2;
        const int c0 = (dir == 0 ? cidx : nck - 1 - cidx) * 128;
        const int tokbase = isctx ? MLAT + b * CTX : b * SEQ;
        SC_PROC(0) SC_PROC(1) SC_PROC(2) SC_PROC(3) SC_PROC(4) SC_PROC(5)
#ifdef XP1
        asm volatile("" ::: "memory"); SC_PROC(0) SC_PROC(1) SC_PROC(2) SC_PROC(3) SC_PROC(4) SC_PROC(5)
#endif
        if (ck + 1 < 18) SC_ISSUE_ALL(ck + 1)
        __syncthreads();
        LAS float* cs = cs_all + w * 128;
        {
            const float a0 = la[2 * lane], a1 = la[2 * lane + 1];
            float s = a0 + a1;
#pragma unroll
            for (int o = 1; o < 64; o <<= 1) { const float tv = __shfl_up(s, o); if (lane >= o) s += tv; }
            cs[2 * lane] = s - a1; cs[2 * lane + 1] = s;
        }
        WAVE_SYNC();
        const float cs_end = cs[127];
#pragma unroll 1
        for (int k2 = 0; k2 < 2; ++k2) {
            const int vi = tid + 512 * k2, i = vi >> 3, c8 = (vi & 7) * 8;
            const float te = __expf(cs_end - cs[i]);
            float kv[8]; { const LAS unsigned* kp = (const LAS unsigned*)(Ks + i * 72 + c8); u32x4 kw; kw.x = kp[0]; kw.y = kp[1]; kw.z = kp[2]; kw.w = kp[3]; unpack8(kw, kv); }
#pragma unroll
            for (int e = 0; e < 8; ++e) Kt[(c8 + e) * 136 + (i ^ (c8 & 56))] = f2bf(kv[e] * te);
        }
#pragma unroll 1
        for (int k5 = 0; k5 < 5; ++k5) {
            const int id = w + 8 * k5;
            const int it = (id >= 2) + (id >= 4) + (id >= 8) + (id >= 12) + (id >= 18) + (id >= 24) + (id >= 32);
            const int cb0 = 2 * (id >= 2) + 2 * (id >= 4) + 4 * (id >= 8) + 4 * (id >= 12) + 6 * (id >= 18) + 6 * (id >= 24) + 8 * (id >= 32);
            const int jt = id - cb0, i0t = 16 * it;
            u32x2 pw;
            if (jt <= it) {
                const float csi = cs[i0t + fr];
                f32x4 acc = {0.f, 0.f, 0.f, 0.f};
#pragma unroll
                for (int kk = 0; kk < 2; ++kk) { const bf16x8 kf = *(const LAS bf16x8*)(Ks + (jt * 16 + fr) * 72 + kk * 32 + fq * 8); const bf16x8 qf = *(const LAS bf16x8*)(Qs + (i0t + fr) * 72 + kk * 32 + fq * 8);
                    acc = __builtin_amdgcn_mfma_f32_16x16x32_bf16(kf, qf, acc, 0, 0, 0); }
                const int j = jt * 16 + 4 * fq, i = i0t + fr;
                float pv[4];
#pragma unroll
                for (int r = 0; r < 4; ++r) pv[r] = (j + r <= i) ? acc[r] * __expf(csi - cs[j + r]) : 0.f;
                pw.x = pk2(pv[0], pv[1]); pw.y = pk2(pv[2], pv[3]);
            } else { pw.x = 0u; pw.y = 0u; }
            *(LAS u32x2*)(Pm + (i0t + fr) * 136 + jt * 16 + 4 * fq) = pw;
        }
        __syncthreads();
#pragma unroll
        for (int hh = 0; hh < 2; ++hh) {
            const int it = hh == 0 ? w : 7 - w, i0t = 16 * it;
            const int nk = (it >> 1) + 1;
            const float ecs = __expf(cs[i0t + fr]);
            const int i = i0t + fr, t = dir == 0 ? c0 + i : c0 + 127 - i;
            bf16_t* yrow = Y + (size_t)(tokbase + t) * 256 + h * 64;
            bf16x8 qf[2];
#pragma unroll
            for (int kk = 0; kk < 2; ++kk) qf[kk] = *(const LAS bf16x8*)(Qs + (i0t + fr) * 72 + kk * 32 + fq * 8);
#pragma unroll
            for (int pp = 0; pp < 2; ++pp) {
                const int pt = 2 * hh + pp;
                f32x4 a1 = {0.f, 0.f, 0.f, 0.f}, a2 = {0.f, 0.f, 0.f, 0.f};
                for (int kk = 0; kk < nk; ++kk) {
                    const bf16x8 vf = *(const LAS bf16x8*)(Vt + (pt * 16 + fr) * 136 + ((kk * 32 + fq * 8) ^ ((pt * 16 + fr) & 56)));
                    const bf16x8 pf = *(const LAS bf16x8*)(Pm + (i0t + fr) * 136 + kk * 32 + fq * 8);
                    a1 = __builtin_amdgcn_mfma_f32_16x16x32_bf16(vf, pf, a1, 0, 0, 0);
                }
#pragma unroll
                for (int kk = 0; kk < 2; ++kk) { const bf16x8 hf = *(const LAS bf16x8*)(Ht + (pt * 16 + fr) * 72 + kk * 32 + fq * 8); a2 = __builtin_amdgcn_mfma_f32_16x16x32_bf16(hf, qf[kk], a2, 0, 0, 0); }
                u32x2 yw; yw.x = pk2(a1[0] + ecs * a2[0], a1[1] + ecs * a2[1]); yw.y = pk2(a1[2] + ecs * a2[2], a1[3] + ecs * a2[3]);
                *(u32x2*)(yrow + pt * 16 + 4 * fq) = yw;
            }
        }
        {
            const float dec = __expf(cs_end);
#pragma unroll
            for (int q2 = 0; q2 < 2; ++q2) {
                const int id = 2 * w + q2, nt = id >> 2, pt = id & 3;
                hacc[q2] = hacc[q2] * dec;
#pragma unroll
                for (int kk = 0; kk < 4; ++kk) {
                    const bf16x8 kf = *(const LAS bf16x8*)(Kt + (nt * 16 + fr) * 136 + ((kk * 32 + fq * 8) ^ ((nt * 16 + fr) & 56)));
                    const bf16x8 vf = *(const LAS bf16x8*)(Vt + (pt * 16 + fr) * 136 + ((kk * 32 + fq * 8) ^ ((pt * 16 + fr) & 56)));
                    hacc[q2] = __builtin_amdgcn_mfma_f32_16x16x32_bf16(kf, vf, hacc[q2], 0, 0, 0);
                }
            }
        }
        __syncthreads();
#pragma unroll
        for (int q2 = 0; q2 < 2; ++q2) {
            const int id = 2 * w + q2, nt = id >> 2, pt = id & 3;
            u32x2 hw; hw.x = pk2(hacc[q2][0], hacc[q2][1]); hw.y = pk2(hacc[q2][2], hacc[q2][3]);
            *(LAS u32x2*)(Ht + (pt * 16 + fr) * 72 + nt * 16 + 4 * fq) = hw;
        }
    }
    __syncthreads();
}

template <bool WITH_Y>
__device__ __forceinline__ void s5_pass(const bf16_t* U, bf16_t* Y, LAS float* buL, LAS bf16_t* hL, const bf16x8 (&bbf)[8], const bf16x8 (&cmf)[4],
                                        const f32x2 ab, float& hre, float& him, int b, int dir, int g, int j0, int lane) {
    const int fr = lane & 15, fq = lane >> 4;
    auto tok_row = [&](int j) { const bool c = j < 16; const int Ls = c ? CTX : SEQ, jb = c ? j : j - 16; const int ti = jb * 16 + fr; return (c ? MLAT + b * CTX : b * SEQ) + (dir == 0 ? ti : Ls - 1 - ti); };
    const bf16_t* ucol = U + UC_S5 + g * 16 + (fq & 1) * 8;
    const unsigned umask = fq < 2 ? 0xffffffffu : 0u;
    u32x4 unext = *(const u32x4*)(ucol + (size_t)tok_row(j0) * UW);
    for (int j = j0; j < j0 + 36; ++j) {
        const int row = tok_row(j);
        u32x4 ucur = unext; ucur.x &= umask; ucur.y &= umask; ucur.z &= umask; ucur.w &= umask;
        unext = *(const u32x4*)(ucol + (size_t)tok_row(j < j0 + 35 ? j + 1 : j) * UW);
        const bf16x8 uf = __builtin_bit_cast(bf16x8, ucur);
#pragma unroll
        for (int T = 0; T < 8; ++T) {
            f32x4 d = {0.f, 0.f, 0.f, 0.f};
            d = __builtin_amdgcn_mfma_f32_16x16x32_bf16(bbf[T], uf, d, 0, 0, 0);
            *(LAS f32x4*)(buL + fr * 132 + 16 * T + 4 * fq) = d;
        }
        WAVE_SYNC();
        float br[16], bi[16];
#pragma unroll
        for (int i = 0; i < 16; ++i) { br[i] = buL[i * 132 + lane]; bi[i] = buL[i * 132 + 64 + lane]; }
#pragma unroll
        for (int i = 0; i < 16; ++i) {
            const float nr = ab.x * hre - ab.y * him + br[i], ni = ab.x * him + ab.y * hre + bi[i];
            hre = nr; him = ni;
            if (WITH_Y) { hL[i * 136 + lane] = f2bf(hre); hL[i * 136 + 64 + lane] = f2bf(him); }
        }
        WAVE_SYNC();
        if (WITH_Y) {
            f32x4 acc = {0.f, 0.f, 0.f, 0.f};
#pragma unroll
            for (int kk = 0; kk < 4; ++kk) { const bf16x8 hf = *(const LAS bf16x8*)(hL + fr * 136 + kk * 32 + fq * 8); acc = __builtin_amdgcn_mfma_f32_16x16x32_bf16(cmf[kk], hf, acc, 0, 0, 0); }
            u32x2 yw; yw.x = pk2(acc[0], acc[1]); yw.y = pk2(acc[2], acc[3]);
            *(u32x2*)(Y + (size_t)row * 256 + g * 16 + 4 * fq) = yw;
            WAVE_SYNC();
        }
    }
}
__device__ __forceinline__ void s5_block(const PV& P, LAS unsigned char* lds, int l, int item) {
    const int tid = P.tid, lane = tid & 63, wave = tid >> 6, fr = lane & 15, fq = lane >> 4;
    const int wi = item * 2 + (wave >> 2), ch = wave & 3, b = wi >> 5, dir = (wi >> 4) & 1, g = wi & 15;
    LAS unsigned char* wl = lds + wave * 12800;
    LAS float* buL = (LAS float*)wl;
    LAS bf16_t* hL = (LAS bf16_t*)(wl + 16 * 132 * 4);
    LAS float* ex = (LAS float*)(lds + 8 * 12800) + (wave >> 2) * 512;
    const int idx = (l * 2 + dir) * 16 + g;
    const f32x2 ab = ((const f32x2*)(P.ws_() + WS_S5AB))[idx * 64 + lane];
    const bf16_t* bb = (const bf16_t*)(P.ws_() + WS_S5BB) + (size_t)idx * 128 * 16;
    const bf16_t* cm = (const bf16_t*)(P.ws_() + WS_S5CM) + (size_t)idx * 16 * 128;
    const bf16x8 zero8 = {0, 0, 0, 0, 0, 0, 0, 0};
    bf16x8 bbf[8], cmf[4];
#pragma unroll
    for (int T = 0; T < 8; ++T) bbf[T] = fq < 2 ? *(const bf16x8*)(bb + (16 * T + fr) * 16 + fq * 8) : zero8;
#pragma unroll
    for (int kk = 0; kk < 4; ++kk) cmf[kk] = *(const bf16x8*)(cm + fr * 128 + kk * 32 + fq * 8);
    const bf16_t* U = (const bf16_t*)(P.ws_() + WS_U);
    bf16_t* Y = (bf16_t*)(P.ws_() + WS_Y) + (size_t)(4 + dir) * MTOT * 256;
    __syncthreads();
    float hre = 0.f, him = 0.f;
    s5_pass<false>(U, Y, buL, hL, bbf, cmf, ab, hre, him, b, dir, g, 36 * ch, lane);
    ex[ch * 128 + lane] = hre; ex[ch * 128 + 64 + lane] = him;
    __syncthreads();
    float ar = ab.x, ai = ab.y, a64r = 0.f, a64i = 0.f;
#pragma unroll
    for (int q = 0; q < 9; ++q) { const float nr = ar * ar - ai * ai, ni = 2.f * ar * ai; ar = nr; ai = ni; if (q == 5) { a64r = ar; a64i = ai; } }
    const float Ar = ar * a64r - ai * a64i, Ai = ar * a64i + ai * a64r;
    float sr = 0.f, si = 0.f;
    for (int j = 0; j < ch; ++j) { const float er = ex[j * 128 + lane], ei = ex[j * 128 + 64 + lane]; const float nr = Ar * sr - Ai * si + er, ni = Ar * si + Ai * sr + ei; sr = nr; si = ni; }
    hre = sr; him = si;
    s5_pass<true>(U, Y, buL, hL, bbf, cmf, ab, hre, him, b, dir, g, 36 * ch, lane);
    __syncthreads();
}

template <int L>
__device__ __forceinline__ void hyena_seg(const PV& P, LAS unsigned char* lds, int l, int ch, int tokbase0, int tokstride) {
    constexpr int TPW = L / 128, NS = L / 32, CPB = (2 * L + 8) * 2, ZROW = (L + 8) * 2, ZOFF = 8 * CPB;
    static_assert(ZOFF + 16 * ZROW <= LDS_BYTES, "hyena LDS");
    const int tid = P.tid, lane = tid & 63, w = __builtin_amdgcn_readfirstlane(tid >> 6), fr = lane & 15, fq = lane >> 4;
    const bf16_t* UH = (const bf16_t*)(P.ws_() + WS_UH);
    bf16_t* ZH = (bf16_t*)(P.ws_() + WS_ZH);
    const float* hcw = P.in_(I_HCW) + (size_t)l * 3 * 768; const float* hcb = P.in_(I_HCB) + (size_t)l * 768;
    LAS bf16_t* cop = (LAS bf16_t*)lds; LAS unsigned char* zs = lds + ZOFF;
    __syncthreads();
    {
        const bf16_t* src = UH + (size_t)(512 + ch) * MTOT;
        const float w0 = hcw[512 + ch], w1 = hcw[768 + 512 + ch], w2 = hcw[2 * 768 + 512 + ch], bz = hcb[512 + ch];
#pragma unroll
        for (int i = tid; i < 16 * L / 8; i += 512) {
            const int b = i / (L / 8), t0 = (i % (L / 8)) * 8; const bf16_t* sp = src + tokbase0 + (size_t)b * tokstride + t0;
            float v[10]; unpack8(*(const u32x4*)sp, v + 1);
            v[0] = t0 > 0 ? bf2f(sp[-1]) : 0.f; v[9] = t0 + 8 < L ? bf2f(sp[8]) : 0.f;
            float o[8];
#pragma unroll
            for (int e = 0; e < 8; ++e) o[e] = bz + w0 * v[e] + w1 * v[e + 1] + w2 * v[e + 2];
            *(LAS u32x4*)(zs + b * ZROW + t0 * 2) = pack8(o);
        }
    }
    for (int order = 0; order < 2; ++order) {
        const float* G = (L == SEQ) ? (const float*)(P.ws_() + WS_GLAT) + ((size_t)(l * 2 + order) * 256 + ch) * 4096 : (const float*)(P.ws_() + WS_GCTX) + ((size_t)order * 256 + ch) * 512;
        LAS float* red = (LAS float*)(lds + LDS_BYTES - 64);
        float sum = 0.f;
        for (int m = tid; m < 2 * L / 8 + 1; m += 512) {
            float gv[16];
#pragma unroll
            for (int q = 0; q < 4; ++q) { const int x0 = 8 * m - 8 + 4 * q; const bool ok = x0 >= 0 && x0 < 2 * L; const f32x4 t4 = ok ? *(const f32x4*)(G + x0) : (f32x4){0.f, 0.f, 0.f, 0.f};
                gv[4 * q] = t4.x; gv[4 * q + 1] = t4.y; gv[4 * q + 2] = t4.z; gv[4 * q + 3] = t4.w; }
#pragma unroll
            for (int e = 8; e < 16; ++e) sum += fabsf(gv[e]);
#pragma unroll
            for (int c = 0; c < 8; ++c) { const int pc = (8 - c) & 7;
                *(LAS u32x4*)((LAS unsigned char*)cop + c * CPB + 16 * m) = pack8(gv + 8 - pc); }
        }
        sum = wave_sum(sum);
        if (lane == 0) red[w] = sum;
        __syncthreads();
        sum = ((red[0] + red[1]) + (red[2] + red[3])) + ((red[4] + red[5]) + (red[6] + red[7]));
        const float inv = 1.f / (sum + 1e-6f);
        f32x4 acc[TPW];
#pragma unroll
        for (int m = 0; m < TPW; ++m) acc[m] = (f32x4){0.f, 0.f, 0.f, 0.f};
        const int cidx = (8 - (fr & 7)) & 7;
        const LAS unsigned char* fbase = lds + cidx * CPB + 2 * (L - (fr & 8) + 8 * fq);
        const LAS unsigned char* zbase = zs + fr * ZROW + fq * 16;
        if constexpr (TPW == 16) {
            bf16x8 fg[16];
#pragma unroll
            for (int m = 2; m < 16; ++m) fg[m] = *(const LAS bf16x8*)(fbase - 32 * (16 * w + m));
            for (int sb = 0; sb < NS / 8; ++sb) {
#pragma unroll
                for (int u = 0; u < 8; ++u) {
                    const int si = sb * 8 + u;
                    fg[(0 - 2 * u) & 15] = *(const LAS bf16x8*)(fbase - 32 * (16 * w - 2 * si));
                    fg[(1 - 2 * u) & 15] = *(const LAS bf16x8*)(fbase - 32 * (16 * w + 1 - 2 * si));
                    const bf16x8 zf = *(const LAS bf16x8*)(zbase + 64 * si);
#pragma unroll
                    for (int m = 0; m < 16; ++m) acc[m] = __builtin_amdgcn_mfma_f32_16x16x32_bf16(fg[(m - 2 * u) & 15], zf, acc[m], 0, 0, 0);
                }
            }
        } else {
            for (int si = 0; si < NS; ++si) {
                const bf16x8 zf = *(const LAS bf16x8*)(zbase + 64 * si);
#pragma unroll
                for (int m = 0; m < TPW; ++m) { const bf16x8 ff = *(const LAS bf16x8*)(fbase - 32 * (TPW * w + m - 2 * si)); acc[m] = __builtin_amdgcn_mfma_f32_16x16x32_bf16(ff, zf, acc[m], 0, 0, 0); }
            }
        }
        __syncthreads();
        {
            const int xc = order * 256 + ch;
            const float w0 = hcw[xc], w1 = hcw[768 + xc], w2 = hcw[2 * 768 + xc], bx = hcb[xc];
            const float bias = P.in_(I_HBIAS)[(size_t)(l * 2 + order) * 256 + ch];
            const bf16_t* xs = UH + (size_t)xc * MTOT + tokbase0 + (size_t)fr * tokstride;
#pragma unroll
            for (int m = 0; m < TPW; ++m) {
                const int t0 = 16 * (TPW * w + m) + 4 * fq;
                float xv[6];
                { const u32x2 xw = *(const u32x2*)(xs + t0); xv[1] = bflo(xw.x); xv[2] = bfhi(xw.x); xv[3] = bflo(xw.y); xv[4] = bfhi(xw.y);
                  xv[0] = t0 > 0 ? bf2f(xs[t0 - 1]) : 0.f; xv[5] = t0 + 4 < L ? bf2f(xs[t0 + 4]) : 0.f; }
                LAS u32x2* zp = (LAS u32x2*)(zs + fr * ZROW + t0 * 2);
                const u32x2 zo = *zp;
                const float zv[4] = {bflo(zo.x), bfhi(zo.x), bflo(zo.y), bfhi(zo.y)};
                float o[4];
#pragma unroll
                for (int r = 0; r < 4; ++r) { const float xg = bx + w0 * xv[r] + w1 * xv[r + 1] + w2 * xv[r + 2]; o[r] = xg * (acc[m][r] * inv + zv[r] * bias); }
                u32x2 ow; ow.x = pk2(o[0], o[1]); ow.y = pk2(o[2], o[3]);
                if (order == 0) *zp = ow;
                else *(u32x2*)(ZH + (size_t)ch * MTOT + tokbase0 + (size_t)fr * tokstride + t0) = ow;
            }
        }
        __syncthreads();
    }
}

constexpr int FZ_T = 0, FZ_V = 256 * 66 * 2;
template <int NROWS>
__device__ __forceinline__ void finalize_item(const PV& P, LAS unsigned char* lds, int l, int row0) {
    constexpr int NPASS = NROWS / 16, NC8 = NROWS / 8;
    const int tid = P.tid, lane = tid & 63, w = __builtin_amdgcn_readfirstlane(tid >> 6), fr = lane & 15, fq = lane >> 4;
    LAS bf16_t* T = (LAS bf16_t*)(lds + FZ_T); LAS bf16_t* Vs = (LAS bf16_t*)(lds + FZ_V);
    const bf16_t* U = (const bf16_t*)(P.ws_() + WS_U);
    const bf16_t* Yb = (const bf16_t*)(P.ws_() + WS_Y); const size_t YS = (size_t)MTOT * 256;
    __syncthreads();
    {
        const bf16_t* ZH = (const bf16_t*)(P.ws_() + WS_ZH);
#pragma unroll
        for (int i = tid; i < 256 * NC8; i += 512) { const int ch = i / NC8, c8 = (i % NC8) * 8; const u32x4 v = *(const u32x4*)(ZH + (size_t)ch * MTOT + row0 + c8);
            LAS unsigned* d = (LAS unsigned*)(T + ch * 66 + c8); d[0] = v.x; d[1] = v.y; d[2] = v.z; d[3] = v.w; }
    }
    __syncthreads();
    const int sub = tid & 31, c = sub * 8;
    const float* cw = P.in_(I_SCW) + (size_t)l * 3 * 384; const float* cb = P.in_(I_SCB) + (size_t)l * 384;
    const float dsk = P.in_(I_SD)[l * 4 + (sub >> 3)];
    const float* ng = P.in_(I_SNG) + l * 256;
    const float* d5 = P.in_(I_5D) + l * 256;
    bf16x8 wf[8][2];
    {
        const bf16_t* Wg0 = (const bf16_t*)(P.ws_() + WS_WGLU) + (size_t)l * 256 * 256;
#pragma unroll
        for (int kk = 0; kk < 8; ++kk)
#pragma unroll
            for (int a = 0; a < 2; ++a) wf[kk][a] = *(const bf16x8*)(Wg0 + (size_t)((2 * w + a) * 16 + fr) * 256 + kk * 32 + fq * 8);
    }
    struct FRaw { u32x4 rx0, rz, rg, ru5, y0, y1, y2, y3, y4, y5; };
    auto load_raw = [&](int pass) __attribute__((always_inline)) {
        const int row = row0 + pass * 16 + (tid >> 5);
        const bf16_t* Ur = U + (size_t)row * UW; const bf16_t* yp = Yb + (size_t)row * 256 + c;
        FRaw f;
        f.rx0 = *(const u32x4*)((const bf16_t*)(P.ws_() + WS_XBC) + (size_t)row * 384 + c);
        f.rz = *(const u32x4*)(Ur + UC_Z + c); f.rg = *(const u32x4*)(Ur + UC_G + c); f.ru5 = *(const u32x4*)(Ur + UC_S5 + c);
        f.y0 = *(const u32x4*)(yp); f.y1 = *(const u32x4*)(yp + YS); f.y2 = *(const u32x4*)(yp + 2 * YS); f.y3 = *(const u32x4*)(yp + 3 * YS); f.y4 = *(const u32x4*)(yp + 4 * YS); f.y5 = *(const u32x4*)(yp + 5 * YS);
        return f;
    };
    float ng8[8], d58[8];
#pragma unroll
    for (int e = 0; e < 8; ++e) { ng8[e] = ng[c + e]; d58[e] = d5[c + e]; }
    FRaw nx = load_raw(0);
#pragma unroll 1
    for (int pass = 0; pass < NPASS; ++pass) {
        const int tk = pass * 16 + (tid >> 5), row = row0 + tk;
        bf16_t* Yc = (bf16_t*)(P.ws_() + WS_XN) + (size_t)row * DM;
        const FRaw cur = nx;
        if (pass + 1 < NPASS) nx = load_raw(pass + 1);
        const u32x4 rx0 = cur.rx0, rz = cur.rz, rg = cur.rg, ru5 = cur.ru5, y0 = cur.y0, y1 = cur.y1, y2 = cur.y2, y3 = cur.y3, y4 = cur.y4, y5 = cur.y5;
        {
            float v[8], x0[8], z[8], yf[8], yb[8]; float ss = 0.f;
            unpack8(rx0, x0); unpack8(rz, z); unpack8(y0, yf); unpack8(y1, yb);
#pragma unroll
            for (int e = 0; e < 8; ++e) { const float y = yf[e] + yb[e] + x0[e] * dsk; const float o = y * siluf_(z[e]); v[e] = o; ss += o * o; }
#pragma unroll
            for (int sh = 1; sh < 32; sh <<= 1) ss += __shfl_xor(ss, sh);
            const float rstd = rsqrtf(ss * (1.f / 256.f) + 1e-6f);
#pragma unroll
            for (int e = 0; e < 8; ++e) v[e] = v[e] * rstd * ng8[e];
            *(u32x4*)(Yc + c) = pack8(v);
        }
        {
            u32x4 o; unsigned short e8[8];
#pragma unroll
            for (int e = 0; e < 8; ++e) e8[e] = T[(c + e) * 66 + tk];
            o.x = e8[0] | ((unsigned)e8[1] << 16); o.y = e8[2] | ((unsigned)e8[3] << 16); o.z = e8[4] | ((unsigned)e8[5] << 16); o.w = e8[6] | ((unsigned)e8[7] << 16);
            *(u32x4*)(Yc + 256 + c) = o;
        }
        {
            float v[8], yf[8], yb[8], g[8]; float sm = 0.f;
            unpack8(y2, yf); unpack8(y3, yb); unpack8(rg, g);
#pragma unroll
            for (int e = 0; e < 8; ++e) { v[e] = yf[e] + yb[e]; sm += v[e]; }
            sm += __shfl_xor(sm, 1); sm += __shfl_xor(sm, 2); sm += __shfl_xor(sm, 4);
            const float mu = sm * (1.f / 64.f); float vs = 0.f;
#pragma unroll
            for (int e = 0; e < 8; ++e) { const float d = v[e] - mu; vs += d * d; }
            vs += __shfl_xor(vs, 1); vs += __shfl_xor(vs, 2); vs += __shfl_xor(vs, 4);
            const float rstd = rsqrtf(vs * (1.f / 64.f) + 1e-6f);
#pragma unroll
            for (int e = 0; e < 8; ++e) v[e] = siluf_(g[e]) * (v[e] - mu) * rstd;
            *(u32x4*)(Yc + 512 + c) = pack8(v);
        }
        {
            float u[8], yf[8], yb[8], o[8];
            unpack8(ru5, u); unpack8(y4, yf); unpack8(y5, yb);
#pragma unroll
            for (int e = 0; e < 8; ++e) o[e] = gelu_tanh(u[e] * d58[e] + yf[e] + yb[e]);
            *(LAS u32x4*)(Vs + tk * 264 + c) = pack8(o);
        }
    }
    __syncthreads();
    {
        const bf16_t* Wg = (const bf16_t*)(P.ws_() + WS_WGLU) + (size_t)l * 256 * 256;
        const float* gb = P.in_(I_5GB) + l * 256;
        f32x4 acc[2][NPASS];
#pragma unroll
        for (int a = 0; a < 2; ++a)
#pragma unroll
            for (int m = 0; m < NPASS; ++m) acc[a][m] = (f32x4){0.f, 0.f, 0.f, 0.f};
#pragma unroll
        for (int kk = 0; kk < 8; ++kk) {
            bf16x8 vf[NPASS];
#pragma unroll
            for (int m = 0; m < NPASS; ++m) vf[m] = *(const LAS bf16x8*)(Vs + (m * 16 + fr) * 264 + kk * 32 + fq * 8);
#pragma unroll
            for (int a = 0; a < 2; ++a)
#pragma unroll
                for (int m = 0; m < NPASS; ++m) acc[a][m] = __builtin_amdgcn_mfma_f32_16x16x32_bf16(wf[kk][a], vf[m], acc[a][m], 0, 0, 0);
        }
#pragma unroll
        for (int a = 0; a < 2; ++a)
#pragma unroll
            for (int m = 0; m < NPASS; ++m) {
                const int n = (2 * w + a) * 16 + 4 * fq, tkk = m * 16 + fr;
                const u32x2 vv = *(const LAS u32x2*)(Vs + tkk * 264 + n);
                const float v4[4] = {bflo(vv.x), bfhi(vv.x), bflo(vv.y), bfhi(vv.y)};
                float o[4];
#pragma unroll
                for (int r = 0; r < 4; ++r) o[r] = v4[r] * sigmoidf_(acc[a][m][r] + gb[n + r]);
                u32x2 ow; ow.x = pk2(o[0], o[1]); ow.y = pk2(o[2], o[3]);
                *(u32x2*)((bf16_t*)(P.ws_() + WS_XN) + (size_t)(row0 + tkk) * DM + 768 + n) = ow;
            }
    }
    __syncthreads();
}

__device__ __forceinline__ void final_norm(const PV& P, int gw, int ngw, int lane) {
    const float* g = P.in_(I_FNG);
    constexpr int NR = 4;
    f32x4 nx[NR][4];
#pragma unroll
    for (int q = 0; q < NR; ++q)
#pragma unroll
        for (int j = 0; j < 4; ++j) nx[q][j] = *(const f32x4*)(P.out_() + (size_t)(gw + q * ngw) * DM + 4 * lane + 256 * j);
    for (int row0 = gw; row0 < MLAT; row0 += NR * ngw) {
        f32x4 v[NR][4]; float ss[NR];
#pragma unroll
        for (int q = 0; q < NR; ++q)
#pragma unroll
            for (int j = 0; j < 4; ++j) v[q][j] = nx[q][j];
        if (row0 + NR * ngw < MLAT) {
#pragma unroll
            for (int q = 0; q < NR; ++q)
#pragma unroll
                for (int j = 0; j < 4; ++j) nx[q][j] = *(const f32x4*)(P.out_() + (size_t)(row0 + NR * ngw + q * ngw) * DM + 4 * lane + 256 * j);
        }
#pragma unroll
        for (int q = 0; q < NR; ++q) { float s_ = 0.f;
#pragma unroll
            for (int j = 0; j < 4; ++j) s_ += v[q][j].x * v[q][j].x + v[q][j].y * v[q][j].y + v[q][j].z * v[q][j].z + v[q][j].w * v[q][j].w;
            ss[q] = s_; }
#pragma unroll
        for (int q = 0; q < NR; ++q) {
            const float rstd = rsqrtf(wave_sum(ss[q]) * (1.f / DM) + 1e-6f);
#pragma unroll
            for (int j = 0; j < 4; ++j) { const f32x4 gg = *(const f32x4*)(g + 4 * lane + 256 * j); *(f32x4*)(P.out_() + (size_t)(row0 + q * ngw) * DM + 4 * lane + 256 * j) = v[q][j] * rstd * gg; }
        }
    }
}

__device__ __forceinline__ void sw_items(const PV& P, LAS unsigned char* lds, int lb, int nlb, int it_lo, int it_hi) {
    LAS float* sc = (LAS float*)lds;
    LAS float* red = (LAS float*)(lds + 17 * 1024 * 4);
    const int tid = P.tid;
    for (int it = it_lo + lb; it < it_hi; it += nlb) {
        const bool win = it >= 176;
        const int l = win ? 1 : it / 88, j0 = (win ? it - 176 : it % 88) * 64, col = tid & 63, ks = tid >> 6;
        const int WN = win ? D_IN : 2 * DFF, soff = win ? 0 : 3 * DM;
        const bool cvalid = j0 + col < WN;
        __syncthreads();
        for (int i = tid; i < 17 * 1024; i += 512) sc[i] = ((const float*)(P.ws_() + WS_MOD))[((size_t)l * 17 + (i >> 10)) * 6144 + soff + (i & 1023)];
        __syncthreads();
        const float* w = (win ? P.in_(I_WIN) + (size_t)DM * D_IN : P.in_(I_FUP) + (size_t)l * DM * 2 * DFF) + (cvalid ? j0 + col : 0);
        float a[17];
#pragma unroll
        for (int r = 0; r < 17; ++r) a[r] = 0.f;
#pragma unroll 1
        for (int k0 = ks * 128; k0 < ks * 128 + 128; k0 += 16) {
            float wv[16];
#pragma unroll
            for (int u = 0; u < 16; ++u) wv[u] = w[(size_t)(k0 + u) * WN];
#pragma unroll
            for (int u = 0; u < 16; ++u)
#pragma unroll
                for (int r = 0; r < 17; ++r) a[r] += sc[r * 1024 + k0 + u] * wv[u];
        }
#pragma unroll
        for (int r = 0; r < 17; ++r) red[(ks * 17 + r) * 64 + col] = a[r];
        __syncthreads();
        for (int i = tid; i < 17 * 64; i += 512) {
            const int r = i >> 6, c = i & 63; float sm = 0.f;
#pragma unroll
            for (int k = 0; k < 8; ++k) sm += red[(k * 17 + r) * 64 + c];
            if (win) ((float*)(P.ws_() + WS_SWIN))[(size_t)r * NIN + j0 + c] = (j0 + c < D_IN) ? sm : 0.f;
            else ((float*)(P.ws_() + WS_SWUP))[((size_t)l * 17 + r) * 2 * DFF + j0 + c] = sm;
        }
    }
    __syncthreads();
}
__device__ __forceinline__ void deferred_work(const PV& P, LAS unsigned char* lds, int which, int first_idle) {
    const int tid = P.tid, lane = tid & 63, wave = tid >> 6, blk = blockIdx.x, nblk = gridDim.x;
    if (blk < first_idle) return;
    const int lb = blk - first_idle, nlb = nblk - first_idle, lgw = lb * 8 + wave, nlgw = nlb * 8;
    constexpr int I_LAYER = 16 * 88 + 16 * 32 + 16 * 176 + 44 * 32 + 4 * 8;
    __syncthreads();
    if (which == 0) {
        p0_filter(P, lds, lb, nlb, 0, 72);
        __syncthreads();
        p0_s5(P, lgw, nlgw, lane, 0, 32);
        p0_weights(P, lds, lgw, nlgw, wave, lane, 1408, 1920);
        p0_weights(P, lds, lgw, nlgw, wave, lane, I_LAYER - 32, I_LAYER);
    } else if (which == 1) {
        p0_weights(P, lds, lgw, nlgw, wave, lane, 1920, I_LAYER - 32);
        __syncthreads();
        sw_items(P, lds, lb, nlb, 0, 88);
        if (lb >= 88) p0_mod(P, lds, lb - 88, nlb - 88, 192, 384);
    } else {
        p0_filter(P, lds, lb, nlb, 72, 136);
        __syncthreads();
        sw_items(P, lds, lb, nlb, 88, 220);
        p0_s5(P, lgw, nlgw, lane, 32, 64);
        p0_weights(P, lds, lgw, nlgw, wave, lane, I_LAYER, 2 * I_LAYER);
    }
    __syncthreads();
}
constexpr int NSP = 9;
constexpr int NPHASE = 1 + 2 * NSP + 1;

__device__ __forceinline__ void run_phase(const PV& P, int ph, LAS unsigned char* lds) {
    const int tid = P.tid, lane = tid & 63, wave = tid >> 6;
    const int blk = blockIdx.x, nblk = gridDim.x, gw = blk * 8 + wave, ngw = nblk * 8;
#ifndef PHMASK
#define PHMASK 0xffff
#endif
    if (ph == 0) {
        if (PHMASK & 1) p0_mod(P, lds, blk, nblk, 0, 192);
        return;
    }
    if (ph == NPHASE - 1) { if (PHMASK & 16) final_norm(P, gw, ngw, lane); return; }
    const int l = (ph - 1) / NSP, sp = (ph - 1) % NSP;
    const bool last = (l == 1);
    const int Mall = MTOT, Mres = last ? MLAT : MTOT;
    pg8::StaticOrder S;
    switch (sp) {
    case 0: if (PHMASK & 16) norm_phase(P, l, 1, Mall, gw, ngw, lane);
            if (l == 0) { __syncthreads(); p0_weights(P, lds, gw, ngw, wave, lane, 0, 1408); }
            break;
    case 1: if (PHMASK & 32) { pg8::Gemm g{(const bf16_t*)(P.ws_() + WS_XN), (const bf16_t*)(P.ws_() + WS_WIN) + (size_t)l * NIN * DM, Mall, NIN, DM};
              EpiU E{(bf16_t*)(P.ws_() + WS_U), (bf16_t*)(P.ws_() + WS_UH)};
              if (l == 0) { S.init(Mall, NIN, nblk, blk); pg8::gemm_phase(lds, g, S, E, P.tid); deferred_work(P, lds, 0, (Mall / 256 * (NIN / 256)) % nblk); }
              else { pg8::LastWinOrder S1; S1.init(nblk, blk); EpiUN E1{(bf16_t*)(P.ws_() + WS_U), (bf16_t*)(P.ws_() + WS_UH), (const float*)(P.ws_() + WS_SSQ2), (const float*)(P.ws_() + WS_SWIN)};
                     pg8::gemm_phase(lds, g, S1, E1, P.tid); } } break;
    case 2: {
#ifndef REP_SUB
#define REP_SUB 0
#endif
        for (int rep = 0; rep < ((REP_SUB == 1 && l == 0) ? 2 : 1); ++rep)
        xbc_prepass(P, l, blk, nblk);
        if (PHMASK & 64) for (int it = blk; it < 256; it += nblk) {
            hyena_seg<SEQ>(P, lds, l, it, 0, SEQ);
            if (!last) hyena_seg<CTX>(P, lds, l, it, MLAT, CTX);
        }
        for (int rep = 0; rep < ((REP_SUB == 3 && l == 0) ? 2 : 1); ++rep)
        if (PHMASK & 256) for (int it = blk; it < 256; it += nblk) s5_block(P, lds, l, it);
        __syncthreads();
    } break;
    case 3:
        if (PHMASK & 128) for (int it = blk; it < 256; it += nblk) { const int kind = it >> 7, r = it & 127; scan_item(P, lds, l, kind, r >> 3, (r >> 1) & 3, r & 1); }
        break;
    case 4: for (int i = blk * 512 + tid; i < MTOT; i += nblk * 512) { ((float*)(P.ws_() + WS_SSQ))[i] = 0.f; if (l == 0) ((float*)(P.ws_() + WS_SSQ2))[i] = 0.f; }
            if (PHMASK & 512) { if (last) { for (int it = blk; it < MLAT / 64; it += nblk) finalize_item<64>(P, lds, l, it * 64); }
                                else { for (int it = blk; it < MTOT / 48; it += nblk) finalize_item<48>(P, lds, l, it * 48); } } break;
    case 5: if (PHMASK & 1024) { pg8::Gemm g{(const bf16_t*)(P.ws_() + WS_XN), (const bf16_t*)(P.ws_() + WS_WOUT) + (size_t)l * DM * DM, Mres, DM, DM};
              S.init(Mres, DM, nblk, blk);
              EpiResN E{l == 0 ? P.in_(I_X) : P.out_(), l == 0 ? P.in_(I_CTX) : (const float*)(P.ws_() + WS_HC), P.out_(), (float*)(P.ws_() + WS_HC), (const float*)(P.ws_() + WS_MOD) + (size_t)l * 17 * 6144 + 2 * DM,
                        P.in_(I_N2G) + l * DM, (const float*)(P.ws_() + WS_MOD) + (size_t)l * 17 * 6144 + 4 * DM, (bf16_t*)(P.ws_() + WS_Y), (float*)(P.ws_() + WS_SSQ)};
              pg8::gemm_phase(lds, g, S, E, P.tid); if (l == 0) deferred_work(P, lds, 1, (Mres / 256 * 4) % nblk); } break;
    case 6: break;
    case 7: if (PHMASK & 2048) { pg8::Gemm g{(const bf16_t*)(P.ws_() + WS_Y), (const bf16_t*)(P.ws_() + WS_WUP) + (size_t)l * 2 * DFF * DM, Mres, 2 * DFF, DM};
              S.init(Mres, 2 * DFF, nblk, blk); EpiSwigluN E{(bf16_t*)(P.ws_() + WS_U), (const float*)(P.ws_() + WS_SSQ), (const float*)(P.ws_() + WS_SWUP) + (size_t)l * 17 * 2 * DFF}; pg8::gemm_phase(lds, g, S, E, P.tid); } break;
    case 8: if (PHMASK & 4096) { pg8::Gemm g{(const bf16_t*)(P.ws_() + WS_U), (const bf16_t*)(P.ws_() + WS_WDN) + (size_t)l * DM * DFF, Mres, DM, DFF};
              S.init(Mres, DM, nblk, blk);
              if (l == 0) {
                  EpiResN E{P.out_(), (const float*)(P.ws_() + WS_HC), P.out_(), (float*)(P.ws_() + WS_HC), (const float*)(P.ws_() + WS_MOD) + (size_t)l * 17 * 6144 + 5 * DM,
                            P.in_(I_N1G) + DM, (const float*)(P.ws_() + WS_MOD) + (size_t)17 * 6144 + 1 * DM, (bf16_t*)(P.ws_() + WS_XN), (float*)(P.ws_() + WS_SSQ2)};
                  pg8::gemm_phase(lds, g, S, E, P.tid); deferred_work(P, lds, 2, (Mres / 256 * 4) % nblk); break; }
              EpiRes E{P.out_(), (const float*)(P.ws_() + WS_HC), P.out_(), (float*)(P.ws_() + WS_HC), (const float*)(P.ws_() + WS_MOD) + (size_t)l * 17 * 6144 + 5 * DM};
              pg8::gemm_phase(lds, g, S, E, P.tid); if (l == 0) deferred_work(P, lds, 2, (Mres / 256 * 4) % nblk); } break;
    }
}


#define XB_TMO      128
#define XB_XCNT(j)  (256  + 64 * (j))
#define XB_XSUB(j)  (1280 + 64 * (j))
#define XB_XGEN(j)  (2304 + 64 * (j))
#define XB_TOP      3328
#define XB_TOPGEN   3392
#define XCD_BAR_WORDS 3456
#define XB_SPIN_CAP (1u << 18)

__device__ __forceinline__ unsigned xb_ld(unsigned* p)              { return __hip_atomic_load(p, __ATOMIC_RELAXED, __HIP_MEMORY_SCOPE_AGENT); }
__device__ __forceinline__ unsigned xb_add(unsigned* p, unsigned v) { return __hip_atomic_fetch_add(p, v, __ATOMIC_RELAXED, __HIP_MEMORY_SCOPE_AGENT); }
__device__ __forceinline__ unsigned xb_xcc_id() { return (unsigned)__builtin_amdgcn_s_getreg((3 << 11) | 20) & 0xFu; }
#define XB_SPIN(cond, bar) do { unsigned _sp = 0; while (cond) { __builtin_amdgcn_s_sleep(1); \
    if ((++_sp & 255u) == 0u) { if (xb_ld(&(bar)[XB_TMO])) break; if (_sp > XB_SPIN_CAP) { atomicAdd(&(bar)[XB_TMO], 1u); break; } } } } while (0)

struct XcdBarrier {
    unsigned* bar; unsigned x;
    volatile LAS unsigned* st;
};

__device__ __forceinline__ XcdBarrier xcd_barrier_post(unsigned* bar, volatile LAS unsigned* st) {
    XcdBarrier b; b.bar = bar; b.x = xb_xcc_id(); b.st = st;
    if (threadIdx.x == 0) (void)xb_add(&bar[XB_XCNT(b.x)], 1u);
    return b;
}
__device__ __forceinline__ void xcd_barrier_complete(unsigned* bar, unsigned x, unsigned& nloc, unsigned& nx) {
    const unsigned G = gridDim.x * gridDim.y * gridDim.z;
    unsigned sum, cnt, mine, sp = 0u;
    for (;;) {
        sum = 0u; cnt = 0u; mine = 0u;
#pragma unroll
        for (unsigned j = 0; j < 16; ++j) { const unsigned c = xb_ld(&bar[XB_XCNT(j)]); sum += c; cnt += (c > 0u) ? 1u : 0u; mine = (j == x) ? c : mine; }
        if (sum == G) break;
        __builtin_amdgcn_s_sleep(1);
        if ((++sp & 255u) == 0u) { if (xb_ld(&bar[XB_TMO])) break; if (sp > XB_SPIN_CAP) { atomicAdd(&bar[XB_TMO], 1u); break; } }
    }
    nloc = mine > 0u ? mine : 1u; nx = cnt > 0u ? cnt : 1u;
}

__device__ __forceinline__ void xcd_barrier(const XcdBarrier& b) {
    asm volatile("s_waitcnt vmcnt(0)" ::: "memory");
    __syncthreads();
    if (threadIdx.x == 0) {
        unsigned* bar = b.bar;
        __builtin_amdgcn_s_waitcnt(0);
        unsigned nloc = b.st[0], nx = b.st[1];
        if (nloc == 0u) { xcd_barrier_complete(bar, b.x, nloc, nx); b.st[0] = nloc; b.st[1] = nx; }
        const unsigned old = xb_add(&bar[XB_XSUB(b.x)], 1u);
        const unsigned gen = old / nloc;
        if (old + 1u == (gen + 1u) * nloc) {
            __builtin_amdgcn_fence(__ATOMIC_RELEASE, "agent");
            asm volatile("s_waitcnt vmcnt(0)" ::: "memory");
            const unsigned og = xb_add(&bar[XB_TOP], 1u);
            const unsigned tg = og / nx;
            if (og + 1u == (tg + 1u) * nx) xb_add(&bar[XB_TOPGEN], 1u);
            else XB_SPIN(xb_ld(&bar[XB_TOPGEN]) == tg, bar);
            __builtin_amdgcn_fence(__ATOMIC_ACQUIRE, "agent");
            xb_add(&bar[XB_XGEN(b.x)], 1u);
            asm volatile("s_waitcnt vmcnt(0)" ::: "memory");
        } else {
            XB_SPIN(xb_ld(&bar[XB_XGEN(b.x)]) == gen, bar);
            __builtin_amdgcn_fence(__ATOMIC_ACQUIRE, "agent");
            asm volatile("s_waitcnt vmcnt(0)" ::: "memory");
        }
    }
    __syncthreads();
}


__device__ __forceinline__ void grid_barrier(unsigned* bar, unsigned k, int tid) {
    asm volatile("s_waitcnt vmcnt(0) lgkmcnt(0)" ::: "memory");
    __builtin_amdgcn_s_barrier();
    if (tid == 0) {
        __builtin_amdgcn_fence(__ATOMIC_RELEASE, "agent");
        asm volatile("s_waitcnt vmcnt(0)" ::: "memory");
        const unsigned old = __hip_atomic_fetch_add(bar, 1u, __ATOMIC_RELAXED, __HIP_MEMORY_SCOPE_AGENT);
        if (old == k * gridDim.x - 1u) __hip_atomic_store(bar + 32, k, __ATOMIC_RELAXED, __HIP_MEMORY_SCOPE_AGENT);
        else {
            unsigned long long t0 = __builtin_amdgcn_s_memrealtime();
            while (__hip_atomic_load(bar + 32, __ATOMIC_RELAXED, __HIP_MEMORY_SCOPE_AGENT) < k) {
                __builtin_amdgcn_s_sleep(2);
                if (__builtin_amdgcn_s_memrealtime() - t0 > 200000000ull) break;
            }
        }
        __builtin_amdgcn_fence(__ATOMIC_ACQUIRE, "agent");
        asm volatile("s_waitcnt vmcnt(0)" ::: "memory");
    }
    asm volatile("" ::: "memory");
    __builtin_amdgcn_s_barrier();
    asm volatile("" ::: "memory");
}
#ifdef DEBUG_CHK
__device__ __forceinline__ void chk_range(const PV& P, int ph, size_t off, size_t bytes, int is_f32, const void* base) {
    const unsigned* p = (const unsigned*)((const unsigned char*)base + off);
    const size_t n = bytes / 4; bool bad = false;
    for (size_t i = (size_t)blockIdx.x * 512 + P.tid; i < n; i += (size_t)gridDim.x * 512) {
        const unsigned v = p[i];
        if (is_f32) { const unsigned e = (v >> 23) & 0xff; if (e >= 127 + 20) bad = true; }
        else { const unsigned e0 = (v >> 7) & 0xff, e1 = (v >> 23) & 0xff; if (e0 >= 127 + 20 || e1 >= 127 + 20) bad = true; }
    }
    if (bad) atomicOr((unsigned*)(P.ws_() + WS_SUM), 1u << ph);
}
__device__ __forceinline__ void chk_phase(const PV& P, int ph) {
    if (ph == 0) {
        chk_range(P, ph, WS_MOD, WS_S5BB - WS_MOD, 1, P.ws_()); chk_range(P, ph, WS_S5BB, WS_GLAT - WS_S5BB, 0, P.ws_());
        chk_range(P, ph, WS_GLAT, WS_WIN - WS_GLAT, 1, P.ws_()); chk_range(P, ph, WS_WIN, WS_HC - WS_WIN, 0, P.ws_()); return; }
    if (ph == NPHASE - 1) { chk_range(P, ph, 0, (size_t)MLAT * DM * 4, 1, P.out_()); return; }
    const int l = (ph - 1) / 8, sp = (ph - 1) % 8; const size_t Mres = l ? MLAT : MTOT;
    switch (sp) {
    case 0: chk_range(P, ph, WS_XN, (size_t)MTOT * DM * 2, 0, P.ws_()); break;
    case 1: chk_range(P, ph, WS_U, (size_t)MTOT * UW * 2 + (size_t)768 * MTOT * 2, 0, P.ws_()); break;
    case 2: chk_range(P, ph, WS_Y, (size_t)6 * MTOT * 256 * 2, 0, P.ws_()); chk_range(P, ph, WS_ZH, l ? (size_t)0 : (size_t)256 * MTOT * 2, 0, P.ws_()); break;
    case 3: case 5: chk_range(P, ph, WS_XN, Mres * DM * 2, 0, P.ws_()); break;
    case 4: case 7: chk_range(P, ph, 0, (size_t)MLAT * DM * 4, 1, P.out_()); if (!l) chk_range(P, ph, WS_HC, (size_t)MCTX * DM * 4, 1, P.ws_()); break;
    case 6: chk_range(P, ph, WS_U, Mres * DFF * 2, 0, P.ws_()); break;
    }
}
#endif
__global__ void __launch_bounds__(512, 2) fwd_mega(Params KP, int ph_lo, int ph_hi) {
    extern __shared__ __attribute__((aligned(16))) unsigned char smem[];
    LAS unsigned char* lds = (LAS unsigned char*)smem;
    if (ph_lo < 0) cg::this_grid().sync();
    unsigned nbar = 0;
    volatile LAS unsigned* xst = (volatile LAS unsigned*)(lds + LDS_BYTES - 16);
    if (threadIdx.x == 0) { xst[0] = 0u; xst[1] = 0u; }
    __syncthreads();
    const XcdBarrier xb = xcd_barrier_post((unsigned*)(KP.ws + WS_XBAR), xst);
    for (int ph = ph_lo; ph < ph_hi; ++ph) {
        if (ph >= 1 && ph < NPHASE - 1 && ((ph - 1) % NSP == 6 || ph == 1 + NSP)) continue;
        int z; asm volatile("s_mov_b32 %0, 0" : "=s"(z));
        int tidv = threadIdx.x; asm volatile("" : "+v"(tidv));
        const PV P{KP, z, tidv};
        run_phase(P, ph, lds);
#ifdef EXTRA_BAR
        if (ph == 9) for (int q = 0; q < EXTRA_BAR; ++q) { ++nbar; grid_barrier((unsigned*)(P.ws_() + WS_SUM), nbar, tidv); }
#endif
#ifdef REP_PHASE
        if (ph == REP_PHASE) { ++nbar; grid_barrier((unsigned*)(P.ws_() + WS_SUM), nbar, tidv); run_phase(P, ph, lds); }
#endif
        if (ph + 1 < ph_hi) { ++nbar; xcd_barrier(xb); }
    }
}


#ifdef DBG2
__global__ void dbg_zero(Params KP) { if (blockIdx.x == 0 && threadIdx.x < 8) ((unsigned*)(KP.ws + WS_SUM))[32 + threadIdx.x] = 0u; }
__global__ void dbg_count(Params KP, size_t off, size_t bytes, int slot, int is_out = 0) {
    const unsigned* p = is_out ? (const unsigned*)KP.out : (const unsigned*)(KP.ws + off); const size_t n = bytes / 4; unsigned bad = 0;
    for (size_t i = (size_t)blockIdx.x * blockDim.x + threadIdx.x; i < n; i += (size_t)gridDim.x * blockDim.x) { const unsigned e = (p[i] >> 23) & 0xff, e2 = (p[i] >> 7) & 0xff; if (e >= 147 || (!is_out && slot < 3 && e2 >= 147)) ++bad; }
    if (bad) atomicAdd((unsigned*)(KP.ws + WS_SUM) + 32 + slot, bad);
}
__global__ void dbg_out(Params KP) {
    const unsigned* c = (const unsigned*)(KP.ws + WS_SUM) + 32;
    float code = 1000.f * (float)(1 + (c[0] ? 1 : 0) + (c[1] ? 2 : 0) + (c[2] ? 4 : 0) + (c[3] ? 8 : 0));
    for (size_t i = (size_t)blockIdx.x * blockDim.x + threadIdx.x; i < (size_t)MLAT * DM; i += (size_t)gridDim.x * blockDim.x) KP.out[i] = (i == 0) ? code : 0.f;
}
#endif
extern "C" void kernel_launch(void* const* d_in, const int* in_sizes, int n_in, void* d_out, int out_size, void* d_ws, size_t ws_size, hipStream_t stream) {
    static int grid = 0;
    if (grid == 0) {
        if (n_in != 39 || out_size != MLAT * DM || ws_size < WS_END) { fprintf(stderr, "kernel_launch: unexpected shapes (n_in %d out %d ws %zu need %zu)\n", n_in, out_size, ws_size, (size_t)WS_END); grid = -1; return; }
        int dev = 0, cus = 0, per_cu = 0;
        hipGetDevice(&dev); hipDeviceGetAttribute(&cus, hipDeviceAttributeMultiprocessorCount, dev);
        hipFuncSetAttribute((const void*)fwd_mega, hipFuncAttributeMaxDynamicSharedMemorySize, LDS_BYTES);
        hipOccupancyMaxActiveBlocksPerMultiprocessor(&per_cu, (const void*)fwd_mega, 512, LDS_BYTES);
        if (per_cu < 1) { fprintf(stderr, "kernel_launch: occupancy query says %d blocks per CU\n", per_cu); per_cu = 1; }
        grid = cus;
        (void)hipGetLastError();
    }
    if (grid < 0) return;
    hipMemsetAsync((unsigned char*)d_ws + WS_XBAR, 0, 16384, stream);
    Params p{};
    for (int i = 0; i < 39; ++i) p.in[i] = (const float*)d_in[i];
    p.out = (float*)d_out; p.ws = (unsigned char*)d_ws;
#ifdef DBG2
    hipLaunchKernelGGL(dbg_zero, dim3(1), dim3(64), 0, stream, p);
    for (int ph = 0; ph < NPHASE; ++ph) {
        hipLaunchKernelGGL(fwd_mega, dim3(grid), dim3(512), LDS_BYTES, stream, p, ph, ph + 1);
        if (ph == 3) {
            hipLaunchKernelGGL(dbg_count, dim3(256), dim3(256), 0, stream, p, (size_t)WS_Y, (size_t)4 * MTOT * 256 * 2, 0, 0);
            hipLaunchKernelGGL(dbg_count, dim3(256), dim3(256), 0, stream, p, (size_t)WS_Y + (size_t)4 * MTOT * 256 * 2, (size_t)2 * MTOT * 256 * 2, 1, 0);
            hipLaunchKernelGGL(dbg_count, dim3(256), dim3(256), 0, stream, p, (size_t)WS_ZH, (size_t)256 * MTOT * 2, 2, 0);
        }
    }
    hipLaunchKernelGGL(dbg_count, dim3(256), dim3(256), 0, stream, p, (size_t)0, (size_t)MLAT * DM * 4, 3, 1);
    hipLaunchKernelGGL(dbg_out, dim3(256), dim3(256), 0, stream, p);
#elif ONE_LAUNCH
    int lo = 0, hi = NPHASE;
    void* args[] = {&p, &lo, &hi};
    hipError_t e = hipLaunchCooperativeKernel((const void*)fwd_mega, dim3(grid), dim3(512), args, LDS_BYTES, stream);
    if (e != hipSuccess) fprintf(stderr, "cooperative launch failed: %s (grid %d)\n", hipGetErrorString(e), grid);
#else
    for (int ph = 0; ph < NPHASE; ++ph) hipLaunchKernelGGL(fwd_mega, dim3(grid), dim3(512), LDS_BYTES, stream, p, ph, ph + 1);
#endif
}
```
